# Optimizing an MI355X kernel written in HIP

```python
import math
import jax, jax.numpy as jnp
from jax import lax
import numpy as np

D_MODEL = 1024
BATCH = 8
SEQ = 2048
DEPTH = 1
DEC_BATCH = 128
DEC_SEQ = 8
PAST_LEN = 2048
PAGE_SIZE = 128

N_META = 16
GDN_HEADS = 8
GDN_DK = 128
GDN_DV = 128
CONV_W = 4
GDN_CHUNK = 64
ATT_HEADS = 8
ATT_KV_HEADS = 2
ATT_DH = 128
IDX_HEADS = 16
IDX_DIM = 64
TOPK_MAX = 256
Q_BLOCK = 128
PEER_HEADS = 8
PEER_NKEYS = 128
PEER_EXPERTS = PEER_NKEYS * PEER_NKEYS
PEER_QDIM = 256
PEER_TOPK = 16
PEER_TOK_BLOCK = 256
DN_ALPHA = (2 * DEPTH) ** 0.25
DN_BETA = (8 * DEPTH) ** -0.25
LN_EPS = 1e-5
RMS_EPS = 1e-6

GDN_QK = GDN_HEADS * GDN_DK
GDN_V = GDN_HEADS * GDN_DV
CONV_DIM = 2 * GDN_QK + GDN_V
ATT_Q = ATT_HEADS * ATT_DH
ATT_KV = ATT_KV_HEADS * ATT_DH
IDX_Q = IDX_HEADS * IDX_DIM
IN_SIZES = (CONV_DIM, GDN_V, GDN_HEADS, GDN_HEADS, ATT_Q, ATT_KV, ATT_KV, IDX_Q, IDX_DIM, IDX_HEADS, D_MODEL, D_MODEL)
IN_DIM = sum(IN_SIZES)

kernel_name = 'hybrid_gdn_dsa_peer_step'


def layer_norm(x, g, b):
    xf = x.astype(jnp.float32)
    mu = xf.mean(-1, keepdims=True)
    var = jnp.square(xf - mu).mean(-1, keepdims=True)
    return ((xf - mu) * lax.rsqrt(var + LN_EPS) * g + b).astype(x.dtype)


def l2norm(x):
    xf = x.astype(jnp.float32)
    return xf * lax.rsqrt(jnp.sum(xf * xf, -1, keepdims=True) + RMS_EPS)


def in_projection(x, w_in):
    offsets = np.cumsum(IN_SIZES)[:-1].tolist()
    return jnp.split(x @ w_in, offsets, axis=-1)


def short_conv(u, prev, conv_w):
    T = u.shape[1]
    up = jnp.concatenate([prev.astype(u.dtype), u], axis=1)
    out = up[:, 0:T] * conv_w[0]
    for i in range(1, CONV_W):
        out = out + up[:, i:i + T] * conv_w[i]
    return jax.nn.silu(out), up[:, -(CONV_W - 1):]


def gdn_features(qkv_pre, conv_prev, b_raw, a_raw, conv_w, a_log, dt_bias):
    qkv, conv_new = short_conv(qkv_pre, conv_prev, conv_w)
    B, T, _ = qkv.shape
    q, k, v = jnp.split(qkv, [GDN_QK, 2 * GDN_QK], axis=-1)
    q = l2norm(q.reshape(B, T, GDN_HEADS, GDN_DK)) * (GDN_DK ** -0.5)
    k = l2norm(k.reshape(B, T, GDN_HEADS, GDN_DK))
    v = v.reshape(B, T, GDN_HEADS, GDN_DV)
    beta = jax.nn.sigmoid(b_raw.astype(jnp.float32))
    log_a = -jnp.exp(a_log.astype(jnp.float32)) * jax.nn.softplus(a_raw.astype(jnp.float32) + dt_bias.astype(jnp.float32))
    return q, k, v, beta, log_a, conv_new


def gdn_chunk(S, q, k, v, beta, log_a):
    f32 = jnp.float32
    q, k, v = (t.astype(f32).transpose(0, 2, 1, 3) for t in (q, k, v))
    beta = beta.astype(f32).transpose(0, 2, 1)
    g = jnp.cumsum(log_a.astype(f32).transpose(0, 2, 1), axis=-1)
    C = q.shape[2]
    incl = jnp.tril(jnp.ones((C, C), dtype=bool))
    strict = jnp.tril(jnp.ones((C, C), dtype=bool), -1)
    dec_incl = jnp.exp(jnp.where(incl, g[..., :, None] - g[..., None, :], -jnp.inf))
    dec_strict = jnp.where(strict, dec_incl, 0.0)
    lower = beta[..., None] * dec_strict * jnp.einsum('bhtd,bhjd->bhtj', k, k)
    eg = jnp.exp(g)[..., None]
    rhs = beta[..., None] * (v - eg * jnp.einsum('bhtd,bhde->bhte', k, S))
    u = lax.linalg.triangular_solve(lower, rhs, left_side=True, lower=True, unit_diagonal=True)
    qk = jnp.einsum('bhtd,bhjd->bhtj', q, k)
    o = eg * jnp.einsum('bhtd,bhde->bhte', q, S) + jnp.einsum('bhtj,bhje->bhte', dec_incl * qk, u)
    g_last = g[..., -1:]
    S_new = jnp.exp(g_last)[..., None] * S + jnp.einsum('bhjd,bhje->bhde', k * jnp.exp(g_last - g)[..., None], u)
    return S_new, o.transpose(0, 2, 1, 3)


def gdn_prompt(q, k, v, beta, log_a):
    B = q.shape[0]
    S0 = jnp.zeros((B, GDN_HEADS, GDN_DK, GDN_DV), jnp.float32)
    S, o_meta = gdn_chunk(S0, q[:, :N_META], k[:, :N_META], v[:, :N_META], beta[:, :N_META], log_a[:, :N_META])

    def chunks(t):
        t = t[:, N_META:]
        return t.reshape(B, -1, GDN_CHUNK, *t.shape[2:]).swapaxes(0, 1)

    S, o_rest = lax.scan(lambda s, c: gdn_chunk(s, *c), S, tuple(chunks(t) for t in (q, k, v, beta, log_a)))
    o_rest = o_rest.swapaxes(0, 1).reshape(B, -1, GDN_HEADS, GDN_DV)
    return jnp.concatenate([o_meta, o_rest], axis=1), S


def gdn_output(o, z, norm_g):
    B, T = o.shape[:2]
    of = o * lax.rsqrt(jnp.mean(o * o, -1, keepdims=True) + RMS_EPS) * norm_g
    zz = z.reshape(B, T, GDN_HEADS, GDN_DV).astype(jnp.float32)
    return (of * jax.nn.silu(zz)).astype(z.dtype).reshape(B, T, GDN_V)


def indexer_scores(qi, ki, wi, qpos, kpos):
    s = jax.nn.relu(jnp.einsum('bqhd,bkd->bqhk', qi, ki).astype(jnp.float32)) * (IDX_DIM ** -0.5)
    I = jnp.einsum('bqhk,bqh->bqk', s, wi.astype(jnp.float32) * (IDX_HEADS ** -0.5))
    return jnp.where(kpos[None, :] <= qpos[:, None], I, -jnp.inf)


def attend_selected(q, k_sel, v_sel, valid):
    B, Q = q.shape[:2]
    qg = q.reshape(B, Q, ATT_KV_HEADS, ATT_HEADS // ATT_KV_HEADS, ATT_DH)
    s = jnp.einsum('bqhgd,bqkhd->bqhgk', qg, k_sel).astype(jnp.float32) * (ATT_DH ** -0.5)
    s = jnp.where(valid[:, :, None, None, :], s, -jnp.inf)
    p = jax.nn.softmax(s, axis=-1).astype(v_sel.dtype)
    o = jnp.einsum('bqhgk,bqkhd->bqhgd', p, v_sel)
    return o.reshape(B, Q, ATT_Q)


def gather_rows(arr, idx):
    return jax.vmap(lambda a, i: a[i])(arr, idx)


def sparse_attn_prompt(q, k, v, qi, ki, wi):
    B, L = q.shape[:2]
    n_sel = min(TOPK_MAX, L // 4)
    n_blk = -(-L // Q_BLOCK)
    pad = n_blk * Q_BLOCK - L

    def blocks(t):
        t = jnp.pad(t, [(0, 0), (0, pad)] + [(0, 0)] * (t.ndim - 2))
        return t.reshape(B, n_blk, Q_BLOCK, *t.shape[2:]).swapaxes(0, 1)

    kpos = jnp.arange(L)
    qpos_all = jnp.arange(n_blk * Q_BLOCK).reshape(n_blk, Q_BLOCK)

    def one_block(args):
        qb, qib, wib, qpos = args
        I = indexer_scores(qib, ki, wib, qpos, kpos)
        _, idx = lax.top_k(I, n_sel)
        valid = idx <= qpos[:, None]
        flat = idx.reshape(B, -1)
        k_sel = gather_rows(k, flat).reshape(B, Q_BLOCK, n_sel, ATT_KV_HEADS, ATT_DH)
        v_sel = gather_rows(v, flat).reshape(B, Q_BLOCK, n_sel, ATT_KV_HEADS, ATT_DH)
        return attend_selected(qb, k_sel, v_sel, valid)

    o = lax.map(one_block, (blocks(q), blocks(qi), blocks(wi), qpos_all))
    return o.swapaxes(0, 1).reshape(B, n_blk * Q_BLOCK, ATT_Q)[:, :L]


def sparse_attn_sample(q, k_new, v_new, qi, ki_new, wi, cache_k, cache_v, cache_ik, page_table):
    DB, T = q.shape[:2]
    past = page_table.shape[1] * PAGE_SIZE
    L = past + T
    n_sel = min(TOPK_MAX, L // 4)
    ki_past = cache_ik[page_table].reshape(DB, past, IDX_DIM).astype(ki_new.dtype)
    ki_all = jnp.concatenate([ki_past, ki_new], axis=1)
    qpos = past + jnp.arange(T)
    I = indexer_scores(qi, ki_all, wi, qpos, jnp.arange(L))
    _, idx = lax.top_k(I, n_sel)
    valid = idx <= qpos[:, None]
    flat = idx.reshape(DB, -1)
    in_past = flat < past
    page = gather_rows(page_table, jnp.minimum(flat, past - 1) // PAGE_SIZE)
    phys = page * PAGE_SIZE + flat % PAGE_SIZE
    new_pos = jnp.clip(flat - past, 0, T - 1)

    def gather(pool, new):
        from_pool = pool.reshape(-1, ATT_KV_HEADS, ATT_DH)[phys].astype(new.dtype)
        from_new = gather_rows(new, new_pos)
        return jnp.where(in_past[:, :, None, None], from_pool, from_new).reshape(DB, T, n_sel, ATT_KV_HEADS, ATT_DH)

    return attend_selected(q, gather(cache_k, k_new), gather(cache_v, v_new), valid)


def peer_ffn(h, peer_wq, peer_subkeys, peer_u, peer_v):
    N = h.shape[0]
    n_blk = -(-N // PEER_TOK_BLOCK)
    hb = jnp.pad(h, ((0, n_blk * PEER_TOK_BLOCK - N), (0, 0))).reshape(n_blk, PEER_TOK_BLOCK, D_MODEL)

    def one_block(xb):
        T = xb.shape[0]
        qry = (xb @ peer_wq).reshape(T, PEER_HEADS, 2, PEER_QDIM // 2)
        s = jnp.einsum('thcd,hcnd->thcn', qry, peer_subkeys).astype(jnp.float32)
        sv, si = lax.top_k(s, PEER_TOPK)
        cand_s = (sv[:, :, 0, :, None] + sv[:, :, 1, None, :]).reshape(T, PEER_HEADS, PEER_TOPK * PEER_TOPK)
        cand_i = (si[:, :, 0, :, None] * PEER_NKEYS + si[:, :, 1, None, :]).reshape(T, PEER_HEADS, PEER_TOPK * PEER_TOPK)
        top_s, pos = lax.top_k(cand_s, PEER_TOPK)
        expert = jnp.take_along_axis(cand_i, pos, axis=-1)
        gate = jax.nn.softmax(top_s, axis=-1)
        act = jax.nn.gelu(jnp.einsum('thkd,td->thk', peer_u[expert], xb).astype(jnp.float32), approximate=False)
        return jnp.einsum('thk,thkd->td', (gate * act).astype(xb.dtype), peer_v[expert])

    return lax.map(one_block, hb).reshape(-1, D_MODEL)[:N]


def finish_layer(x, o_gdn, o_att, ga, gb, w_bg, w_ba, w_out, ln1_g, ln1_b, peer_wq, peer_subkeys, peer_u, peer_v, ln2_g, ln2_b):
    merged = jax.nn.sigmoid(ga) * (o_gdn @ w_bg) + jax.nn.sigmoid(gb) * (o_att @ w_ba)
    h = layer_norm(DN_ALPHA * x + merged @ w_out, ln1_g, ln1_b)
    f = peer_ffn(h.reshape(-1, D_MODEL), peer_wq, peer_subkeys, peer_u, peer_v).reshape(h.shape)
    return layer_norm(DN_ALPHA * h + f, ln2_g, ln2_b)


def setup_inputs(seed: int = 0) -> dict:
    key = jax.random.key(seed)
    ks = iter(jax.random.split(key, 40))
    f32 = jnp.float32

    def nrm(shape, scale):
        return jax.random.normal(next(ks), shape, f32) * scale

    n_pages = PAST_LEN // PAGE_SIZE
    n_used = DEC_BATCH * n_pages
    n_pool = n_used + n_used // 4
    x_prompt = nrm((BATCH, SEQ, D_MODEL), 1.0)
    x_sample = nrm((DEC_BATCH, DEC_SEQ, D_MODEL), 1.0)
    cache_k = nrm((DEPTH, n_pool, PAGE_SIZE, ATT_KV_HEADS, ATT_DH), 1.0)
    cache_v = nrm((DEPTH, n_pool, PAGE_SIZE, ATT_KV_HEADS, ATT_DH), 1.0)
    cache_idx_k = nrm((DEPTH, n_pool, PAGE_SIZE, IDX_DIM), 1.0)
    state_conv = nrm((DEPTH, DEC_BATCH, CONV_W - 1, CONV_DIM), 1.0)
    state_delta = nrm((DEPTH, DEC_BATCH, GDN_HEADS, GDN_DK, GDN_DV), 0.05)
    page_table = jax.random.permutation(next(ks), n_pool)[:n_used].reshape(DEC_BATCH, n_pages).astype(jnp.int32)
    meta_tokens = nrm((N_META, D_MODEL), 1.0)
    w_in = nrm((DEPTH, D_MODEL, IN_DIM), D_MODEL ** -0.5)
    conv_w = nrm((DEPTH, CONV_W, CONV_DIM), CONV_W ** -0.5)
    a_log = jnp.log(jax.random.uniform(next(ks), (DEPTH, GDN_HEADS), f32, 1.0, 16.0))
    dt = jnp.exp(jax.random.uniform(next(ks), (DEPTH, GDN_HEADS), f32, math.log(1e-3), math.log(1e-1)))
    dt_bias = dt + jnp.log(-jnp.expm1(-dt))
    gdn_norm_g = 1.0 + nrm((DEPTH, GDN_DV), 0.02)
    w_branch_gdn = nrm((DEPTH, GDN_V, D_MODEL), GDN_V ** -0.5)
    w_branch_attn = nrm((DEPTH, ATT_Q, D_MODEL), ATT_Q ** -0.5)
    w_out = nrm((DEPTH, D_MODEL, D_MODEL), DN_BETA * D_MODEL ** -0.5)
    ln1_g = 1.0 + nrm((DEPTH, D_MODEL), 0.02)
    ln1_b = nrm((DEPTH, D_MODEL), 0.02)
    peer_wq = nrm((DEPTH, D_MODEL, PEER_HEADS * PEER_QDIM), D_MODEL ** -0.5)
    peer_subkeys = nrm((DEPTH, PEER_HEADS, 2, PEER_NKEYS, PEER_QDIM // 2), (PEER_QDIM // 2) ** -0.5)
    peer_u = nrm((DEPTH, PEER_EXPERTS, D_MODEL), D_MODEL ** -0.5)
    peer_v = nrm((DEPTH, PEER_EXPERTS, D_MODEL), DN_BETA * PEER_HEADS ** -0.5)
    ln2_g = 1.0 + nrm((DEPTH, D_MODEL), 0.02)
    ln2_b = nrm((DEPTH, D_MODEL), 0.02)
    return {'x_prompt': x_prompt, 'x_sample': x_sample, 'cache_k': cache_k, 'cache_v': cache_v,
            'cache_idx_k': cache_idx_k, 'state_conv': state_conv, 'state_delta': state_delta,
            'page_table': page_table, 'meta_tokens': meta_tokens, 'w_in': w_in, 'conv_w': conv_w,
            'a_log': a_log, 'dt_bias': dt_bias, 'gdn_norm_g': gdn_norm_g, 'w_branch_gdn': w_branch_gdn,
            'w_branch_attn': w_branch_attn, 'w_out': w_out, 'ln1_g': ln1_g, 'ln1_b': ln1_b,
            'peer_wq': peer_wq, 'peer_subkeys': peer_subkeys, 'peer_u': peer_u, 'peer_v': peer_v,
            'ln2_g': ln2_g, 'ln2_b': ln2_b}


def reference(x_prompt, x_sample, cache_k, cache_v, cache_idx_k, state_conv, state_delta, page_table,
              meta_tokens, w_in, conv_w, a_log, dt_bias, gdn_norm_g, w_branch_gdn, w_branch_attn, w_out,
              ln1_g, ln1_b, peer_wq, peer_subkeys, peer_u, peer_v, ln2_g, ln2_b):
    B = x_prompt.shape[0]
    DB, T = x_sample.shape[:2]
    hp = jnp.concatenate([jnp.broadcast_to(meta_tokens[None].astype(x_prompt.dtype), (B, N_META, D_MODEL)), x_prompt], axis=1)
    hs = x_sample
    Lp = hp.shape[1]
    p_conv_l, p_delta_l, p_k_l, p_v_l, p_ik_l = [], [], [], [], []
    s_conv_l, s_delta_l, s_k_l, s_v_l, s_ik_l = [], [], [], [], []
    for l in range(DEPTH):
        qkv_pre, z, b_raw, a_raw, aq, ak, av, iq, ik, iw, ga, gb = in_projection(hp, w_in[l])
        zero_prev = jnp.zeros((B, CONV_W - 1, CONV_DIM), hp.dtype)
        q, k, v, beta, log_a, p_conv = gdn_features(qkv_pre, zero_prev, b_raw, a_raw, conv_w[l], a_log[l], dt_bias[l])
        o_gdn, p_S = gdn_prompt(q, k, v, beta, log_a)
        o_gdn = gdn_output(o_gdn, z, gdn_norm_g[l])
        pk = ak.reshape(B, Lp, ATT_KV_HEADS, ATT_DH)
        pv = av.reshape(B, Lp, ATT_KV_HEADS, ATT_DH)
        o_att = sparse_attn_prompt(aq.reshape(B, Lp, ATT_HEADS, ATT_DH), pk, pv,
                                   iq.reshape(B, Lp, IDX_HEADS, IDX_DIM), ik, iw)
        hp = finish_layer(hp, o_gdn, o_att, ga, gb, w_branch_gdn[l], w_branch_attn[l], w_out[l], ln1_g[l], ln1_b[l],
                          peer_wq[l], peer_subkeys[l], peer_u[l], peer_v[l], ln2_g[l], ln2_b[l])
        p_conv_l.append(p_conv)
        p_delta_l.append(p_S.astype(state_delta.dtype))
        p_k_l.append(pk)
        p_v_l.append(pv)
        p_ik_l.append(ik)
        qkv_pre, z, b_raw, a_raw, aq, ak, av, iq, ik, iw, ga, gb = in_projection(hs, w_in[l])
        q, k, v, beta, log_a, s_conv = gdn_features(qkv_pre, state_conv[l], b_raw, a_raw, conv_w[l], a_log[l], dt_bias[l])
        s_S, o_gdn = gdn_chunk(state_delta[l].astype(jnp.float32), q, k, v, beta, log_a)
        o_gdn = gdn_output(o_gdn, z, gdn_norm_g[l])
        sk = ak.reshape(DB, T, ATT_KV_HEADS, ATT_DH)
        sv = av.reshape(DB, T, ATT_KV_HEADS, ATT_DH)
        o_att = sparse_attn_sample(aq.reshape(DB, T, ATT_HEADS, ATT_DH), sk, sv,
                                   iq.reshape(DB, T, IDX_HEADS, IDX_DIM), ik, iw,
                                   cache_k[l], cache_v[l], cache_idx_k[l], page_table)
        hs = finish_layer(hs, o_gdn, o_att, ga, gb, w_branch_gdn[l], w_branch_attn[l], w_out[l], ln1_g[l], ln1_b[l],
                          peer_wq[l], peer_subkeys[l], peer_u[l], peer_v[l], ln2_g[l], ln2_b[l])
        s_conv_l.append(s_conv)
        s_delta_l.append(s_S.astype(state_delta.dtype))
        s_k_l.append(sk)
        s_v_l.append(sv)
        s_ik_l.append(ik)
    y_prompt = hp[:, N_META:]
    y_sample = hs
    p_conv = jnp.stack(p_conv_l)
    p_delta = jnp.stack(p_delta_l)
    p_k = jnp.stack(p_k_l)
    p_v = jnp.stack(p_v_l)
    p_idx_k = jnp.stack(p_ik_l)
    s_conv = jnp.stack(s_conv_l)
    s_delta = jnp.stack(s_delta_l)
    s_k = jnp.stack(s_k_l)
    s_v = jnp.stack(s_v_l)
    s_idx_k = jnp.stack(s_ik_l)
    return (y_prompt, y_sample, p_conv, p_delta, p_k, p_v, p_idx_k, s_conv, s_delta, s_k, s_v, s_idx_k)
```

```cpp
#include <hip/hip_runtime.h>
#include <stdint.h>
#include <stdio.h>

#define LAS __attribute__((address_space(3)))
typedef unsigned short bf16_t;
typedef short bf16x8 __attribute__((ext_vector_type(8)));
typedef float f32x4 __attribute__((ext_vector_type(4)));
typedef unsigned u32x4 __attribute__((ext_vector_type(4)));
typedef unsigned u32x2 __attribute__((ext_vector_type(2)));

constexpr int D = 1024, NB = 8, SEQ = 2048, NMETA = 16, LP = 2064, DBATCH = 128, TS = 8, PAST = 2048, PAGE = 128, NPAGES = 16;
constexpr int MP = NB * LP  , MS = DBATCH * TS  , MR = MP + MS  , MPAD = 17664;
constexpr int NIN = 8800, NPAD = 8960;
constexpr int GH = 8, GDK = 128, GDV = 128, CONVD = 3072;
constexpr int AH = 8, AKV = 2, ADH = 128, IH = 16, IDIM = 64, TOPK = 256;
constexpr int PH = 8, PNK = 128, PQD = 256, PTOPK = 16, NEXP = 16384;
constexpr float DN_ALPHA = 1.189207115002721f;
constexpr float LN_EPS = 1e-5f, RMS_EPS = 1e-6f;
constexpr int C_QKV = 0, C_Z = 3072, C_AQ = 4096, C_AK = 5120, C_AV = 5376, C_IQ = 5632, C_GA = 6656, C_GB = 7680, C_IK = 8704, C_IW = 8768, C_BETA = 8784, C_A = 8792;
constexpr long O_YP = 0, O_YS = 16777216, O_PCONV = 17825792, O_PDELTA = 17899520, O_PK = 18948096, O_PV = 23175168, O_PIK = 27402240,
               O_SCONV = 28459008, O_SDELTA = 29638656, O_SK = 46415872, O_SV = 46678016, O_SIK = 46940160;
constexpr int NCHUNK = 33;
constexpr int BLOB64 = 81920, BLOB16 = 32768;

struct Params {
    const float *x_prompt, *x_sample, *cache_k, *cache_v, *cache_ik, *state_conv, *state_delta; const int* page_table;
    const float *meta, *w_in, *conv_w, *a_log, *dt_bias, *gnorm, *w_bg, *w_ba, *w_out, *ln1_g, *ln1_b, *peer_wq, *peer_sub, *peer_u, *peer_v, *ln2_g, *ln2_b;
    float* out;
    unsigned* bar;
    bf16_t *XB, *WINT, *WBGT, *WBAT, *WOUTT, *WQT, *SUBK, *PU, *PV, *PARTS;
    float* SMALL;
    unsigned char *GOPS, *GOPS_S;
    bf16_t *ORAW, *OGDN, *OATT;
    unsigned long long* MASK;
    float* TMPA; bf16_t* MERGED; float* V1; bf16_t* HB; bf16_t* QRY;
    unsigned short* EIDX; float* EGATE;
};

__device__ __forceinline__ bf16_t f2bf(float f) { unsigned u = __float_as_uint(f); u += 0x7FFFu + ((u >> 16) & 1u); return (bf16_t)(u >> 16); }
__device__ __forceinline__ float bf2f(bf16_t b) { return __uint_as_float(((unsigned)b) << 16); }
__device__ __forceinline__ unsigned pk2(float lo, float hi) { return (unsigned)f2bf(lo) | ((unsigned)f2bf(hi) << 16); }
__device__ __forceinline__ float bflo(unsigned w) { return __uint_as_float(w << 16); }
__device__ __forceinline__ float bfhi(unsigned w) { return __uint_as_float(w & 0xFFFF0000u); }
__device__ __forceinline__ float sigmoidf_(float x) { return 1.0f / (1.0f + __expf(-x)); }
__device__ __forceinline__ float wave_sum(float v) {
#pragma unroll
    for (int o = 1; o < 64; o <<= 1) v += __shfl_xor(v, o);
    return v;
}
__device__ __forceinline__ float wave_max(float v) {
#pragma unroll
    for (int o = 1; o < 64; o <<= 1) v = fmaxf(v, __shfl_xor(v, o));
    return v;
}
__device__ __forceinline__ const float* xrow_ptr(const Params& p, int row) {
    if (row < MP) { const int b = row / LP, t = row - b * LP; return t < NMETA ? p.meta + (size_t)t * D : p.x_prompt + ((size_t)b * SEQ + (t - NMETA)) * D; }
    if (row < MR) return p.x_sample + (size_t)(row - MP) * D;
    return nullptr;
}

#define XB_TMO      128
#define XB_XCNT(j)  (256  + 64 * (j))
#define XB_XSUB(j)  (1280 + 64 * (j))
#define XB_XGEN(j)  (2304 + 64 * (j))
#define XB_TOP      3328
#define XB_TOPGEN   3392
#define XCD_BAR_WORDS 3456
#define XB_SPIN_CAP (1u << 22)

__device__ __forceinline__ unsigned xb_ld(unsigned* p)              { return __hip_atomic_load(p, __ATOMIC_RELAXED, __HIP_MEMORY_SCOPE_AGENT); }
__device__ __forceinline__ unsigned xb_add(unsigned* p, unsigned v) { return __hip_atomic_fetch_add(p, v, __ATOMIC_RELAXED, __HIP_MEMORY_SCOPE_AGENT); }
__device__ __forceinline__ unsigned xb_xcc_id() { return (unsigned)__builtin_amdgcn_s_getreg((3 << 11) | 20) & 0xFu; }
#define XB_SPIN(cond, bar) do { unsigned _sp = 0; while (cond) { __builtin_amdgcn_s_sleep(1); \
    if ((++_sp & 255u) == 0u) { if (xb_ld(&(bar)[XB_TMO])) break; if (_sp > XB_SPIN_CAP) { atomicAdd(&(bar)[XB_TMO], 1u); break; } } } } while (0)

struct XcdBarrier { unsigned* bar; unsigned x; volatile LAS unsigned* st; };

__device__ __forceinline__ XcdBarrier xcd_barrier_post(unsigned* bar, volatile LAS unsigned* st) {
    XcdBarrier b; b.bar = bar; b.x = xb_xcc_id(); b.st = st;
    if (threadIdx.x == 0) (void)xb_add(&bar[XB_XCNT(b.x)], 1u);
    return b;
}
__device__ __forceinline__ void xcd_barrier_complete(unsigned* bar, unsigned x, unsigned& nloc, unsigned& nx) {
    const unsigned G = gridDim.x * gridDim.y * gridDim.z;
    unsigned sum, cnt, mine, sp = 0u;
    for (;;) {
        sum = 0u; cnt = 0u; mine = 0u;
#pragma unroll
        for (unsigned j = 0; j < 16; ++j) { const unsigned c = xb_ld(&bar[XB_XCNT(j)]); sum += c; cnt += (c > 0u) ? 1u : 0u; mine = (j == x) ? c : mine; }
        if (sum == G) break;
        __builtin_amdgcn_s_sleep(1);
        if ((++sp & 255u) == 0u) { if (xb_ld(&bar[XB_TMO])) break; if (sp > XB_SPIN_CAP) { atomicAdd(&bar[XB_TMO], 1u); break; } }
    }
    nloc = mine > 0u ? mine : 1u; nx = cnt > 0u ? cnt : 1u;
}
__device__ __forceinline__ void xcd_barrier(const XcdBarrier& b) {
    asm volatile("s_waitcnt vmcnt(0)" ::: "memory");
    __syncthreads();
    if (threadIdx.x == 0) {
        unsigned* bar = b.bar;
        __builtin_amdgcn_s_waitcnt(0);
        unsigned nloc = b.st[0], nx = b.st[1];
        if (nloc == 0u) { xcd_barrier_complete(bar, b.x, nloc, nx); b.st[0] = nloc; b.st[1] = nx; }
        const unsigned old = xb_add(&bar[XB_XSUB(b.x)], 1u);
        const unsigned gen = old / nloc;
        if (old + 1u == (gen + 1u) * nloc) {
            __builtin_amdgcn_fence(__ATOMIC_RELEASE, "agent");
            asm volatile("s_waitcnt vmcnt(0)" ::: "memory");
            const unsigned og = xb_add(&bar[XB_TOP], 1u);
            const unsigned tg = og / nx;
            if (og + 1u == (tg + 1u) * nx) xb_add(&bar[XB_TOPGEN], 1u);
            else XB_SPIN(xb_ld(&bar[XB_TOPGEN]) == tg, bar);
            __builtin_amdgcn_fence(__ATOMIC_ACQUIRE, "agent");
            xb_add(&bar[XB_XGEN(b.x)], 1u);
            asm volatile("s_waitcnt vmcnt(0)" ::: "memory");
        } else {
            XB_SPIN(xb_ld(&bar[XB_XGEN(b.x)]) == gen, bar);
            __builtin_amdgcn_fence(__ATOMIC_ACQUIRE, "agent");
            asm volatile("s_waitcnt vmcnt(0)" ::: "memory");
        }
    }
    __syncthreads();
}

namespace pg8 {
#define PG8_LAS __attribute__((address_space(3)))
typedef unsigned short bf16_t;
typedef short bf16x8 __attribute__((ext_vector_type(8)));
typedef float f32x4 __attribute__((ext_vector_type(4)));
typedef unsigned u32x4 __attribute__((ext_vector_type(4)));
constexpr int BM = 256, BK = 64, HALF = 128, HTB = HALF * BK * 2  , STAGE_BYTES = 8 * HTB, NXCD = 8, WGM = 8;

__host__ __device__ __forceinline__ int lds_byte(int r, int c) { const int st = (r >> 4) * 2 + (c >> 5), rr = r & 15, cc = c & 31, ob = rr * 64 + cc * 2; return st * 1024 + (ob ^ (((ob >> 9) & 1) << 5)); }
__host__ __device__ __forceinline__ void stage_rc(int b, int& R, int& C) { const int st = b / 1024, sb = b % 1024, swz = sb ^ (((sb >> 9) & 1) << 5); R = (st >> 1) * 16 + swz / 64; C = (st & 1) * 32 + (swz % 64) / 2; }
__host__ __device__ __forceinline__ int perm32(int rho) { const int n = rho >> 4, i = rho & 15; return 8 * (i >> 2) + 4 * n + (i & 3); }

struct Unit { int pm, pn; };
struct Gemm { const bf16_t* A; const bf16_t* Bt; int M, N, K; };

struct StaticOrder {
    int nM, nN, nwg, G, c;
    __host__ __device__ void init(int M, int N, int G_, int c_) { nM = M / BM; nN = N / BM; nwg = nM * nN; G = G_; c = c_; }
    __host__ __device__ bool next(int i, Unit& u) const {
        const long L = (long)i * G + c; if (L >= nwg) return false;
        int wgid = (int)L; { const int q = nwg / NXCD, r = nwg % NXCD, xcd = wgid % NXCD, off = wgid / NXCD; wgid = (xcd < r ? xcd * (q + 1) : r * (q + 1) + (xcd - r) * q) + off; }
        const int nig = WGM * nN, gid = wgid / nig, fm = gid * WGM, gsz = (nM - fm) < WGM ? (nM - fm) : WGM;
        u.pm = fm + ((wgid % nig) % gsz); u.pn = (wgid % nig) / gsz; return true;
    }
    __device__ __forceinline__ void a_ready(const Unit&) const {}
    __device__ __forceinline__ void done(const Unit&) const {}
};
__device__ __forceinline__ unsigned cvt_pk_bf16(float lo, float hi) { unsigned r; asm volatile("v_cvt_pk_bf16_f32 %0, %1, %2" : "=v"(r) : "v"(lo), "v"(hi)); return r; }
typedef float f32x2 __attribute__((ext_vector_type(2)));
template <class Epi, class Sched, bool STAMP = false>
__device__ __forceinline__ void gemm_phase(PG8_LAS unsigned char* lds, const Gemm g, const Sched& S, const Epi& E, unsigned long long* stamps) {
    const int tid = threadIdx.x, wid = __builtin_amdgcn_readfirstlane(tid >> 6), lane = tid & 63, wr = wid >> 2, wc = wid & 3, fr = lane & 15, fq = lane >> 4;
    const int K = g.K, nt = K / BK;
    int ts_lo = 0, ts_hi = 0, nts = 0; const unsigned long long rt_entry = STAMP ? (unsigned long long)wall_clock64() : 0ull;
#define PG8_STAMP() do { if (STAMP && wid == 0 && nts < 64) { const unsigned long long _c = (unsigned long long)clock64(); \
        ts_lo = (lane == nts) ? (int)(unsigned)_c : ts_lo; ts_hi = (lane == nts) ? (int)(unsigned)(_c >> 32) : ts_hi; ++nts; } } while (0)
    PG8_STAMP();
    unsigned voffA[2], voffB[2];
#pragma unroll
    for (int i = 0; i < 2; ++i) { int R, C; stage_rc(tid * 16 + i * 8192, R, C); const int Rb = Epi::PERM ? ((R & ~31) + perm32(R & 31)) : R;
        voffA[i] = (unsigned)(R * K + C) * 2u; voffB[i] = (unsigned)(Rb * K + C) * 2u; }
    const size_t kstep = (size_t)(BK * 2);
    const size_t hstep = (size_t)HALF * K * 2;
    const size_t tstep = 2 * hstep;
    const unsigned ldsw = (unsigned)wid * 1024u;
    const int aoff = lds_byte(wr * 64 + fr, fq * 8), boff = lds_byte(wc * 32 + fr, fq * 8);
#define PG8_SA(b, h) (((b) * 2 + (h)) * HTB)
#define PG8_SB(b, h) ((4 + (b) * 2 + (h)) * HTB)
#define PG8_STAGE(bufoff, gbase, voff) do { _Pragma("unroll") for (int _i = 0; _i < 2; ++_i) \
        __builtin_amdgcn_global_load_lds((const unsigned*)((const char*)(gbase) + (voff)[_i]), (PG8_LAS unsigned*)(lds + (bufoff) + ldsw + _i * 8192), 16, 0, 0); } while (0)
#define PG8_LDA(dst, b, h) do { _Pragma("unroll") for (int m = 0; m < 4; ++m) _Pragma("unroll") for (int k = 0; k < 2; ++k) dst[m][k] = *(const PG8_LAS bf16x8*)(lds + PG8_SA(b, h) + aoff + m * 2048 + k * 1024); } while (0)
#define PG8_LDB(dst, b, h) do { _Pragma("unroll") for (int n = 0; n < 2; ++n) _Pragma("unroll") for (int k = 0; k < 2; ++k) dst[n][k] = *(const PG8_LAS bf16x8*)(lds + PG8_SB(b, h) + boff + n * 2048 + k * 1024); } while (0)
#define PG8_MMA(ai, bj, At, Bt) do { __builtin_amdgcn_s_setprio(1); _Pragma("unroll") for (int m = 0; m < 4; ++m) _Pragma("unroll") for (int n = 0; n < 2; ++n) _Pragma("unroll") for (int k = 0; k < 2; ++k) \
        acc[ai][bj][m][n] = __builtin_amdgcn_mfma_f32_16x16x32_bf16(Bt[n][k], At[m][k], acc[ai][bj][m][n], 0, 0, 0); __builtin_amdgcn_s_setprio(0); } while (0)
#define PG8_WAIT_V(n) asm volatile("s_waitcnt vmcnt(" #n ")" ::: "memory")
#define PG8_WAIT_L(n) asm volatile("s_waitcnt lgkmcnt(" #n ")" ::: "memory")
#define PG8_BAR __builtin_amdgcn_s_barrier()
#define PG8_SCHED __builtin_amdgcn_sched_barrier(0)
    Unit cur, nxt; int ui = 0;
    if (!S.next(0, cur)) return;
    f32x4 acc[2][2][4][2];
#pragma unroll
    for (int a = 0; a < 2; ++a)
#pragma unroll
        for (int b = 0; b < 2; ++b)
#pragma unroll
            for (int m = 0; m < 4; ++m)
#pragma unroll
                for (int n = 0; n < 2; ++n) acc[a][b][m][n] = (f32x4){0.f, 0.f, 0.f, 0.f};
    bf16x8 At[4][2], B0[2][2], B1[2][2];
    const char* cA = (const char*)g.A + (size_t)cur.pm * tstep; const char* cB = (const char*)g.Bt + (size_t)cur.pn * tstep;
    S.a_ready(cur);
    PG8_STAGE(PG8_SB(0, 0), cB, voffB); PG8_STAGE(PG8_SA(0, 0), cA, voffA); PG8_STAGE(PG8_SB(0, 1), cB + hstep, voffB); PG8_STAGE(PG8_SA(0, 1), cA + hstep, voffA);
    if (wr == 1) PG8_BAR;
    PG8_WAIT_V(4); PG8_BAR;
    PG8_STAGE(PG8_SB(1, 0), cB + kstep, voffB); PG8_STAGE(PG8_SA(1, 0), cA + kstep, voffA); PG8_STAGE(PG8_SB(1, 1), cB + hstep + kstep, voffB);
    PG8_WAIT_V(6); PG8_BAR;
    PG8_STAMP();
    for (;;) {
        const bool has_next = S.next(ui + 1, nxt);
        const char* nA = has_next ? (const char*)g.A + (size_t)nxt.pm * tstep : cA; const char* nB = has_next ? (const char*)g.Bt + (size_t)nxt.pn * tstep : cB;
        for (int t = 0; t < nt; t += 2) {
            const bool last = (t == nt - 2);
            const char* a1 = cA + (size_t)(t + 1) * kstep;
            const char* a2 = last ? nA : cA + (size_t)(t + 2) * kstep; const char* b2 = last ? nB : cB + (size_t)(t + 2) * kstep;
            const char* a3 = a2 + kstep; const char* b3 = b2 + kstep;
            if (last && has_next) S.a_ready(nxt);
            PG8_LDB(B0, 0, 0); PG8_SCHED; PG8_LDA(At, 0, 0); PG8_STAGE(PG8_SA(1, 1), a1 + hstep, voffA);
            PG8_WAIT_L(8); PG8_BAR; PG8_WAIT_L(0); PG8_MMA(0, 0, At, B0); PG8_BAR; PG8_SCHED;
            PG8_LDB(B1, 0, 1); PG8_STAGE(PG8_SB(0, 0), b2, voffB);
            PG8_BAR; PG8_WAIT_L(0); PG8_MMA(0, 1, At, B1); PG8_BAR;
            PG8_LDA(At, 0, 1); PG8_STAGE(PG8_SA(0, 0), a2, voffA);
            PG8_BAR; PG8_WAIT_L(0); PG8_MMA(1, 0, At, B0); PG8_BAR; PG8_SCHED;
            PG8_STAGE(PG8_SB(0, 1), b2 + hstep, voffB);
            PG8_WAIT_V(6); PG8_BAR; PG8_MMA(1, 1, At, B1); PG8_BAR;
            PG8_LDB(B0, 1, 0); PG8_SCHED; PG8_LDA(At, 1, 0); PG8_STAGE(PG8_SA(0, 1), a2 + hstep, voffA);
            PG8_WAIT_L(8); PG8_BAR; PG8_WAIT_L(0); PG8_MMA(0, 0, At, B0); PG8_BAR; PG8_SCHED;
            PG8_LDB(B1, 1, 1); PG8_STAGE(PG8_SB(1, 0), b3, voffB);
            PG8_BAR; PG8_WAIT_L(0); PG8_MMA(0, 1, At, B1); PG8_BAR;
            PG8_LDA(At, 1, 1); PG8_STAGE(PG8_SA(1, 0), a3, voffA);
            PG8_BAR; PG8_WAIT_L(0); PG8_MMA(1, 0, At, B0); PG8_BAR; PG8_SCHED;
            PG8_STAGE(PG8_SB(1, 1), b3 + hstep, voffB);
            PG8_WAIT_V(6); PG8_BAR; PG8_MMA(1, 1, At, B1); PG8_BAR;
        }
        PG8_STAMP();
        if constexpr (!Epi::AFTER_DRAIN) { E(acc, cur, wr, wc, fr, fq); S.done(cur); }
        PG8_STAMP();
        if (!has_next) break;
#pragma unroll
        for (int a = 0; a < 2; ++a)
#pragma unroll
            for (int b = 0; b < 2; ++b)
#pragma unroll
                for (int m = 0; m < 4; ++m)
#pragma unroll
                    for (int n = 0; n < 2; ++n) acc[a][b][m][n] = (f32x4){0.f, 0.f, 0.f, 0.f};
        cur = nxt; cA = nA; cB = nB; ++ui;
    }
    PG8_WAIT_V(0);
    if (wr == 0) PG8_BAR;
    PG8_BAR;
    if constexpr (Epi::AFTER_DRAIN) { E.fused(acc, cur, wr, wc, fr, fq, lds, wid, lane); S.done(cur); }
    PG8_STAMP();
    if (STAMP && wid == 0) { stamps[lane] = lane < nts ? (((unsigned long long)(unsigned)ts_hi << 32) | (unsigned)ts_lo) : 0ull;
        if (lane == 62) stamps[62] = rt_entry; if (lane == 63) stamps[63] = (unsigned long long)wall_clock64(); }
#undef PG8_STAMP
#undef PG8_SA
#undef PG8_SB
#undef PG8_STAGE
#undef PG8_LDA
#undef PG8_LDB
#undef PG8_MMA
#undef PG8_WAIT_V
#undef PG8_WAIT_L
#undef PG8_BAR
#undef PG8_SCHED
}
}

__device__ __forceinline__ int win_src_col(int n) {
    if (n < 4096) return n;
    if (n < C_GA) return n + 16;
    if (n < C_IK) return n + 96;
    if (n < C_IW) return 6672 + (n - C_IK);
    if (n < C_BETA) return 6736 + (n - C_IW);
    if (n < C_A) return 4096 + (n - C_BETA);
    if (n < NIN) return 4104 + (n - C_A);
    return -1;
}
template <bool PERMUTE>
__device__ __forceinline__ void transpose_item(const float* W, int ldw, bf16_t* WT, int k0, int n0, LAS float* tile) {
    const int tid = threadIdx.x, j = tid & 63, i0 = tid >> 6;
    const int sc = PERMUTE ? win_src_col(n0 + j) : (n0 + j);
#pragma unroll
    for (int m = 0; m < 8; ++m) { const int i = i0 + 8 * m; tile[i * 65 + j] = sc >= 0 ? W[(size_t)(k0 + i) * ldw + sc] : 0.f; }
    __syncthreads();
    const int jn = tid >> 3, c = tid & 7;
    u32x4 o;
    o.x = pk2(tile[(8 * c + 0) * 65 + jn], tile[(8 * c + 1) * 65 + jn]); o.y = pk2(tile[(8 * c + 2) * 65 + jn], tile[(8 * c + 3) * 65 + jn]);
    o.z = pk2(tile[(8 * c + 4) * 65 + jn], tile[(8 * c + 5) * 65 + jn]); o.w = pk2(tile[(8 * c + 6) * 65 + jn], tile[(8 * c + 7) * 65 + jn]);
    *(u32x4*)(WT + (size_t)(n0 + jn) * 1024 + k0 + 8 * c) = o;
    __syncthreads();
}
__device__ __forceinline__ void cvt_stream(const float* src, bf16_t* dst, long n8) {
    for (long it = (long)blockIdx.x * 512 + threadIdx.x; it < n8; it += (long)gridDim.x * 512) {
        const f32x4 a = *(const f32x4*)(src + it * 8), b = *(const f32x4*)(src + it * 8 + 4);
        u32x4 o; o.x = pk2(a.x, a.y); o.y = pk2(a.z, a.w); o.z = pk2(b.x, b.y); o.w = pk2(b.z, b.w);
        *(u32x4*)(dst + it * 8) = o;
    }
}
__device__ __forceinline__ void phase0(const Params& p, LAS unsigned char* lds) {
    for (long it = (long)blockIdx.x * 512 + threadIdx.x; it < (long)MPAD * 128; it += (long)gridDim.x * 512) {
        const int row = (int)(it >> 7), c8 = (int)(it & 127) * 8;
        const float* src = xrow_ptr(p, row);
        u32x4 o = {0u, 0u, 0u, 0u};
        if (src) { const f32x4 a = *(const f32x4*)(src + c8), b = *(const f32x4*)(src + c8 + 4); o.x = pk2(a.x, a.y); o.y = pk2(a.z, a.w); o.z = pk2(b.x, b.y); o.w = pk2(b.z, b.w); }
        *(u32x4*)(p.XB + (size_t)row * D + c8) = o;
    }
    LAS float* tile = (LAS float*)lds;
    constexpr int I_IN = 16 * (NPAD / 64), I_SQ = 16 * 16, I_WQ = 16 * 32, NIT = I_IN + 3 * I_SQ + I_WQ;
    for (int it = blockIdx.x; it < NIT; it += gridDim.x) {
        int r = it;
        if (r < I_IN) { transpose_item<true>(p.w_in, NIN, p.WINT, (r & 15) * 64, (r >> 4) * 64, tile); continue; } r -= I_IN;
        if (r < I_SQ) { transpose_item<false>(p.w_bg, D, p.WBGT, (r & 15) * 64, (r >> 4) * 64, tile); continue; } r -= I_SQ;
        if (r < I_SQ) { transpose_item<false>(p.w_ba, D, p.WBAT, (r & 15) * 64, (r >> 4) * 64, tile); continue; } r -= I_SQ;
        if (r < I_SQ) { transpose_item<false>(p.w_out, D, p.WOUTT, (r & 15) * 64, (r >> 4) * 64, tile); continue; } r -= I_SQ;
        transpose_item<false>(p.peer_wq, 2048, p.WQT, (r & 15) * 64, (r >> 4) * 64, tile);
    }
    cvt_stream(p.peer_sub, p.SUBK, (long)16 * 128 * 128 / 8);
    cvt_stream(p.peer_u, p.PU, (long)NEXP * D / 8);
    cvt_stream(p.peer_v, p.PV, (long)NEXP * D / 8);
}

struct EpiInProj {
    static constexpr bool PERM = true, AFTER_DRAIN = false;
    bf16_t* parts; float* out; float* small_;
    __device__ __forceinline__ void operator()(const pg8::f32x4 (&acc)[2][2][4][2], const pg8::Unit& u, int wr, int wc, int fr, int fq) const {
        const int row0 = u.pm * 256 + wr * 64 + fr, col0 = u.pn * 256 + wc * 32 + 8 * fq;
#pragma unroll
        for (int ai = 0; ai < 2; ++ai)
#pragma unroll
            for (int m = 0; m < 4; ++m) {
                const int row = row0 + ai * 128 + m * 16;
#pragma unroll
                for (int bj = 0; bj < 2; ++bj) {
                    const int col = col0 + bj * 128;
                    const pg8::f32x4 v0 = acc[ai][bj][m][0], v1 = acc[ai][bj][m][1];
                    u32x4 w; w.x = pg8::cvt_pk_bf16(v0[0], v0[1]); w.y = pg8::cvt_pk_bf16(v0[2], v0[3]); w.z = pg8::cvt_pk_bf16(v1[0], v1[1]); w.w = pg8::cvt_pk_bf16(v1[2], v1[3]);
                    *(u32x4*)(parts + (size_t)row * NPAD + col) = w;
                    if (u.pn == 20 || u.pn == 21) {
                        if (row < MR) {
                            const int c = col - u.pn * 256;
                            float* dst = (row < MP) ? out + (u.pn == 20 ? O_PK : O_PV) + (size_t)row * 256 + c : out + (u.pn == 20 ? O_SK : O_SV) + (size_t)(row - MP) * 256 + c;
                            *(pg8::f32x4*)dst = v0; *(pg8::f32x4*)(dst + 4) = v1;
                        }
                    } else if (u.pn == 34) {
                        const int c = col - C_IK;
                        if (c < 64) {
                            if (row < MR) { float* dst = (row < MP) ? out + O_PIK + (size_t)row * 64 + c : out + O_SIK + (size_t)(row - MP) * 64 + c; *(pg8::f32x4*)dst = v0; *(pg8::f32x4*)(dst + 4) = v1; }
                        } else if (c < 96) { float* dst = small_ + (size_t)row * 32 + (c - 64); *(pg8::f32x4*)dst = v0; *(pg8::f32x4*)(dst + 4) = v1; }
                    }
                }
            }
    }
};
__device__ __forceinline__ void phase1(const Params& p, LAS unsigned char* lds) {
    pg8::Gemm g; g.A = p.XB; g.Bt = p.WINT; g.M = MPAD; g.N = NPAD; g.K = D;
    pg8::StaticOrder S; S.init(MPAD, NPAD, gridDim.x, blockIdx.x);
    EpiInProj E; E.parts = p.PARTS; E.out = p.out; E.small_ = p.SMALL;
    pg8::gemm_phase<EpiInProj, pg8::StaticOrder, false>(lds, g, S, E, nullptr);
}

template <int K>
__device__ __forceinline__ f32x4 mm_tile(const LAS bf16_t* A, int sa, const LAS bf16_t* Bt, int sb, int m0, int n0, f32x4 acc, int lane) {
    const int r = lane & 15, q = lane >> 4;
    const LAS bf16_t* ap = A + (m0 + r) * sa + 8 * q;
    const LAS bf16_t* bp = Bt + (n0 + r) * sb + 8 * q;
#pragma unroll
    for (int ks = 0; ks < K / 32; ++ks) {
        const bf16x8 a = *(const LAS bf16x8*)(ap + ks * 32);
        const bf16x8 b = *(const LAS bf16x8*)(bp + ks * 32);
        acc = __builtin_amdgcn_mfma_f32_16x16x32_bf16(a, b, acc, 0, 0, 0);
    }
    return acc;
}
__device__ __forceinline__ void st4_bf16(LAS bf16_t* p, f32x4 v) { u32x2 w; w.x = pk2(v[0], v[1]); w.y = pk2(v[2], v[3]); *(LAS u32x2*)p = w; }
__device__ __forceinline__ void st4_bf16_g(bf16_t* p, f32x4 v) { u32x2 w; w.x = pk2(v[0], v[1]); w.y = pk2(v[2], v[3]); *(u32x2*)p = w; }

template <int C> struct GBlob {
    static constexpr int KP = C < 32 ? 32 : C, JS = KP + 8;
    static constexpr int W = 64, QE = W + C * 272, P = QE + C * 272, KDT = P + C * JS * 2, U0T = KDT + 128 * JS * 2, END = U0T + 128 * JS * 2;
    static constexpr int MAIN_BYTES = U0T - W;
};

template <int C>
__device__ __forceinline__ void gdn_chunk_local(const Params& p, LAS unsigned char* lds, int rowbase, int nreal, int tok0, const float* sconv, int h, unsigned char* blob) {
    typedef GBlob<C> GB;
    constexpr int KP = GB::KP, JS = GB::JS;
    const int tid = threadIdx.x, lane = tid & 63, wave = tid >> 6;
    LAS bf16_t* Kn = (LAS bf16_t*)lds;
    LAS bf16_t* Qn = Kn + C * 136;
    LAS bf16_t* KbT = Qn + C * 136;
    LAS bf16_t* VbT = KbT + 128 * JS;
    LAS bf16_t* KdT = VbT + 128 * JS;
    LAS bf16_t* Xa = KdT + 128 * JS;
    LAS bf16_t* XaT = Xa + C * JS;
    LAS bf16_t* Xb = XaT + C * JS;
    LAS bf16_t* XbT = Xb + C * JS;
    LAS bf16_t* Ta = XbT + C * JS;
    LAS bf16_t* Tb = Ta + C * JS;
    LAS float* gv = (LAS float*)(Tb + C * JS);
    LAS float* betav = gv + C;
    LAS float* lav = betav + C;

    if (C < 32) {
        LAS unsigned* z = (LAS unsigned*)KbT; const int nz = (3 * 128 * JS + 6 * C * JS) / 2;
        for (int i = tid; i < nz; i += 512) z[i] = 0u;
        __syncthreads();
    }
    const int t = tid >> 3, part = tid & 7, ch0 = part * 16;
    float qv[16], kv[16], vv[16];
    const bool active = t < C;
    const bool real = active && t < nreal;
#pragma unroll
    for (int i = 0; i < 16; ++i) { qv[i] = 0.f; kv[i] = 0.f; vv[i] = 0.f; }
    if (real) {
#pragma unroll
        for (int ti = 0; ti < 3; ++ti) {
            const int cb = ti * 1024 + h * 128 + ch0;
            float acc[16];
#pragma unroll
            for (int i = 0; i < 16; ++i) acc[i] = 0.f;
#pragma unroll
            for (int tap = 0; tap < 4; ++tap) {
                const int dt = tap - 3;
                float xs[16];
                bool have = true;
                if (sconv) {
                    if (t + dt >= 0) { const bf16_t* src = p.PARTS + (size_t)(rowbase + t + dt) * NPAD + cb;
                        const u32x4 a = *(const u32x4*)src, b = *(const u32x4*)(src + 8);
                        xs[0] = bflo(a.x); xs[1] = bfhi(a.x); xs[2] = bflo(a.y); xs[3] = bfhi(a.y); xs[4] = bflo(a.z); xs[5] = bfhi(a.z); xs[6] = bflo(a.w); xs[7] = bfhi(a.w);
                        xs[8] = bflo(b.x); xs[9] = bfhi(b.x); xs[10] = bflo(b.y); xs[11] = bfhi(b.y); xs[12] = bflo(b.z); xs[13] = bfhi(b.z); xs[14] = bflo(b.w); xs[15] = bfhi(b.w);
                    } else { const float* src = sconv + (size_t)(3 + t + dt) * CONVD + cb;
#pragma unroll
                        for (int i = 0; i < 16; i += 4) { const f32x4 a = *(const f32x4*)(src + i); xs[i] = a.x; xs[i + 1] = a.y; xs[i + 2] = a.z; xs[i + 3] = a.w; } }
                } else {
                    if (tok0 + t + dt >= 0) { const bf16_t* src = p.PARTS + (size_t)(rowbase + t + dt) * NPAD + cb;
                        const u32x4 a = *(const u32x4*)src, b = *(const u32x4*)(src + 8);
                        xs[0] = bflo(a.x); xs[1] = bfhi(a.x); xs[2] = bflo(a.y); xs[3] = bfhi(a.y); xs[4] = bflo(a.z); xs[5] = bfhi(a.z); xs[6] = bflo(a.w); xs[7] = bfhi(a.w);
                        xs[8] = bflo(b.x); xs[9] = bfhi(b.x); xs[10] = bflo(b.y); xs[11] = bfhi(b.y); xs[12] = bflo(b.z); xs[13] = bfhi(b.z); xs[14] = bflo(b.w); xs[15] = bfhi(b.w);
                    } else have = false;
                }
                if (have) {
                    const float* wsrc = p.conv_w + (size_t)tap * CONVD + cb;
#pragma unroll
                    for (int i = 0; i < 16; i += 4) { const f32x4 w = *(const f32x4*)(wsrc + i); acc[i] += xs[i] * w.x; acc[i + 1] += xs[i + 1] * w.y; acc[i + 2] += xs[i + 2] * w.z; acc[i + 3] += xs[i + 3] * w.w; }
                }
            }
#pragma unroll
            for (int i = 0; i < 16; ++i) { const float s = acc[i] * sigmoidf_(acc[i]); if (ti == 0) qv[i] = s; else if (ti == 1) kv[i] = s; else vv[i] = s; }
        }
    }
    float ssq = 0.f, ssk = 0.f;
#pragma unroll
    for (int i = 0; i < 16; ++i) { ssq += qv[i] * qv[i]; ssk += kv[i] * kv[i]; }
    ssq += __shfl_xor(ssq, 1); ssq += __shfl_xor(ssq, 2); ssq += __shfl_xor(ssq, 4);
    ssk += __shfl_xor(ssk, 1); ssk += __shfl_xor(ssk, 2); ssk += __shfl_xor(ssk, 4);
    const float rq = rsqrtf(ssq + RMS_EPS) * 0.08838834764831845f, rk = rsqrtf(ssk + RMS_EPS);
#pragma unroll
    for (int i = 0; i < 16; ++i) { qv[i] *= rq; kv[i] *= rk; }
    if (active && part == 0) {
        float be = 0.f, la = 0.f;
        if (real) {
            const float* sm = p.SMALL + (size_t)(rowbase + t) * 32;
            be = sigmoidf_(sm[16 + h]);
            const float xa = sm[24 + h] + p.dt_bias[h];
            const float sp = xa > 20.f ? xa : log1pf(__expf(xa));
            la = -__expf(p.a_log[h]) * sp;
        }
        betav[t] = be; lav[t] = la;
    }
    __syncthreads();
    if (tid < C) { float s = 0.f; for (int j = 0; j <= tid; ++j) s += lav[j]; gv[tid] = s; }
    __syncthreads();
    const float glast = gv[C - 1];
    if (active) {
        const float g = gv[t], be = betav[t], eg = __expf(g), bk = be * eg, kd = __expf(glast - g);
        u32x4 w0, w1;
        w0.x = pk2(kv[0], kv[1]); w0.y = pk2(kv[2], kv[3]); w0.z = pk2(kv[4], kv[5]); w0.w = pk2(kv[6], kv[7]);
        w1.x = pk2(kv[8], kv[9]); w1.y = pk2(kv[10], kv[11]); w1.z = pk2(kv[12], kv[13]); w1.w = pk2(kv[14], kv[15]);
        *(LAS u32x4*)(Kn + t * 136 + ch0) = w0; *(LAS u32x4*)(Kn + t * 136 + ch0 + 8) = w1;
        w0.x = pk2(qv[0], qv[1]); w0.y = pk2(qv[2], qv[3]); w0.z = pk2(qv[4], qv[5]); w0.w = pk2(qv[6], qv[7]);
        w1.x = pk2(qv[8], qv[9]); w1.y = pk2(qv[10], qv[11]); w1.z = pk2(qv[12], qv[13]); w1.w = pk2(qv[14], qv[15]);
        *(LAS u32x4*)(Qn + t * 136 + ch0) = w0; *(LAS u32x4*)(Qn + t * 136 + ch0 + 8) = w1;
        w0.x = pk2(eg * qv[0], eg * qv[1]); w0.y = pk2(eg * qv[2], eg * qv[3]); w0.z = pk2(eg * qv[4], eg * qv[5]); w0.w = pk2(eg * qv[6], eg * qv[7]);
        w1.x = pk2(eg * qv[8], eg * qv[9]); w1.y = pk2(eg * qv[10], eg * qv[11]); w1.z = pk2(eg * qv[12], eg * qv[13]); w1.w = pk2(eg * qv[14], eg * qv[15]);
        bf16_t* qe = (bf16_t*)(blob + GB::QE) + t * 136 + ch0;
        *(u32x4*)qe = w0; *(u32x4*)(qe + 8) = w1;
#pragma unroll
        for (int i = 0; i < 16; ++i) {
            KbT[(ch0 + i) * JS + t] = f2bf(bk * kv[i]);
            VbT[(ch0 + i) * JS + t] = f2bf(be * vv[i]);
            KdT[(ch0 + i) * JS + t] = f2bf(kd * kv[i]);
        }
    }
    if (tid == 0) *(float*)blob = __expf(glast);
    __syncthreads();
    { const LAS u32x4* s = (const LAS u32x4*)KdT; u32x4* d = (u32x4*)(blob + GB::KDT);
      for (int i = tid; i < 128 * JS * 2 / 16; i += 512) d[i] = s[i]; }
    if (C < 32) {
        bf16_t* P = (bf16_t*)(blob + GB::P);
        for (int i = tid; i < C * (JS - C); i += 512) P[(i / (JS - C)) * JS + C + i % (JS - C)] = 0;
    }
    constexpr int NT = C / 16;
    for (int tl = wave; tl < NT * NT; tl += 8) {
        const int tm = tl / NT, tn = tl % NT, r = lane & 15, q = lane >> 4;
        f32x4 acc = {0.f, 0.f, 0.f, 0.f};
        acc = mm_tile<128>(Kn, 136, Kn, 136, tm * 16, tn * 16, acc, lane);
        const int j = tn * 16 + r; const float gj = gv[j];
        f32x4 x;
#pragma unroll
        for (int i = 0; i < 4; ++i) { const int tt = tm * 16 + 4 * q + i; x[i] = (j < tt) ? -betav[tt] * __expf(gv[tt] - gj) * acc[i] : 0.f; }
#pragma unroll
        for (int i = 0; i < 4; ++i) { const int tt = tm * 16 + 4 * q + i; Xa[tt * JS + j] = f2bf(x[i]); Ta[tt * JS + j] = f2bf(x[i] + (tt == j ? 1.f : 0.f)); }
        st4_bf16(XaT + j * JS + tm * 16 + 4 * q, x);
        f32x4 pc = {0.f, 0.f, 0.f, 0.f};
        pc = mm_tile<128>(Kn, 136, Qn, 136, tm * 16, tn * 16, pc, lane);
        const int t2 = tn * 16 + r; const float gt = gv[t2];
        f32x4 pv;
#pragma unroll
        for (int i = 0; i < 4; ++i) { const int jj = tm * 16 + 4 * q + i; pv[i] = (jj <= t2) ? __expf(gt - gv[jj]) * pc[i] : 0.f; }
        st4_bf16_g((bf16_t*)(blob + GB::P) + t2 * JS + tm * 16 + 4 * q, pv);
    }
    __syncthreads();
    LAS bf16_t *Xc = Xa, *XcT = XaT, *Xn = Xb, *XnT = XbT, *Tc = Ta, *Tn = Tb;
    constexpr int NSQ = (C == 64) ? 5 : 3;
#pragma unroll 1
    for (int s = 0; s <= NSQ; ++s) {
        for (int tl = wave; tl < 2 * NT * NT; tl += 8) {
            const int which = tl / (NT * NT), tt = tl % (NT * NT), tm = tt / NT, tn = tt % NT, r = lane & 15, q = lane >> 4;
            if (which == 0) {
                if (s < NSQ) {
                    f32x4 acc = {0.f, 0.f, 0.f, 0.f};
                    acc = mm_tile<KP>(Xc, JS, XcT, JS, tm * 16, tn * 16, acc, lane);
#pragma unroll
                    for (int i = 0; i < 4; ++i) Xn[(tm * 16 + 4 * q + i) * JS + tn * 16 + r] = f2bf(acc[i]);
                    st4_bf16(XnT + (tn * 16 + r) * JS + tm * 16 + 4 * q, acc);
                }
            } else {
                if (s >= 1) {
                    f32x4 acc;
#pragma unroll
                    for (int i = 0; i < 4; ++i) acc[i] = bf2f(Tc[(tm * 16 + 4 * q + i) * JS + tn * 16 + r]);
                    acc = mm_tile<KP>(Tc, JS, XcT, JS, tm * 16, tn * 16, acc, lane);
#pragma unroll
                    for (int i = 0; i < 4; ++i) Tn[(tm * 16 + 4 * q + i) * JS + tn * 16 + r] = f2bf(acc[i]);
                }
            }
        }
        __syncthreads();
        if (s >= 1) { LAS bf16_t* tmp = Tc; Tc = Tn; Tn = tmp; }
        if (s < NSQ) { LAS bf16_t* t1 = Xc; Xc = Xn; Xn = t1; LAS bf16_t* t2 = XcT; XcT = XnT; XnT = t2; }
    }
    for (int tl = wave; tl < 2 * 8 * NT; tl += 8) {
        const int which = tl / (8 * NT), tt = tl % (8 * NT), r = lane & 15, q = lane >> 4;
        f32x4 acc = {0.f, 0.f, 0.f, 0.f};
        if (which == 0) {
            const int tm = tt / NT, tn = tt % NT;
            acc = mm_tile<KP>(KbT, JS, Tc, JS, tm * 16, tn * 16, acc, lane);
            st4_bf16_g((bf16_t*)(blob + GB::W) + (tn * 16 + r) * 136 + tm * 16 + 4 * q, acc);
        } else {
            const int tm = tt / 8, tn = tt % 8;
            acc = mm_tile<KP>(Tc, JS, VbT, JS, tm * 16, tn * 16, acc, lane);
            st4_bf16_g((bf16_t*)(blob + GB::U0T) + (tn * 16 + r) * JS + tm * 16 + 4 * q, acc);
        }
    }
    if (C < 32) {
        bf16_t* U = (bf16_t*)(blob + GB::U0T);
        for (int i = tid; i < 128 * (JS - C); i += 512) U[(i / (JS - C)) * JS + C + i % (JS - C)] = 0;
    }
    __syncthreads();
}

__device__ __forceinline__ void phase2(const Params& p, LAS unsigned char* lds) {
    for (int it = blockIdx.x * 512 + threadIdx.x; it < (NB + DBATCH) * 3 * (CONVD / 8); it += gridDim.x * 512) {
        const int c8 = (it % (CONVD / 8)) * 8, ri = it / (CONVD / 8), i = ri % 3, bb = ri / 3;
        const int row = bb < NB ? bb * LP + (LP - 3) + i : MP + (bb - NB) * TS + (TS - 3) + i;
        float* dst = bb < NB ? p.out + O_PCONV + ((size_t)bb * 3 + i) * CONVD + c8 : p.out + O_SCONV + ((size_t)(bb - NB) * 3 + i) * CONVD + c8;
        const u32x4 a = *(const u32x4*)(p.PARTS + (size_t)row * NPAD + c8);
        *(f32x4*)dst = (f32x4){bflo(a.x), bfhi(a.x), bflo(a.y), bfhi(a.y)}; *(f32x4*)(dst + 4) = (f32x4){bflo(a.z), bfhi(a.z), bflo(a.w), bfhi(a.w)};
    }
    const int NU = NB * GH * NCHUNK + DBATCH * GH;
    for (int u = blockIdx.x; u < NU; u += gridDim.x) {
        if (u < NB * GH * NCHUNK) {
            const int bh = u / NCHUNK, c = u % NCHUNK, b = bh >> 3, h = bh & 7;
            unsigned char* blob = p.GOPS + (size_t)u * BLOB64;
            if (c == 0) gdn_chunk_local<16>(p, lds, b * LP, 16, 0, nullptr, h, blob);
            else gdn_chunk_local<64>(p, lds, b * LP + 16 + 64 * (c - 1), 64, 16 + 64 * (c - 1), nullptr, h, blob);
        } else {
            const int v = u - NB * GH * NCHUNK, sb = v >> 3, h = v & 7;
            gdn_chunk_local<16>(p, lds, MP + sb * TS, TS, 0, p.state_conv + (size_t)sb * 3 * CONVD, h, p.GOPS_S + (size_t)v * BLOB16);
        }
    }
}

template <int C, int DVS>
__device__ __forceinline__ void gdn_scan_step(const LAS unsigned char* ops, LAS bf16_t* ST, LAS bf16_t* UT, f32x4 (&accS)[DVS / 16], float decay,
                                              bf16_t* orow  , int nreal, int wave, int lane) {
    typedef GBlob<C> GB;
    constexpr int KP = GB::KP, JS = GB::JS, NTN = DVS / 16, NT1 = (C / 16) * NTN;
    const LAS bf16_t* W = (const LAS bf16_t*)(ops + (GB::W - 64));
    const LAS bf16_t* QE = (const LAS bf16_t*)(ops + (GB::QE - 64));
    const LAS bf16_t* P = (const LAS bf16_t*)(ops + (GB::P - 64));
    const LAS bf16_t* KDT = (const LAS bf16_t*)(ops + (GB::KDT - 64));
    const LAS bf16_t* U0T = (const LAS bf16_t*)(ops + (GB::U0T - 64));
    const int r = lane & 15, q = lane >> 4;
    const int tm = wave / NTN, tn = wave % NTN;
    f32x4 acco = {0.f, 0.f, 0.f, 0.f};
    if (wave < NT1) {
        f32x4 ws = {0.f, 0.f, 0.f, 0.f};
        ws = mm_tile<128>(W, 136, ST, 136, tm * 16, tn * 16, ws, lane);
        const LAS u32x2* up = (const LAS u32x2*)(U0T + (tn * 16 + r) * JS + tm * 16 + 4 * q);
        const u32x2 u0 = *up;
        f32x4 u; u[0] = bflo(u0.x) - ws[0]; u[1] = bfhi(u0.x) - ws[1]; u[2] = bflo(u0.y) - ws[2]; u[3] = bfhi(u0.y) - ws[3];
        st4_bf16(UT + (tn * 16 + r) * JS + tm * 16 + 4 * q, u);
        acco = mm_tile<128>(QE, 136, ST, 136, tm * 16, tn * 16, acco, lane);
    }
    __syncthreads();
    if (wave < NT1) {
        acco = mm_tile<KP>(P, JS, UT, JS, tm * 16, tn * 16, acco, lane);
#pragma unroll
        for (int i = 0; i < 4; ++i) { const int t = tm * 16 + 4 * q + i; if (t < nreal) orow[(size_t)t * D + tn * 16 + r] = f2bf(acco[i]); }
    }
#pragma unroll
    for (int n = 0; n < NTN; ++n) {
        f32x4 a = accS[n] * decay;
        a = mm_tile<KP>(KDT, JS, UT, JS, wave * 16, n * 16, a, lane);
        accS[n] = a;
        st4_bf16(ST + (n * 16 + r) * 136 + wave * 16 + 4 * q, a);
    }
}

template <int C, int DVS, int NR>
__device__ __forceinline__ void gdn_ops_load(const unsigned char* blob, int dv0, u32x4 (&regs)[NR], int tid) {
    typedef GBlob<C> GB;
    constexpr int MAINB = GB::MAIN_BYTES, UB = DVS * GB::JS * 2, TOT = MAINB + UB;
    static_assert(NR * 512 * 16 >= TOT, "NR too small");
#pragma unroll
    for (int i = 0; i < NR; ++i) {
        const int off = (tid + i * 512) * 16;
        if (off < MAINB) regs[i] = *(const u32x4*)(blob + GB::W + off);
        else if (off < TOT) regs[i] = *(const u32x4*)(blob + GB::U0T + dv0 * GB::JS * 2 + (off - MAINB));
    }
}
template <int C, int DVS, int NR>
__device__ __forceinline__ void gdn_ops_store(LAS unsigned char* ops, const u32x4 (&regs)[NR], int tid) {
    typedef GBlob<C> GB;
    constexpr int TOT = GB::MAIN_BYTES + DVS * GB::JS * 2;
#pragma unroll
    for (int i = 0; i < NR; ++i) { const int off = (tid + i * 512) * 16; if (off < TOT) *(LAS u32x4*)(ops + off) = regs[i]; }
}

__device__ __forceinline__ void phase3(const Params& p, LAS unsigned char* lds) {
    const int tid = threadIdx.x, lane = tid & 63, wave = tid >> 6, r = lane & 15, q = lane >> 4;
    constexpr int OPS64 = GBlob<64>::MAIN_BYTES + 32 * GBlob<64>::JS * 2;
    LAS unsigned char* ops0 = lds;
    LAS unsigned char* ops1 = lds + 67584;
    LAS bf16_t* ST = (LAS bf16_t*)(lds + 2 * 67584);
    LAS bf16_t* UT = (LAS bf16_t*)(lds + 2 * 67584 + 8704);
    for (int vu = blockIdx.x; vu < 256; vu += gridDim.x) {
        const int xg = vu & 7, idx = vu >> 3, bh = xg * 8 + (idx >> 2), sl = idx & 3, b = bh >> 3, h = bh & 7, dv0 = sl * 32;
        f32x4 accS[2] = {{0.f, 0.f, 0.f, 0.f}, {0.f, 0.f, 0.f, 0.f}};
        for (int i = tid; i < 32 * 136 / 2; i += 512) ((LAS unsigned*)ST)[i] = 0u;
        for (int i = tid; i < 32 * 72 / 2; i += 512) ((LAS unsigned*)UT)[i] = 0u;
        const unsigned char* blob0 = p.GOPS + (size_t)(bh * NCHUNK) * BLOB64;
        u32x4 regs[9];
        { u32x4 r16[4]; gdn_ops_load<16, 32, 4>(blob0, dv0, r16, tid); gdn_ops_store<16, 32, 4>(ops0, r16, tid); }
        gdn_ops_load<64, 32, 9>(blob0 + BLOB64, dv0, regs, tid);
        __syncthreads();
        gdn_scan_step<16, 32>(ops0, ST, UT, accS, *(const float*)blob0, p.ORAW + (size_t)(b * LP) * D + h * 128 + dv0, 16, wave, lane);
        gdn_ops_store<64, 32, 9>(ops1, regs, tid);
        __syncthreads();
#pragma unroll 1
        for (int c = 1; c < NCHUNK; ++c) {
            const unsigned char* blob = blob0 + (size_t)c * BLOB64;
            LAS unsigned char* cur = (c & 1) ? ops1 : ops0;
            LAS unsigned char* nxt = (c & 1) ? ops0 : ops1;
            if (c + 1 < NCHUNK) gdn_ops_load<64, 32, 9>(blob + BLOB64, dv0, regs, tid);
            gdn_scan_step<64, 32>(cur, ST, UT, accS, *(const float*)blob, p.ORAW + (size_t)(b * LP + 16 + 64 * (c - 1)) * D + h * 128 + dv0, 64, wave, lane);
            if (c + 1 < NCHUNK) gdn_ops_store<64, 32, 9>(nxt, regs, tid);
            __syncthreads();
        }
#pragma unroll
        for (int n = 0; n < 2; ++n)
#pragma unroll
            for (int i = 0; i < 4; ++i) p.out[O_PDELTA + ((size_t)bh * 128 + wave * 16 + 4 * q + i) * 128 + dv0 + n * 16 + r] = accS[n][i];
        __syncthreads();
    }
    LAS bf16_t* STs = (LAS bf16_t*)(lds + 32768);
    LAS bf16_t* UTs = (LAS bf16_t*)(lds + 32768 + 34816);
    for (int v = blockIdx.x; v < DBATCH * GH; v += gridDim.x) {
        const int sb = v >> 3, h = v & 7;
        const unsigned char* blob = p.GOPS_S + (size_t)v * BLOB16;
        u32x4 r16[4]; gdn_ops_load<16, 128, 4>(blob, 0, r16, tid); gdn_ops_store<16, 128, 4>(ops0, r16, tid);
        for (int i = tid; i < 128 * 40 / 2; i += 512) ((LAS unsigned*)UTs)[i] = 0u;
        f32x4 accS[8];
        const float* s0 = p.state_delta + (size_t)v * 128 * 128;
#pragma unroll
        for (int n = 0; n < 8; ++n) {
#pragma unroll
            for (int i = 0; i < 4; ++i) accS[n][i] = s0[(size_t)(wave * 16 + 4 * q + i) * 128 + n * 16 + r];
            st4_bf16(STs + (n * 16 + r) * 136 + wave * 16 + 4 * q, accS[n]);
        }
        __syncthreads();
        gdn_scan_step<16, 128>(ops0, STs, UTs, accS, *(const float*)blob, p.ORAW + (size_t)(MP + sb * TS) * D + h * 128, TS, wave, lane);
#pragma unroll
        for (int n = 0; n < 8; ++n)
#pragma unroll
            for (int i = 0; i < 4; ++i) p.out[O_SDELTA + ((size_t)v * 128 + wave * 16 + 4 * q + i) * 128 + n * 16 + r] = accS[n][i];
        __syncthreads();
    }
}

__device__ __forceinline__ void phase4(const Params& p, LAS unsigned char* lds) {
    const int lane = threadIdx.x & 63, gw = blockIdx.x * 8 + (threadIdx.x >> 6), ngw = gridDim.x * 8;
    for (int row = gw; row < MR; row += ngw) {
        const u32x4 a = *(const u32x4*)(p.ORAW + (size_t)row * D + lane * 16), b = *(const u32x4*)(p.ORAW + (size_t)row * D + lane * 16 + 8);
        float o[16] = {bflo(a.x), bfhi(a.x), bflo(a.y), bfhi(a.y), bflo(a.z), bfhi(a.z), bflo(a.w), bfhi(a.w), bflo(b.x), bfhi(b.x), bflo(b.y), bfhi(b.y), bflo(b.z), bfhi(b.z), bflo(b.w), bfhi(b.w)};
        float ss = 0.f;
#pragma unroll
        for (int i = 0; i < 16; ++i) ss += o[i] * o[i];
        ss += __shfl_xor(ss, 1); ss += __shfl_xor(ss, 2); ss += __shfl_xor(ss, 4);
        const float rs = rsqrtf(ss * (1.f / 128.f) + RMS_EPS);
        const u32x4 za = *(const u32x4*)(p.PARTS + (size_t)row * NPAD + C_Z + lane * 16), zb = *(const u32x4*)(p.PARTS + (size_t)row * NPAD + C_Z + lane * 16 + 8);
        const float z[16] = {bflo(za.x), bfhi(za.x), bflo(za.y), bfhi(za.y), bflo(za.z), bfhi(za.z), bflo(za.w), bfhi(za.w), bflo(zb.x), bfhi(zb.x), bflo(zb.y), bfhi(zb.y), bflo(zb.z), bfhi(zb.z), bflo(zb.w), bfhi(zb.w)};
        const float* gn = p.gnorm + (lane & 7) * 16;
        float y[16];
#pragma unroll
        for (int i = 0; i < 16; ++i) y[i] = o[i] * rs * gn[i] * (z[i] * sigmoidf_(z[i]));
        u32x4 w0, w1;
        w0.x = pk2(y[0], y[1]); w0.y = pk2(y[2], y[3]); w0.z = pk2(y[4], y[5]); w0.w = pk2(y[6], y[7]);
        w1.x = pk2(y[8], y[9]); w1.y = pk2(y[10], y[11]); w1.z = pk2(y[12], y[13]); w1.w = pk2(y[14], y[15]);
        *(u32x4*)(p.OGDN + (size_t)row * D + lane * 16) = w0; *(u32x4*)(p.OGDN + (size_t)row * D + lane * 16 + 8) = w1;
    }
}

constexpr int SCS = 2116;
__device__ __forceinline__ bf16x8 pack8(const f32x4 a, const f32x4 b) {
    u32x4 w; w.x = pk2(a.x, a.y); w.y = pk2(a.z, a.w); w.z = pk2(b.x, b.y); w.w = pk2(b.z, b.w);
    return __builtin_bit_cast(bf16x8, w);
}
template <bool SAMPLE>
__device__ __forceinline__ void indexer_unit(const Params& p, LAS unsigned char* lds, int qrow0, int nq, int qpos0, int krow0, int sb) {
    const int tid = threadIdx.x, lane = tid & 63, wave = tid >> 6, r = lane & 15, q = lane >> 4;
    LAS float* sc = (LAS float*)lds;
    bf16x8 qf[16][2];
    float wq[16];
    {
        const bf16_t* qsrc = p.PARTS + (size_t)(qrow0 + r) * NPAD + C_IQ + 8 * q;
#pragma unroll
        for (int hd = 0; hd < 16; ++hd)
#pragma unroll
            for (int ks = 0; ks < 2; ++ks) qf[hd][ks] = *(const bf16x8*)(qsrc + hd * 64 + ks * 32);
        const float* wsrc = p.SMALL + (size_t)(qrow0 + r) * 32;
#pragma unroll
        for (int hd = 0; hd < 16; ++hd) wq[hd] = wsrc[hd] * 0.03125f;
    }
    const int lastq = qpos0 + 15;
    const int nkt = SAMPLE ? (PAST + TS + 15) / 16 : (lastq / 16 + 1);
    for (int kt = wave; kt < nkt; kt += 8) {
        bf16x8 kf[2];
        const int s = kt * 16 + r;
        if (SAMPLE) {
            if (s < PAST) {
                const int page = p.page_table[sb * NPAGES + (s >> 7)];
                const float* src = p.cache_ik + ((size_t)page * PAGE + (s & 127)) * IDIM + 8 * q;
#pragma unroll
                for (int ks = 0; ks < 2; ++ks) { const f32x4 a = *(const f32x4*)(src + ks * 32), b = *(const f32x4*)(src + ks * 32 + 4); kf[ks] = pack8(a, b); }
            } else {
                const int sn = s - PAST < TS ? s - PAST : TS - 1;
                const bf16_t* src = p.PARTS + (size_t)(MP + sb * TS + sn) * NPAD + C_IK + 8 * q;
#pragma unroll
                for (int ks = 0; ks < 2; ++ks) kf[ks] = *(const bf16x8*)(src + ks * 32);
            }
        } else {
            const bf16_t* src = p.PARTS + (size_t)(krow0 + s) * NPAD + C_IK + 8 * q;
#pragma unroll
            for (int ks = 0; ks < 2; ++ks) kf[ks] = *(const bf16x8*)(src + ks * 32);
        }
        f32x4 tot = {0.f, 0.f, 0.f, 0.f};
#pragma unroll
        for (int hd = 0; hd < 16; ++hd) {
            f32x4 a = {0.f, 0.f, 0.f, 0.f};
            a = __builtin_amdgcn_mfma_f32_16x16x32_bf16(kf[0], qf[hd][0], a, 0, 0, 0);
            a = __builtin_amdgcn_mfma_f32_16x16x32_bf16(kf[1], qf[hd][1], a, 0, 0, 0);
#pragma unroll
            for (int i = 0; i < 4; ++i) tot[i] += wq[hd] * fmaxf(a[i], 0.f);
        }
        *(LAS f32x4*)(sc + r * SCS + kt * 16 + 4 * q) = tot;
    }
    __syncthreads();
#pragma unroll 1
    for (int qq = 0; qq < 2; ++qq) {
        const int qi = wave * 2 + qq;
        if (qi >= nq) continue;
        const int tpos = qpos0 + qi;
        unsigned key[33];
#pragma unroll
        for (int j = 0; j < 33; ++j) {
            const int s = lane + 64 * j;
            const unsigned u = __float_as_uint(sc[qi * SCS + s]);
            const unsigned srt = (u & 0x80000000u) ? ~u : (u | 0x80000000u);
            key[j] = (s <= tpos) ? srt : 0u;
        }
        unsigned long long mymask = 0ull;
        if (tpos < TOPK) {
#pragma unroll
            for (int j = 0; j < 33; ++j) { const unsigned long long m = __ballot(lane + 64 * j <= tpos); if (lane == j) mymask = m; }
        } else {
            unsigned prefix = 0u;
#pragma unroll 1
            for (int bit = 31; bit >= 0; --bit) {
                const unsigned cand = prefix | (1u << bit);
                int cnt = 0;
#pragma unroll
                for (int j = 0; j < 33; ++j) cnt += __popcll(__ballot(key[j] >= cand));
                if (cnt >= TOPK) prefix = cand;
            }
            int cgt = 0;
#pragma unroll
            for (int j = 0; j < 33; ++j) cgt += __popcll(__ballot(key[j] > prefix));
            int need = TOPK - cgt;
#pragma unroll
            for (int j = 0; j < 33; ++j) {
                const unsigned long long mg = __ballot(key[j] > prefix);
                unsigned long long me = __ballot(key[j] == prefix);
                const int ne = __popcll(me);
                if (ne <= need) need -= ne;
                else { while (__popcll(me) > need) me &= ~(1ull << (63 - __clzll(me))); need = 0; }
                if (lane == j) mymask = mg | me;
            }
        }
        if (lane < 33) p.MASK[(size_t)(qrow0 + qi) * 33 + lane] = mymask;
    }
    __syncthreads();
}
__device__ __forceinline__ void phase5(const Params& p, LAS unsigned char* lds) {
    constexpr int NQT = LP / 16;
    const int NU = NB * NQT + DBATCH;
    for (int u = blockIdx.x; u < NU; u += gridDim.x) {
        if (u < NB * NQT) {
            const int b = u % NB, qt = NQT - 1 - u / NB;
            indexer_unit<false>(p, lds, b * LP + qt * 16, 16, qt * 16, b * LP, 0);
        } else {
            const int sb = u - NB * NQT;
            indexer_unit<true>(p, lds, MP + sb * TS, TS, PAST, 0, sb);
        }
    }
}

template <int NRT>
__device__ __forceinline__ void attn_tile32(const LAS bf16_t* Ks, const LAS bf16_t* Vt, const bf16x8 (&qf)[NRT][4], const unsigned (&mbits)[NRT], float (&m)[NRT], float (&l)[NRT], f32x4 (&acco)[NRT][8], int lane) {
    const int r = lane & 15, q = lane >> 4;
    constexpr float CSC = 0.12751743082459868f;
    f32x4 s[NRT][2];
#pragma unroll
    for (int sub = 0; sub < 2; ++sub) {
        const LAS bf16_t* kp = Ks + (sub * 16 + r) * 136 + 8 * q;
#pragma unroll
        for (int rt = 0; rt < NRT; ++rt) s[rt][sub] = (f32x4){0.f, 0.f, 0.f, 0.f};
#pragma unroll
        for (int ks = 0; ks < 4; ++ks) {
            const bf16x8 kf = *(const LAS bf16x8*)(kp + ks * 32);
#pragma unroll
            for (int rt = 0; rt < NRT; ++rt) s[rt][sub] = __builtin_amdgcn_mfma_f32_16x16x32_bf16(kf, qf[rt][ks], s[rt][sub], 0, 0, 0);
        }
    }
    __builtin_amdgcn_sched_barrier(0);
    bf16x8 pf[NRT];
#pragma unroll
    for (int rt = 0; rt < NRT; ++rt) {
        float tmax = -1e30f;
#pragma unroll
        for (int sub = 0; sub < 2; ++sub)
#pragma unroll
            for (int i = 0; i < 4; ++i) { const bool sel = (mbits[rt] >> (sub * 16 + 4 * q + i)) & 1u; s[rt][sub][i] = sel ? s[rt][sub][i] : -1e30f; tmax = fmaxf(tmax, s[rt][sub][i]); }
        tmax = fmaxf(tmax, __shfl_xor(tmax, 16)); tmax = fmaxf(tmax, __shfl_xor(tmax, 32));
        const float mn = fmaxf(m[rt], tmax);
        const float alpha = exp2f((m[rt] - mn) * CSC);
        m[rt] = mn;
        float psum = 0.f;
#pragma unroll
        for (int sub = 0; sub < 2; ++sub)
#pragma unroll
            for (int i = 0; i < 4; ++i) { const float pv = s[rt][sub][i] > -1e29f ? exp2f((s[rt][sub][i] - mn) * CSC) : 0.f; s[rt][sub][i] = pv; psum += pv; }
        l[rt] = l[rt] * alpha + psum;
#pragma unroll
        for (int dt = 0; dt < 8; ++dt) acco[rt][dt] *= alpha;
        pf[rt] = pack8(s[rt][0], s[rt][1]);
    }
    __builtin_amdgcn_sched_barrier(0);
#pragma unroll
    for (int dt = 0; dt < 8; ++dt) {
        const LAS bf16_t* vp = Vt + (dt * 16 + r) * 72 + 4 * q;
        const u32x2 v0 = *(const LAS u32x2*)vp, v1 = *(const LAS u32x2*)(vp + 16);
        u32x4 vw; vw.x = v0.x; vw.y = v0.y; vw.z = v1.x; vw.w = v1.y;
        const bf16x8 vf = __builtin_bit_cast(bf16x8, vw);
#pragma unroll
        for (int rt = 0; rt < NRT; ++rt) acco[rt][dt] = __builtin_amdgcn_mfma_f32_16x16x32_bf16(vf, pf[rt], acco[rt][dt], 0, 0, 0);
    }
    __builtin_amdgcn_sched_barrier(0);
}
__device__ __forceinline__ void attn_finish(const f32x4 (&acco)[8], float l, bf16_t* orow  , int lane) {
    const int q = lane >> 4;
    l += __shfl_xor(l, 16); l += __shfl_xor(l, 32);
    const float inv = 1.f / l;
    if (orow) {
#pragma unroll
        for (int dt = 0; dt < 8; ++dt) st4_bf16_g(orow + dt * 16 + 4 * q, acco[dt] * inv);
    }
}

constexpr int KS_BYTES = 64 * 136 * 2, VT_BYTES = 128 * 72 * 2;

__device__ __forceinline__ void attn_prompt_unit(const Params& p, LAS unsigned char* lds, int b, int qb) {
    const int tid = threadIdx.x, lane = tid & 63, wave = tid >> 6, r = lane & 15, q = lane >> 4;
    const int head = wave, kvh = wave >> 2;
    LAS bf16_t* Ks0 = (LAS bf16_t*)lds;
    LAS bf16_t* Vt0 = (LAS bf16_t*)(lds + 2 * KS_BYTES);
    const int t0 = qb * 32, nkt = (t0 + 31) / 64 + 1;
    const int rowb = b * LP;
    bf16x8 qf[2][4]; float m[2] = {-1e30f, -1e30f}, l[2] = {0.f, 0.f}; f32x4 acco[2][8];
#pragma unroll
    for (int rt = 0; rt < 2; ++rt) {
        const bf16_t* qsrc = p.PARTS + (size_t)(rowb + t0 + rt * 16 + r) * NPAD + C_AQ + head * 128 + 8 * q;
#pragma unroll
        for (int ks = 0; ks < 4; ++ks) qf[rt][ks] = *(const bf16x8*)(qsrc + ks * 32);
#pragma unroll
        for (int dt = 0; dt < 8; ++dt) acco[rt][dt] = (f32x4){0.f, 0.f, 0.f, 0.f};
    }
    u32x4 kreg[2][2], vreg[2][2];
    auto load_k = [&](int kt) {
#pragma unroll
        for (int kh = 0; kh < 2; ++kh)
#pragma unroll
            for (int it = 0; it < 2; ++it) {
                const int id = tid + 512 * it, key = id >> 4, ch = id & 15;
                kreg[kh][it] = *(const u32x4*)(p.PARTS + (size_t)(rowb + kt * 64 + key) * NPAD + C_AK + kh * 128 + ch * 8);
            }
    };
    auto load_v = [&](int kt) {
#pragma unroll
        for (int kh = 0; kh < 2; ++kh)
#pragma unroll
            for (int it = 0; it < 2; ++it) {
                const int vkey = tid & 63, vch = (tid >> 6) + 8 * it;
                vreg[kh][it] = *(const u32x4*)(p.PARTS + (size_t)(rowb + kt * 64 + vkey) * NPAD + C_AV + kh * 128 + vch * 8);
            }
    };
    auto store_tile = [&]() {
#pragma unroll
        for (int kh = 0; kh < 2; ++kh)
#pragma unroll
            for (int it = 0; it < 2; ++it) {
                const int id = tid + 512 * it, key = id >> 4, ch = id & 15;
                *(LAS u32x4*)((LAS unsigned char*)Ks0 + kh * KS_BYTES + (key * 136 + ch * 8) * 2) = kreg[kh][it];
                const int vkey = tid & 63, vch = (tid >> 6) + 8 * it;
                LAS bf16_t* vt = (LAS bf16_t*)((LAS unsigned char*)Vt0 + kh * VT_BYTES) + (vch * 8) * 72 + vkey;
                const u32x4 v = vreg[kh][it];
                vt[0 * 72] = (bf16_t)(v.x & 0xFFFFu); vt[1 * 72] = (bf16_t)(v.x >> 16); vt[2 * 72] = (bf16_t)(v.y & 0xFFFFu); vt[3 * 72] = (bf16_t)(v.y >> 16);
                vt[4 * 72] = (bf16_t)(v.z & 0xFFFFu); vt[5 * 72] = (bf16_t)(v.z >> 16); vt[6 * 72] = (bf16_t)(v.w & 0xFFFFu); vt[7 * 72] = (bf16_t)(v.w >> 16);
            }
    };
    load_k(0); load_v(0);
#pragma unroll 1
    for (int kt = 0; kt < nkt; ++kt) {
        store_tile();
        __syncthreads();
        if (kt + 1 < nkt) { load_k(kt + 1); load_v(kt + 1); }
        const LAS bf16_t* Ks = (const LAS bf16_t*)((LAS unsigned char*)Ks0 + kvh * KS_BYTES);
        const LAS bf16_t* Vt = (const LAS bf16_t*)((LAS unsigned char*)Vt0 + kvh * VT_BYTES);
        const unsigned long long mw0 = p.MASK[(size_t)(rowb + t0 + r) * 33 + kt], mw1 = p.MASK[(size_t)(rowb + t0 + 16 + r) * 33 + kt];
        { const unsigned mb[2] = {(unsigned)mw0, (unsigned)mw1}; attn_tile32<2>(Ks, Vt, qf, mb, m, l, acco, lane); }
        { const unsigned mb[2] = {(unsigned)(mw0 >> 32), (unsigned)(mw1 >> 32)}; attn_tile32<2>(Ks + 32 * 136, Vt + 32, qf, mb, m, l, acco, lane); }
        __syncthreads();
    }
#pragma unroll
    for (int rt = 0; rt < 2; ++rt) {
        const int t = t0 + rt * 16 + r;
        attn_finish(acco[rt], l[rt], t < LP ? p.OATT + (size_t)(rowb + t) * D + head * 128 : nullptr, lane);
    }
}

__device__ __forceinline__ void attn_sample_unit(const Params& p, LAS unsigned char* lds, int sb, int kvh) {
    const int tid = threadIdx.x, lane = tid & 63, wave = tid >> 6, r = lane & 15, q = lane >> 4;
    LAS bf16_t* Ks = (LAS bf16_t*)lds;
    LAS bf16_t* Vt = (LAS bf16_t*)(lds + KS_BYTES);
    const int rowq = MP + sb * TS;
    constexpr int nkt = (PAST + TS + 63) / 64;
    const int tok = r & 7, head = kvh * 4 + (wave & 1) * 2 + (r >> 3);
    bf16x8 qf[1][4]; float m[1] = {-1e30f}, l[1] = {0.f}; f32x4 acco[1][8];
    {
        const bf16_t* qsrc = p.PARTS + (size_t)(rowq + tok) * NPAD + C_AQ + head * 128 + 8 * q;
#pragma unroll
        for (int ks = 0; ks < 4; ++ks) qf[0][ks] = *(const bf16x8*)(qsrc + ks * 32);
#pragma unroll
        for (int dt = 0; dt < 8; ++dt) acco[0][dt] = (f32x4){0.f, 0.f, 0.f, 0.f};
    }
    f32x4 kreg[2][2], vreg[2][2];
    auto src_row = [&](const float* cache, int s, int c_new) -> const float* {
        const int page = p.page_table[sb * NPAGES + (s >> 7)];
        return cache + (((size_t)page * PAGE + (s & 127)) * AKV + kvh) * ADH;
    };
    auto load_tile = [&](int kt) {
#pragma unroll
        for (int it = 0; it < 2; ++it) {
            const int id = tid + 512 * it, key = id >> 4, ch = id & 15, s = kt * 64 + key;
            const int vkey = tid & 63, vch = (tid >> 6) + 8 * it, sv = kt * 64 + vkey;
            if (s < PAST) { const float* a = src_row(p.cache_k, s, 0) + ch * 8; kreg[it][0] = *(const f32x4*)a; kreg[it][1] = *(const f32x4*)(a + 4); }
            else { const int sn = s - PAST < TS ? s - PAST : TS - 1; const u32x4 w = *(const u32x4*)(p.PARTS + (size_t)(rowq + sn) * NPAD + C_AK + kvh * 128 + ch * 8);
                   kreg[it][0] = (f32x4){bflo(w.x), bfhi(w.x), bflo(w.y), bfhi(w.y)}; kreg[it][1] = (f32x4){bflo(w.z), bfhi(w.z), bflo(w.w), bfhi(w.w)}; }
            if (sv < PAST) { const float* a = src_row(p.cache_v, sv, 0) + vch * 8; vreg[it][0] = *(const f32x4*)a; vreg[it][1] = *(const f32x4*)(a + 4); }
            else { const int sn = sv - PAST < TS ? sv - PAST : TS - 1; const u32x4 w = *(const u32x4*)(p.PARTS + (size_t)(rowq + sn) * NPAD + C_AV + kvh * 128 + vch * 8);
                   vreg[it][0] = (f32x4){bflo(w.x), bfhi(w.x), bflo(w.y), bfhi(w.y)}; vreg[it][1] = (f32x4){bflo(w.z), bfhi(w.z), bflo(w.w), bfhi(w.w)}; }
        }
    };
    auto store_tile = [&]() {
#pragma unroll
        for (int it = 0; it < 2; ++it) {
            const int id = tid + 512 * it, key = id >> 4, ch = id & 15;
            const bf16x8 kw = pack8(kreg[it][0], kreg[it][1]);
            *(LAS bf16x8*)(Ks + key * 136 + ch * 8) = kw;
            const int vkey = tid & 63, vch = (tid >> 6) + 8 * it;
            LAS bf16_t* vt = Vt + (vch * 8) * 72 + vkey;
            vt[0 * 72] = f2bf(vreg[it][0].x); vt[1 * 72] = f2bf(vreg[it][0].y); vt[2 * 72] = f2bf(vreg[it][0].z); vt[3 * 72] = f2bf(vreg[it][0].w);
            vt[4 * 72] = f2bf(vreg[it][1].x); vt[5 * 72] = f2bf(vreg[it][1].y); vt[6 * 72] = f2bf(vreg[it][1].z); vt[7 * 72] = f2bf(vreg[it][1].w);
        }
    };
    load_tile(0);
#pragma unroll 1
    for (int kt = 0; kt < nkt; ++kt) {
        store_tile();
        __syncthreads();
        if (kt + 1 < nkt) load_tile(kt + 1);
        if (wave < 2) {
            const unsigned long long mw0 = p.MASK[(size_t)(rowq + tok) * 33 + kt];
            { const unsigned mb[1] = {(unsigned)mw0}; attn_tile32<1>(Ks, Vt, qf, mb, m, l, acco, lane); }
            { const unsigned mb[1] = {(unsigned)(mw0 >> 32)}; attn_tile32<1>(Ks + 32 * 136, Vt + 32, qf, mb, m, l, acco, lane); }
        }
        __syncthreads();
    }
    if (wave < 2) attn_finish(acco[0], l[0], p.OATT + (size_t)(rowq + tok) * D + head * 128, lane);
}

__device__ __forceinline__ void phase6(const Params& p, LAS unsigned char* lds) {
    constexpr int NQB = (LP + 31) / 32;
    constexpr int NU = NB * NQB;
    const int G = gridDim.x;
    for (int i = blockIdx.x, round = 0; ; ++round) {
        int li;
        if (round == 0) li = blockIdx.x; else if (round == 1) li = 2 * G - 1 - blockIdx.x; else li = round * G + blockIdx.x;
        if (round >= 2 && li >= NU) break;
        if (li < NU) { const int qb = NQB - 1 - li / NB, b = li % NB; attn_prompt_unit(p, lds, b, qb); }
        (void)i;
    }
    for (int u = blockIdx.x; u < DBATCH * AKV; u += G) attn_sample_unit(p, lds, u >> 1, u & 1);
}

__device__ __forceinline__ void unpack8(const u32x4 w, float (&o)[8]) {
    o[0] = bflo(w.x); o[1] = bfhi(w.x); o[2] = bflo(w.y); o[3] = bfhi(w.y); o[4] = bflo(w.z); o[5] = bfhi(w.z); o[6] = bflo(w.w); o[7] = bfhi(w.w);
}
template <int MODE> struct EpiFin {
    static constexpr bool PERM = true, AFTER_DRAIN = false;
    Params p;
    __device__ __forceinline__ void operator()(const pg8::f32x4 (&acc)[2][2][4][2], const pg8::Unit& u, int wr, int wc, int fr, int fq) const {
        const int row0 = u.pm * 256 + wr * 64 + fr, col0 = u.pn * 256 + wc * 32 + 8 * fq;
#pragma unroll
        for (int ai = 0; ai < 2; ++ai)
#pragma unroll
            for (int m = 0; m < 4; ++m) {
                const int row = row0 + ai * 128 + m * 16;
                const float* xr = (MODE == 2) ? xrow_ptr(p, row) : nullptr;
#pragma unroll
                for (int bj = 0; bj < 2; ++bj) {
                    const int col = col0 + bj * 128;
                    float v[8] = {acc[ai][bj][m][0][0], acc[ai][bj][m][0][1], acc[ai][bj][m][0][2], acc[ai][bj][m][0][3], acc[ai][bj][m][1][0], acc[ai][bj][m][1][1], acc[ai][bj][m][1][2], acc[ai][bj][m][1][3]};
                    if (MODE == 0 || MODE == 1) {
                        float g[8]; unpack8(*(const u32x4*)(p.PARTS + (size_t)row * NPAD + (MODE == 0 ? C_GA : C_GB) + col), g);
#pragma unroll
                        for (int i = 0; i < 8; ++i) v[i] *= sigmoidf_(g[i]);
                    }
                    if (MODE == 0) {
                        float* dst = p.TMPA + (size_t)row * D + col;
                        *(f32x4*)dst = (f32x4){v[0], v[1], v[2], v[3]}; *(f32x4*)(dst + 4) = (f32x4){v[4], v[5], v[6], v[7]};
                    } else if (MODE == 1) {
                        const float* src = p.TMPA + (size_t)row * D + col;
                        const f32x4 a = *(const f32x4*)src, b = *(const f32x4*)(src + 4);
                        u32x4 w; w.x = pk2(v[0] + a.x, v[1] + a.y); w.y = pk2(v[2] + a.z, v[3] + a.w); w.z = pk2(v[4] + b.x, v[5] + b.y); w.w = pk2(v[6] + b.z, v[7] + b.w);
                        *(u32x4*)(p.MERGED + (size_t)row * D + col) = w;
                    } else if (MODE == 2) {
                        f32x4 a = {0.f, 0.f, 0.f, 0.f}, b = {0.f, 0.f, 0.f, 0.f};
                        if (xr) { a = *(const f32x4*)(xr + col); b = *(const f32x4*)(xr + col + 4); }
                        float* dst = p.V1 + (size_t)row * D + col;
                        *(f32x4*)dst = (f32x4){DN_ALPHA * a.x + v[0], DN_ALPHA * a.y + v[1], DN_ALPHA * a.z + v[2], DN_ALPHA * a.w + v[3]};
                        *(f32x4*)(dst + 4) = (f32x4){DN_ALPHA * b.x + v[4], DN_ALPHA * b.y + v[5], DN_ALPHA * b.z + v[6], DN_ALPHA * b.w + v[7]};
                    } else {
                        u32x4 w; w.x = pk2(v[0], v[1]); w.y = pk2(v[2], v[3]); w.z = pk2(v[4], v[5]); w.w = pk2(v[6], v[7]);
                        *(u32x4*)(p.QRY + (size_t)row * 2048 + col) = w;
                    }
                }
            }
    }
};
template <int MODE>
__device__ __forceinline__ void fin_gemm(const Params& p, LAS unsigned char* lds, const bf16_t* A, const bf16_t* Bt, int N) {
    pg8::Gemm g; g.A = A; g.Bt = Bt; g.M = MPAD; g.N = N; g.K = D;
    pg8::StaticOrder S; S.init(MPAD, N, gridDim.x, blockIdx.x);
    EpiFin<MODE> E; E.p = p;
    pg8::gemm_phase<EpiFin<MODE>, pg8::StaticOrder, false>(lds, g, S, E, nullptr);
}
__device__ __forceinline__ void phase7(const Params& p, LAS unsigned char* lds) {
    fin_gemm<0>(p, lds, p.OGDN, p.WBGT, D);
    fin_gemm<1>(p, lds, p.OATT, p.WBAT, D);
}
__device__ __forceinline__ void phase8(const Params& p, LAS unsigned char* lds) { fin_gemm<2>(p, lds, p.MERGED, p.WOUTT, D); }

__device__ __forceinline__ void ln_row(float (&v)[16], const float* g, const float* b, int lane) {
    float s = 0.f;
#pragma unroll
    for (int i = 0; i < 16; ++i) s += v[i];
    const float mu = wave_sum(s) * (1.f / D);
    float s2 = 0.f;
#pragma unroll
    for (int i = 0; i < 16; ++i) { v[i] -= mu; s2 += v[i] * v[i]; }
    const float rstd = rsqrtf(wave_sum(s2) * (1.f / D) + LN_EPS);
#pragma unroll
    for (int i = 0; i < 16; i += 4) {
        const f32x4 gg = *(const f32x4*)(g + lane * 16 + i), bb = *(const f32x4*)(b + lane * 16 + i);
        v[i] = v[i] * rstd * gg.x + bb.x; v[i + 1] = v[i + 1] * rstd * gg.y + bb.y; v[i + 2] = v[i + 2] * rstd * gg.z + bb.z; v[i + 3] = v[i + 3] * rstd * gg.w + bb.w;
    }
}
__device__ __forceinline__ void phase9(const Params& p, LAS unsigned char* lds) {
    const int lane = threadIdx.x & 63, gw = blockIdx.x * 8 + (threadIdx.x >> 6), ngw = gridDim.x * 8;
    for (int row = gw; row < MPAD; row += ngw) {
        float v[16];
        float* src = p.V1 + (size_t)row * D + lane * 16;
        if (row < MR) {
#pragma unroll
            for (int i = 0; i < 16; i += 4) { const f32x4 a = *(const f32x4*)(src + i); v[i] = a.x; v[i + 1] = a.y; v[i + 2] = a.z; v[i + 3] = a.w; }
            ln_row(v, p.ln1_g, p.ln1_b, lane);
        } else {
#pragma unroll
            for (int i = 0; i < 16; ++i) v[i] = 0.f;
        }
#pragma unroll
        for (int i = 0; i < 16; i += 4) *(f32x4*)(src + i) = (f32x4){v[i], v[i + 1], v[i + 2], v[i + 3]};
        u32x4 w0, w1;
        w0.x = pk2(v[0], v[1]); w0.y = pk2(v[2], v[3]); w0.z = pk2(v[4], v[5]); w0.w = pk2(v[6], v[7]);
        w1.x = pk2(v[8], v[9]); w1.y = pk2(v[10], v[11]); w1.z = pk2(v[12], v[13]); w1.w = pk2(v[14], v[15]);
        *(u32x4*)(p.HB + (size_t)row * D + lane * 16) = w0; *(u32x4*)(p.HB + (size_t)row * D + lane * 16 + 8) = w1;
    }
}
__device__ __forceinline__ void phase10(const Params& p, LAS unsigned char* lds) { fin_gemm<3>(p, lds, p.HB, p.WQT, 2048); }

template <int N> __device__ __forceinline__ void bitonic_sort_desc(float (&v)[N]) {
#pragma unroll
    for (int k = 2; k <= N; k <<= 1)
#pragma unroll
        for (int j = k >> 1; j > 0; j >>= 1)
#pragma unroll
            for (int i = 0; i < N; ++i) {
                const int l = i ^ j;
                if (l > i) {
                    const bool desc = ((i & k) == 0);
                    const float a = v[i], b = v[l];
                    v[i] = desc ? fmaxf(a, b) : fminf(a, b);
                    v[l] = desc ? fminf(a, b) : fmaxf(a, b);
                }
            }
}
template <int N> __device__ __forceinline__ void bitonic_merge_desc(float (&v)[N]) {
#pragma unroll
    for (int j = N >> 1; j > 0; j >>= 1)
#pragma unroll
        for (int i = 0; i < N; ++i) { const int l = i ^ j; if (l > i) { const float a = v[i], b = v[l]; v[i] = fmaxf(a, b); v[l] = fminf(a, b); } }
}
__device__ __forceinline__ void merge_top16(float (&a)[16], int mask) {
    float b[16];
#pragma unroll
    for (int i = 0; i < 16; ++i) b[i] = __shfl_xor(a[15 - i], mask);
#pragma unroll
    for (int i = 0; i < 16; ++i) a[i] = fmaxf(a[i], b[i]);
    bitonic_merge_desc<16>(a);
}
__device__ __forceinline__ void ce_kp(float& ka, int& pa, float& kb, int& pb) {
    const bool sw = kb > ka;
    const float k0 = sw ? kb : ka, k1 = sw ? ka : kb; const int p0 = sw ? pb : pa, p1 = sw ? pa : pb;
    ka = k0; kb = k1; pa = p0; pb = p1;
}
__device__ __forceinline__ void bitonic_sort_desc_kp16(float (&v)[16], int (&pl)[16]) {
#pragma unroll
    for (int k = 2; k <= 16; k <<= 1)
#pragma unroll
        for (int j = k >> 1; j > 0; j >>= 1)
#pragma unroll
            for (int i = 0; i < 16; ++i) { const int l = i ^ j; if (l > i) { if ((i & k) == 0) ce_kp(v[i], pl[i], v[l], pl[l]); else ce_kp(v[l], pl[l], v[i], pl[i]); } }
}
__device__ __forceinline__ void merge_top16_kp(float (&a)[16], int (&pa)[16], int mask) {
#pragma unroll
    for (int i = 0; i < 16; ++i) {
        const float bk = __shfl_xor(a[15 - i], mask); const int bp = __shfl_xor(pa[15 - i], mask);
        const bool takeb = (bk > a[i]) || (bk == a[i] && bp < pa[i]);
        a[i] = takeb ? bk : a[i]; pa[i] = takeb ? bp : pa[i];
    }
#pragma unroll
    for (int j = 8; j > 0; j >>= 1)
#pragma unroll
        for (int i = 0; i < 16; ++i) { const int l = i ^ j; if (l > i) ce_kp(a[i], pa[i], a[l], pa[l]); }
}

__device__ __forceinline__ void phase11(const Params& p, LAS unsigned char* lds) {
    const int lane = threadIdx.x & 63, h = threadIdx.x >> 6, r = lane & 15, q = lane >> 4;
    for (int ut = blockIdx.x; ut < MR / 16; ut += gridDim.x) {
        const int row0 = ut * 16;
        float top[2][16];
#pragma unroll
        for (int c = 0; c < 2; ++c) {
            const int g = 2 * h + c;
            bf16x8 qf[4];
            const bf16_t* qsrc = p.QRY + (size_t)(row0 + r) * 2048 + g * 128 + 8 * q;
#pragma unroll
            for (int ks = 0; ks < 4; ++ks) qf[ks] = *(const bf16x8*)(qsrc + ks * 32);
            float sv[32];
#pragma unroll
            for (int nt = 0; nt < 8; ++nt) {
                const bf16_t* ksrc = p.SUBK + ((size_t)g * 128 + nt * 16 + r) * 128 + 8 * q;
                f32x4 a = {0.f, 0.f, 0.f, 0.f};
#pragma unroll
                for (int ks = 0; ks < 4; ++ks) a = __builtin_amdgcn_mfma_f32_16x16x32_bf16(*(const bf16x8*)(ksrc + ks * 32), qf[ks], a, 0, 0, 0);
#pragma unroll
                for (int i = 0; i < 4; ++i) sv[nt * 4 + i] = __uint_as_float((__float_as_uint(a[i]) & ~127u) | (unsigned)(nt * 16 + 4 * q + i));
            }
            bitonic_sort_desc<32>(sv);
#pragma unroll
            for (int i = 0; i < 16; ++i) top[c][i] = sv[i];
            merge_top16(top[c], 16);
            merge_top16(top[c], 32);
        }
        float ck[16]; int cp[16];
        {
            constexpr int PI[50] = {0,0,0,0,0,0,0,0,0,0,0,0,0,0,0,0, 1,1,1,1,1,1,1,1, 2,2,2,2,2, 3,3,3,3, 4,4,4, 5,5, 6,6, 7,7, 8,9,10,11,12,13,14,15};
            constexpr int PJ[50] = {0,1,2,3,4,5,6,7,8,9,10,11,12,13,14,15, 0,1,2,3,4,5,6,7, 0,1,2,3,4, 0,1,2,3, 0,1,2, 0,1, 0,1, 0,1, 0,0,0,0,0,0,0,0};
#pragma unroll
            for (int k = 0; k < 16; ++k) { ck[k] = -3.0e38f; cp[k] = 0x7fffffff; }
#pragma unroll
            for (int pi = 0; pi < 50; ++pi) {
                const float a = top[0][PI[pi]], b = top[1][PJ[pi]];
                const float sum = __uint_as_float(__float_as_uint(a) & ~127u) + __uint_as_float(__float_as_uint(b) & ~127u);
                const int e = (int)((__float_as_uint(a) & 127u) * 128u + (__float_as_uint(b) & 127u));
                if ((pi & 3) == q) { ck[pi >> 2] = sum; cp[pi >> 2] = e; }
            }
        }
        bitonic_sort_desc_kp16(ck, cp);
        merge_top16_kp(ck, cp, 16);
        merge_top16_kp(ck, cp, 32);
        float e[16], es = 0.f;
#pragma unroll
        for (int k = 0; k < 16; ++k) { e[k] = __expf(ck[k] - ck[0]); es += e[k]; }
        const float inv = 1.f / es;
        const int row = row0 + r;
        if (row < MR) {
#pragma unroll
            for (int k = 0; k < 16; ++k) if ((k >> 2) == q) { p.EIDX[(size_t)row * 128 + h * 16 + k] = (unsigned short)cp[k]; p.EGATE[(size_t)row * 128 + h * 16 + k] = e[k] * inv; }
        }
    }
}

__device__ __forceinline__ void phase12(const Params& p, LAS unsigned char* lds) {
    const int lane = threadIdx.x & 63, gw = blockIdx.x * 8 + (threadIdx.x >> 6), ngw = gridDim.x * 8;
    for (int row = gw; row < MR; row += ngw) {
        float* yout;
        if (row < MP) { const int b = row / LP, t = row - b * LP; if (t < NMETA) continue; yout = p.out + O_YP + ((size_t)b * SEQ + (t - NMETA)) * D; }
        else yout = p.out + O_YS + (size_t)(row - MP) * D;
        float hv[16];
        const float* hsrc = p.V1 + (size_t)row * D + lane * 16;
#pragma unroll
        for (int i = 0; i < 16; i += 4) { const f32x4 a = *(const f32x4*)(hsrc + i); hv[i] = a.x; hv[i + 1] = a.y; hv[i + 2] = a.z; hv[i + 3] = a.w; }
        const int e0 = p.EIDX[(size_t)row * 128 + lane], e1 = p.EIDX[(size_t)row * 128 + 64 + lane];
        const float g0 = p.EGATE[(size_t)row * 128 + lane], g1 = p.EGATE[(size_t)row * 128 + 64 + lane];
        float f[16];
#pragma unroll
        for (int i = 0; i < 16; ++i) f[i] = 0.f;
#pragma unroll 1
        for (int eb = 0; eb < 128; eb += 8) {
            int eid[8]; float gt[8];
#pragma unroll
            for (int k = 0; k < 8; ++k) { const int e = eb + k; eid[k] = __shfl(e < 64 ? e0 : e1, e & 63); gt[k] = __shfl(e < 64 ? g0 : g1, e & 63); }
            u32x4 ua[8], ub[8];
#pragma unroll
            for (int k = 0; k < 8; ++k) { const bf16_t* us = p.PU + (size_t)eid[k] * D + lane * 16; ua[k] = *(const u32x4*)us; ub[k] = *(const u32x4*)(us + 8); }
            float cf[8];
#pragma unroll
            for (int k = 0; k < 8; ++k) {
                float u[16]; { float t0[8], t1[8]; unpack8(ua[k], t0); unpack8(ub[k], t1);
#pragma unroll
                    for (int i = 0; i < 8; ++i) { u[i] = t0[i]; u[8 + i] = t1[i]; } }
                float d = 0.f;
#pragma unroll
                for (int i = 0; i < 16; ++i) d += u[i] * hv[i];
                d = wave_sum(d);
                cf[k] = gt[k] * 0.5f * d * (1.f + erff(d * 0.70710678118654752f));
            }
#pragma unroll
            for (int k = 0; k < 8; ++k) { const bf16_t* vs = p.PV + (size_t)eid[k] * D + lane * 16; ua[k] = *(const u32x4*)vs; ub[k] = *(const u32x4*)(vs + 8); }
#pragma unroll
            for (int k = 0; k < 8; ++k) {
                float t0[8], t1[8]; unpack8(ua[k], t0); unpack8(ub[k], t1);
#pragma unroll
                for (int i = 0; i < 8; ++i) { f[i] += cf[k] * t0[i]; f[8 + i] += cf[k] * t1[i]; }
            }
        }
        float v[16];
#pragma unroll
        for (int i = 0; i < 16; ++i) v[i] = DN_ALPHA * hv[i] + f[i];
        ln_row(v, p.ln2_g, p.ln2_b, lane);
#pragma unroll
        for (int i = 0; i < 16; i += 4) *(f32x4*)(yout + lane * 16 + i) = (f32x4){v[i], v[i + 1], v[i + 2], v[i + 3]};
    }
}

#ifndef MEGA
#define MEGA 0
#endif
template <int PHX> __device__ __forceinline__ void run_phase(const Params& p, LAS unsigned char* lds) {
    if constexpr (PHX == 0) phase0(p, lds);
    else if constexpr (PHX == 1) phase1(p, lds);
    else if constexpr (PHX == 2) phase2(p, lds);
    else if constexpr (PHX == 3) phase3(p, lds);
    else if constexpr (PHX == 4) phase4(p, lds);
    else if constexpr (PHX == 5) phase5(p, lds);
    else if constexpr (PHX == 6) phase6(p, lds);
    else if constexpr (PHX == 7) phase7(p, lds);
    else if constexpr (PHX == 8) phase8(p, lds);
    else if constexpr (PHX == 9) phase9(p, lds);
    else if constexpr (PHX == 10) phase10(p, lds);
    else if constexpr (PHX == 11) phase11(p, lds);
    else if constexpr (PHX == 12) phase12(p, lds);
}
#define FOR_PHASES(X) X(0) X(1) X(2) X(3) X(4) X(5) X(6) X(7) X(8) X(9) X(10) X(11) X(12)

constexpr int LDS_BYTES = 163840;
constexpr int LDS_BAR_OFF = LDS_BYTES - 16;

template <int PHX> __global__ __launch_bounds__(512, 2) void k_phase(Params p) {
    extern __shared__ __attribute__((aligned(16))) unsigned char smem[];
    LAS unsigned char* lds = (LAS unsigned char*)smem;
    run_phase<PHX>(p, lds);
}

#if MEGA
__global__ __launch_bounds__(512, 2) void k_mega(Params p) {
    extern __shared__ __attribute__((aligned(16))) unsigned char smem[];
    LAS unsigned char* lds = (LAS unsigned char*)smem;
    if (threadIdx.x == 0) *(LAS u32x4*)(lds + LDS_BAR_OFF) = (u32x4){0u, 0u, 0u, 0u};
    __syncthreads();
    XcdBarrier bar = xcd_barrier_post(p.bar, (volatile LAS unsigned*)(lds + LDS_BAR_OFF));
    run_phase<0>(p, lds);  xcd_barrier(bar);
    run_phase<1>(p, lds);  xcd_barrier(bar);
    run_phase<2>(p, lds);  xcd_barrier(bar);
    run_phase<3>(p, lds);  xcd_barrier(bar);
    run_phase<4>(p, lds);  xcd_barrier(bar);
    run_phase<5>(p, lds);  xcd_barrier(bar);
    run_phase<6>(p, lds);  xcd_barrier(bar);
    run_phase<7>(p, lds);  xcd_barrier(bar);
    run_phase<8>(p, lds);  xcd_barrier(bar);
    run_phase<9>(p, lds);  xcd_barrier(bar);
    run_phase<10>(p, lds); xcd_barrier(bar);
    run_phase<11>(p, lds); xcd_barrier(bar);
    run_phase<12>(p, lds);
}
#endif

static size_t carve(size_t& off, size_t bytes) { const size_t o = off; off += (bytes + 255) & ~(size_t)255; return o; }

extern "C" void kernel_launch(void* const* d_in, const int* in_sizes, int n_in, void* d_out, int out_size, void* d_ws, size_t ws_size, hipStream_t stream) {
    Params p{};
    p.x_prompt = (const float*)d_in[0]; p.x_sample = (const float*)d_in[1]; p.cache_k = (const float*)d_in[2]; p.cache_v = (const float*)d_in[3];
    p.cache_ik = (const float*)d_in[4]; p.state_conv = (const float*)d_in[5]; p.state_delta = (const float*)d_in[6]; p.page_table = (const int*)d_in[7];
    p.meta = (const float*)d_in[8]; p.w_in = (const float*)d_in[9]; p.conv_w = (const float*)d_in[10]; p.a_log = (const float*)d_in[11]; p.dt_bias = (const float*)d_in[12];
    p.gnorm = (const float*)d_in[13]; p.w_bg = (const float*)d_in[14]; p.w_ba = (const float*)d_in[15]; p.w_out = (const float*)d_in[16];
    p.ln1_g = (const float*)d_in[17]; p.ln1_b = (const float*)d_in[18]; p.peer_wq = (const float*)d_in[19]; p.peer_sub = (const float*)d_in[20];
    p.peer_u = (const float*)d_in[21]; p.peer_v = (const float*)d_in[22]; p.ln2_g = (const float*)d_in[23]; p.ln2_b = (const float*)d_in[24];
    p.out = (float*)d_out;
    unsigned char* ws = (unsigned char*)d_ws; size_t off = 0;
    p.bar = (unsigned*)(ws + carve(off, 16384));
    p.XB = (bf16_t*)(ws + carve(off, (size_t)MPAD * D * 2));
    p.WINT = (bf16_t*)(ws + carve(off, (size_t)NPAD * D * 2));
    p.WBGT = (bf16_t*)(ws + carve(off, (size_t)D * D * 2));
    p.WBAT = (bf16_t*)(ws + carve(off, (size_t)D * D * 2));
    p.WOUTT = (bf16_t*)(ws + carve(off, (size_t)D * D * 2));
    p.WQT = (bf16_t*)(ws + carve(off, (size_t)2048 * D * 2));
    p.SUBK = (bf16_t*)(ws + carve(off, (size_t)16 * 128 * 128 * 2));
    p.PU = (bf16_t*)(ws + carve(off, (size_t)NEXP * D * 2));
    p.PV = (bf16_t*)(ws + carve(off, (size_t)NEXP * D * 2));
    p.PARTS = (bf16_t*)(ws + carve(off, (size_t)MPAD * NPAD * 2));
    p.SMALL = (float*)(ws + carve(off, (size_t)MPAD * 32 * 4));
    p.GOPS = ws + carve(off, (size_t)NB * GH * NCHUNK * BLOB64);
    p.GOPS_S = ws + carve(off, (size_t)DBATCH * GH * BLOB16);
    p.ORAW = (bf16_t*)(ws + carve(off, (size_t)MPAD * D * 2));
    p.OGDN = (bf16_t*)(ws + carve(off, (size_t)MPAD * D * 2));
    p.OATT = (bf16_t*)(ws + carve(off, (size_t)MPAD * D * 2));
    p.MASK = (unsigned long long*)(ws + carve(off, (size_t)MR * 33 * 8));
    p.TMPA = (float*)(ws + carve(off, (size_t)MPAD * D * 4));
    p.MERGED = (bf16_t*)(ws + carve(off, (size_t)MPAD * D * 2));
    p.V1 = (float*)(ws + carve(off, (size_t)MPAD * D * 4));
    p.HB = (bf16_t*)(ws + carve(off, (size_t)MPAD * D * 2));
    p.QRY = (bf16_t*)(ws + carve(off, (size_t)MPAD * 2048 * 2));
    p.EIDX = (unsigned short*)(ws + carve(off, (size_t)MR * 128 * 2));
    p.EGATE = (float*)(ws + carve(off, (size_t)MR * 128 * 4));
    if (off > ws_size || n_in != 25) { fprintf(stderr, "kernel_launch: workspace too small (%zu > %zu) or n_in %d != 25\n", off, ws_size, n_in); return; }

    static int grid = 0;
    if (grid == 0) {
        int dev = 0, cus = 0;
        (void)hipGetDevice(&dev); (void)hipDeviceGetAttribute(&cus, hipDeviceAttributeMultiprocessorCount, dev);
        grid = cus > 0 ? cus : 256;
#if MEGA
        (void)hipFuncSetAttribute((const void*)k_mega, hipFuncAttributeMaxDynamicSharedMemorySize, LDS_BYTES);
#else
#define X_ATTR(i) (void)hipFuncSetAttribute((const void*)k_phase<i>, hipFuncAttributeMaxDynamicSharedMemorySize, LDS_BYTES);
        FOR_PHASES(X_ATTR)
#endif
        (void)hipGetLastError();
    }
    (void)hipMemsetAsync(p.bar, 0, 16384, stream);
#if MEGA
    hipLaunchKernelGGL(k_mega, dim3(grid), dim3(512), LDS_BYTES, stream, p);
#else
#define X_LAUNCH(i) hipLaunchKernelGGL(k_phase<i>, dim3(grid), dim3(512), LDS_BYTES, stream, p);
    FOR_PHASES(X_LAUNCH)
#endif
}
```

```cpp
#include <hip/hip_runtime.h>
#include <stdint.h>
#include <stdio.h>

#define LAS __attribute__((address_space(3)))
typedef unsigned short bf16_t;
typedef short bf16x8 __attribute__((ext_vector_type(8)));
typedef float f32x4 __attribute__((ext_vector_type(4)));
typedef unsigned u32x4 __attribute__((ext_vector_type(4)));
typedef unsigned u32x2 __attribute__((ext_vector_type(2)));

constexpr int D = 1024, NB = 8, SEQ = 2048, NMETA = 16, LP = 2064, DBATCH = 128, TS = 8, PAST = 2048, PAGE = 128, NPAGES = 16;
constexpr int MP = NB * LP  , MS = DBATCH * TS  , MR = MP + MS  , MPAD = 17664;
constexpr int NIN = 8800, NPAD = 8960;
constexpr int MFB = NB * SEQ  , MF = MFB + MS  ;
constexpr int GH = 8, GDK = 128, GDV = 128, CONVD = 3072;
constexpr int AH = 8, AKV = 2, ADH = 128, IH = 16, IDIM = 64, TOPK = 256;
constexpr int PH = 8, PNK = 128, PQD = 256, PTOPK = 16, NEXP = 16384;
constexpr float DN_ALPHA = 1.189207115002721f;
constexpr float LN_EPS = 1e-5f, RMS_EPS = 1e-6f;
constexpr int C_QKV = 0, C_Z = 3072, C_AQ = 4096, C_AK = 5120, C_AV = 5376, C_IQ = 5632, C_GA = 6656, C_GB = 7680, C_IK = 8704, C_IW = 8768, C_BETA = 8784, C_A = 8792;
constexpr long O_YP = 0, O_YS = 16777216, O_PCONV = 17825792, O_PDELTA = 17899520, O_PK = 18948096, O_PV = 23175168, O_PIK = 27402240,
               O_SCONV = 28459008, O_SDELTA = 29638656, O_SK = 46415872, O_SV = 46678016, O_SIK = 46940160;
constexpr int NCHUNK = 33;
constexpr int BLOB64 = 81920, BLOB16 = 32768;

struct Params {
    const float *x_prompt, *x_sample, *cache_k, *cache_v, *cache_ik, *state_conv, *state_delta; const int* page_table;
    const float *meta, *w_in, *conv_w, *a_log, *dt_bias, *gnorm, *w_bg, *w_ba, *w_out, *ln1_g, *ln1_b, *peer_wq, *peer_sub, *peer_u, *peer_v, *ln2_g, *ln2_b;
    float* out;
    unsigned* bar;
    bf16_t *XB, *WINT, *WBGT, *WBAT, *WOUTT, *WQT, *SUBK, *PU, *PV, *PARTS;
    float* SMALL;
    unsigned char *GOPS, *GOPS_S;
    bf16_t *ORAW, *OGDN, *OATT;
    unsigned long long* MASK;
    float* TMPA; bf16_t* MERGED; float* V1; bf16_t* HB; bf16_t* QRY;
    unsigned short* EIDX; float* EGATE;
    unsigned char *PU8, *PV8; float *SU, *SV;
    float* ESU;
    bf16_t *KIDX, *AKC, *AVC;
    bf16_t *IKC;
    int G;
};

#ifndef STAMPS
#define STAMPS 0
#endif
#if STAMPS == 2
#define SEG_DECL unsigned long long seg_t0 = wall_clock64();
#define SEG(i) do { if (blockIdx.x == 0 && threadIdx.x == 0) { const unsigned long long _t = wall_clock64(); atomicAdd(&p.bar[3620 + (i)], (unsigned)(_t - seg_t0)); seg_t0 = _t; } } while (0)
#else
#define SEG_DECL
#define SEG(i) do {} while (0)
#endif
__device__ __forceinline__ void lds_barrier() { asm volatile("s_waitcnt lgkmcnt(0)" ::: "memory"); __builtin_amdgcn_s_barrier(); asm volatile("" ::: "memory"); }
__device__ __forceinline__ int tidx() { int t = threadIdx.x; asm volatile("" : "+v"(t)); return t; }
typedef __bf16 bf16v2 __attribute__((ext_vector_type(2)));
__device__ __forceinline__ bf16_t f2bf(float f) { return __builtin_bit_cast(bf16_t, (__bf16)f); }
__device__ __forceinline__ float bf2f(bf16_t b) { return __uint_as_float(((unsigned)b) << 16); }
__device__ __forceinline__ unsigned pk2(float lo, float hi) { bf16v2 v; v.x = (__bf16)lo; v.y = (__bf16)hi; return __builtin_bit_cast(unsigned, v); }
typedef _Float16 f16v2 __attribute__((ext_vector_type(2)));
__device__ __forceinline__ unsigned pk2h(float lo, float hi) { f16v2 v; v.x = (_Float16)lo; v.y = (_Float16)hi; return __builtin_bit_cast(unsigned, v); }
__device__ __forceinline__ float hlo(unsigned w) { return (float)__builtin_bit_cast(f16v2, w).x; }
__device__ __forceinline__ float hhi(unsigned w) { return (float)__builtin_bit_cast(f16v2, w).y; }
__device__ __forceinline__ float bflo(unsigned w) { return __uint_as_float(w << 16); }
__device__ __forceinline__ float bfhi(unsigned w) { return __uint_as_float(w & 0xFFFF0000u); }
__device__ __forceinline__ float sigmoidf_(float x) { return __builtin_amdgcn_rcpf(1.0f + __expf(-x)); }
template <int CTRL> __device__ __forceinline__ unsigned dpp_u(unsigned v) { return (unsigned)__builtin_amdgcn_update_dpp(0, (int)v, CTRL, 0xF, 0xF, false); }
template <int J> __device__ __forceinline__ unsigned lane_xor(unsigned v, int lane) {
    if constexpr (J == 1) return dpp_u<0xB1>(v);
    else if constexpr (J == 2) return dpp_u<0x4E>(v);
    else if constexpr (J == 4) return dpp_u<0x1B>(dpp_u<0x141>(v));
    else if constexpr (J == 8) return dpp_u<0x128>(v);
    else if constexpr (J == 16) { const auto r = __builtin_amdgcn_permlane16_swap(v, v, false, false); return (lane & 16) ? r[0] : r[1]; }
    else { const auto r = __builtin_amdgcn_permlane32_swap(v, v, false, false); return (lane & 32) ? r[0] : r[1]; }
}
__device__ __forceinline__ float wave_sum(float v) {
    v += __uint_as_float(dpp_u<0xB1>(__float_as_uint(v))); v += __uint_as_float(dpp_u<0x4E>(__float_as_uint(v)));
    v += __uint_as_float(dpp_u<0x141>(__float_as_uint(v))); v += __uint_as_float(dpp_u<0x140>(__float_as_uint(v)));
    { const auto r = __builtin_amdgcn_permlane16_swap(__float_as_uint(v), __float_as_uint(v), false, false); v = __uint_as_float(r[0]) + __uint_as_float(r[1]); }
    { const auto r = __builtin_amdgcn_permlane32_swap(__float_as_uint(v), __float_as_uint(v), false, false); v = __uint_as_float(r[0]) + __uint_as_float(r[1]); }
    return v;
}
__device__ __forceinline__ float wave_max(float v) {
    v = fmaxf(v, __uint_as_float(dpp_u<0xB1>(__float_as_uint(v)))); v = fmaxf(v, __uint_as_float(dpp_u<0x4E>(__float_as_uint(v))));
    v = fmaxf(v, __uint_as_float(dpp_u<0x141>(__float_as_uint(v)))); v = fmaxf(v, __uint_as_float(dpp_u<0x140>(__float_as_uint(v))));
    { const auto r = __builtin_amdgcn_permlane16_swap(__float_as_uint(v), __float_as_uint(v), false, false); v = fmaxf(__uint_as_float(r[0]), __uint_as_float(r[1])); }
    { const auto r = __builtin_amdgcn_permlane32_swap(__float_as_uint(v), __float_as_uint(v), false, false); v = fmaxf(__uint_as_float(r[0]), __uint_as_float(r[1])); }
    return v;
}
__device__ __forceinline__ int full_row(int fr) { return fr < MFB ? fr + NMETA * ((fr >> 11) + 1) : fr + (MP - MFB); }
__device__ __forceinline__ const float* xrow_ptr(const Params& p, int row) {
    if (row < MP) { const int b = row / LP, t = row - b * LP; return t < NMETA ? p.meta + (size_t)t * D : p.x_prompt + ((size_t)b * SEQ + (t - NMETA)) * D; }
    if (row < MR) return p.x_sample + (size_t)(row - MP) * D;
    return nullptr;
}

#define XB_TMO      128
#define XB_XCNT(j)  (256  + 64 * (j))
#define XB_XSUB(j)  (1280 + 64 * (j))
#define XB_XGEN(j)  (2304 + 64 * (j))
#define XB_TOP      3328
#define XB_TOPGEN   3392
#define XCD_BAR_WORDS 3456
#define XB_SPIN_CAP (1u << 22)

__device__ __forceinline__ unsigned xb_ld(unsigned* p)              { return __hip_atomic_load(p, __ATOMIC_RELAXED, __HIP_MEMORY_SCOPE_AGENT); }
__device__ __forceinline__ unsigned xb_add(unsigned* p, unsigned v) { return __hip_atomic_fetch_add(p, v, __ATOMIC_RELAXED, __HIP_MEMORY_SCOPE_AGENT); }
__device__ __forceinline__ unsigned xb_xcc_id() { return (unsigned)__builtin_amdgcn_s_getreg((3 << 11) | 20) & 0xFu; }
#define XB_SPIN(cond, bar) do { unsigned _sp = 0; while (cond) { __builtin_amdgcn_s_sleep(1); \
    if ((++_sp & 255u) == 0u) { if (xb_ld(&(bar)[XB_TMO])) break; if (_sp > XB_SPIN_CAP) { atomicAdd(&(bar)[XB_TMO], 1u); break; } } } } while (0)

struct XcdBarrier { unsigned* bar; unsigned x; volatile LAS unsigned* st; int G; };

__device__ __forceinline__ XcdBarrier xcd_barrier_post(unsigned* bar, volatile LAS unsigned* st, int G) {
    XcdBarrier b; b.bar = bar; b.x = xb_xcc_id(); b.st = st; b.G = G;
    if (threadIdx.x == 0) (void)xb_add(&bar[XB_XCNT(b.x)], 1u);
    return b;
}
__device__ __forceinline__ void xcd_barrier_complete(unsigned* bar, unsigned x, unsigned& nloc, unsigned& nx, int gridsz) {
    const unsigned G = (unsigned)gridsz;
    unsigned sum, cnt, mine, sp = 0u;
    for (;;) {
        sum = 0u; cnt = 0u; mine = 0u;
#pragma unroll
        for (unsigned j = 0; j < 16; ++j) { const unsigned c = xb_ld(&bar[XB_XCNT(j)]); sum += c; cnt += (c > 0u) ? 1u : 0u; mine = (j == x) ? c : mine; }
        if (sum == G) break;
        __builtin_amdgcn_s_sleep(1);
        if ((++sp & 255u) == 0u) { if (xb_ld(&bar[XB_TMO])) break; if (sp > XB_SPIN_CAP) { atomicAdd(&bar[XB_TMO], 1u); break; } }
    }
    nloc = mine > 0u ? mine : 1u; nx = cnt > 0u ? cnt : 1u;
}
__device__ __forceinline__ void xcd_barrier(const XcdBarrier& b) {
    asm volatile("s_waitcnt vmcnt(0)" ::: "memory");
    __syncthreads();
    if (threadIdx.x == 0) {
        unsigned* bar = b.bar;
        unsigned bx = b.x; asm volatile("" : "+s"(bx));
        __builtin_amdgcn_s_waitcnt(0);
        unsigned nloc = b.st[0], nx = b.st[1];
        if (nloc == 0u) { xcd_barrier_complete(bar, bx, nloc, nx, b.G); b.st[0] = nloc; b.st[1] = nx; }
        const unsigned old = xb_add(&bar[XB_XSUB(bx)], 1u);
        const unsigned gen = old / nloc;
        if (old + 1u == (gen + 1u) * nloc) {
            __builtin_amdgcn_fence(__ATOMIC_RELEASE, "agent");
            asm volatile("s_waitcnt vmcnt(0)" ::: "memory");
            const unsigned og = xb_add(&bar[XB_TOP], 1u);
            const unsigned tg = og / nx;
            if (og + 1u == (tg + 1u) * nx) xb_add(&bar[XB_TOPGEN], 1u);
            else XB_SPIN(xb_ld(&bar[XB_TOPGEN]) == tg, bar);
            __builtin_amdgcn_fence(__ATOMIC_ACQUIRE, "agent");
            xb_add(&bar[XB_XGEN(bx)], 1u);
            asm volatile("s_waitcnt vmcnt(0)" ::: "memory");
        } else {
            XB_SPIN(xb_ld(&bar[XB_XGEN(bx)]) == gen, bar);
            __builtin_amdgcn_fence(__ATOMIC_ACQUIRE, "agent");
            asm volatile("s_waitcnt vmcnt(0)" ::: "memory");
        }
    }
    __syncthreads();
}

namespace pg8 {
#define PG8_LAS __attribute__((address_space(3)))
typedef unsigned short bf16_t;
typedef short bf16x8 __attribute__((ext_vector_type(8)));
typedef float f32x4 __attribute__((ext_vector_type(4)));
typedef unsigned u32x4 __attribute__((ext_vector_type(4)));
constexpr int BM = 256, BK = 64, HALF = 128, HTB = HALF * BK * 2  , STAGE_BYTES = 8 * HTB, NXCD = 8, WGM = 8;

__host__ __device__ __forceinline__ int lds_byte(int r, int c) { const int st = (r >> 4) * 2 + (c >> 5), rr = r & 15, cc = c & 31, ob = rr * 64 + cc * 2; return st * 1024 + (ob ^ (((ob >> 9) & 1) << 5)); }
__host__ __device__ __forceinline__ void stage_rc(int b, int& R, int& C) { const int st = b / 1024, sb = b % 1024, swz = sb ^ (((sb >> 9) & 1) << 5); R = (st >> 1) * 16 + swz / 64; C = (st & 1) * 32 + (swz % 64) / 2; }
__host__ __device__ __forceinline__ int perm32(int rho) { const int n = rho >> 4, i = rho & 15; return 8 * (i >> 2) + 4 * n + (i & 3); }

struct Unit { int pm, pn, sel; };
struct Gemm { const bf16_t* A; const bf16_t* Bt; int M, N, K; const bf16_t* A2; const bf16_t* Bt2; };

struct StaticOrder {
    int nM, nN, nwg, G, c;
    __host__ __device__ void init(int M, int N, int G_, int c_) { nM = M / BM; nN = N / BM; nwg = nM * nN; G = G_; c = c_; }
    __host__ __device__ bool next(int i, Unit& u) const {
        const long L = (long)i * G + c; if (L >= nwg) return false;
        int wgid = (int)L; { const int q = nwg / NXCD, r = nwg % NXCD, xcd = wgid % NXCD, off = wgid / NXCD; wgid = (xcd < r ? xcd * (q + 1) : r * (q + 1) + (xcd - r) * q) + off; }
        const int nig = WGM * nN, gid = wgid / nig, fm = gid * WGM, gsz = (nM - fm) < WGM ? (nM - fm) : WGM;
        u.pm = fm + ((wgid % nig) % gsz); u.pn = (wgid % nig) / gsz; u.sel = 0; return true;
    }
    __device__ __forceinline__ void a_ready(const Unit&) const {}
    __device__ __forceinline__ void done(const Unit&) const {}
};
__device__ __forceinline__ unsigned cvt_pk_bf16(float lo, float hi) { unsigned r; asm volatile("v_cvt_pk_bf16_f32 %0, %1, %2" : "=v"(r) : "v"(lo), "v"(hi)); return r; }
typedef float f32x2 __attribute__((ext_vector_type(2)));
template <class Epi, class Sched, bool STAMP = false>
__device__ __forceinline__ void gemm_phase(PG8_LAS unsigned char* lds, const Gemm g, const Sched& S, const Epi& E, unsigned long long* stamps) {
    const int tid = tidx(), wid = __builtin_amdgcn_readfirstlane(tid >> 6), lane = tid & 63, wr = wid >> 2, wc = wid & 3, fr = lane & 15, fq = lane >> 4;
    const int K = g.K, nt = K / BK;
    int ts_lo = 0, ts_hi = 0, nts = 0; const unsigned long long rt_entry = STAMP ? (unsigned long long)wall_clock64() : 0ull;
#define PG8_STAMP() do { if (STAMP && wid == 0 && nts < 64) { const unsigned long long _c = (unsigned long long)clock64(); \
        ts_lo = (lane == nts) ? (int)(unsigned)_c : ts_lo; ts_hi = (lane == nts) ? (int)(unsigned)(_c >> 32) : ts_hi; ++nts; } } while (0)
    PG8_STAMP();
    unsigned voffA[2], voffB[2];
#pragma unroll
    for (int i = 0; i < 2; ++i) { int R, C; stage_rc(tid * 16 + i * 8192, R, C); const int Rb = Epi::PERM ? ((R & ~31) + perm32(R & 31)) : R;
        voffA[i] = (unsigned)(R * K + C) * 2u; voffB[i] = (unsigned)(Rb * K + C) * 2u; }
    const size_t kstep = (size_t)(BK * 2);
    const size_t hstep = (size_t)HALF * K * 2;
    const size_t tstep = 2 * hstep;
    const unsigned ldsw = (unsigned)wid * 1024u;
    const int aoff = lds_byte(wr * 64 + fr, fq * 8), boff = lds_byte(wc * 32 + fr, fq * 8);
#define PG8_SA(b, h) (((b) * 2 + (h)) * HTB)
#define PG8_SB(b, h) ((4 + (b) * 2 + (h)) * HTB)
#define PG8_STAGE(bufoff, gbase, voff) do { _Pragma("unroll") for (int _i = 0; _i < 2; ++_i) \
        __builtin_amdgcn_global_load_lds((const unsigned*)((const char*)(gbase) + (voff)[_i]), (PG8_LAS unsigned*)(lds + (bufoff) + ldsw + _i * 8192), 16, 0, 0); } while (0)
#define PG8_LDA(dst, b, h) do { _Pragma("unroll") for (int m = 0; m < 4; ++m) _Pragma("unroll") for (int k = 0; k < 2; ++k) dst[m][k] = *(const PG8_LAS bf16x8*)(lds + PG8_SA(b, h) + aoff + m * 2048 + k * 1024); } while (0)
#define PG8_LDB(dst, b, h) do { _Pragma("unroll") for (int n = 0; n < 2; ++n) _Pragma("unroll") for (int k = 0; k < 2; ++k) dst[n][k] = *(const PG8_LAS bf16x8*)(lds + PG8_SB(b, h) + boff + n * 2048 + k * 1024); } while (0)
#define PG8_MMA(ai, bj, At, Bt) do { __builtin_amdgcn_s_setprio(1); _Pragma("unroll") for (int m = 0; m < 4; ++m) _Pragma("unroll") for (int n = 0; n < 2; ++n) _Pragma("unroll") for (int k = 0; k < 2; ++k) \
        acc[ai][bj][m][n] = __builtin_amdgcn_mfma_f32_16x16x32_bf16(Bt[n][k], At[m][k], acc[ai][bj][m][n], 0, 0, 0); __builtin_amdgcn_s_setprio(0); } while (0)
#define PG8_WAIT_V(n) asm volatile("s_waitcnt vmcnt(" #n ")" ::: "memory")
#define PG8_WAIT_L(n) asm volatile("s_waitcnt lgkmcnt(" #n ")" ::: "memory")
#define PG8_BAR __builtin_amdgcn_s_barrier()
#define PG8_SCHED __builtin_amdgcn_sched_barrier(0)
    Unit cur, nxt; int ui = 0;
    if (!S.next(0, cur)) return;
    f32x4 acc[2][2][4][2];
#pragma unroll
    for (int a = 0; a < 2; ++a)
#pragma unroll
        for (int b = 0; b < 2; ++b)
#pragma unroll
            for (int m = 0; m < 4; ++m)
#pragma unroll
                for (int n = 0; n < 2; ++n) acc[a][b][m][n] = (f32x4){0.f, 0.f, 0.f, 0.f};
    bf16x8 At[4][2], B0[2][2], B1[2][2];
    const char* cA = (const char*)(cur.sel ? g.A2 : g.A) + (size_t)cur.pm * tstep; const char* cB = (const char*)(cur.sel ? g.Bt2 : g.Bt) + (size_t)cur.pn * tstep;
    S.a_ready(cur);
    PG8_STAGE(PG8_SB(0, 0), cB, voffB); PG8_STAGE(PG8_SA(0, 0), cA, voffA); PG8_STAGE(PG8_SB(0, 1), cB + hstep, voffB); PG8_STAGE(PG8_SA(0, 1), cA + hstep, voffA);
    if (wr == 1) PG8_BAR;
    PG8_WAIT_V(4); PG8_BAR;
    PG8_STAGE(PG8_SB(1, 0), cB + kstep, voffB); PG8_STAGE(PG8_SA(1, 0), cA + kstep, voffA); PG8_STAGE(PG8_SB(1, 1), cB + hstep + kstep, voffB);
    PG8_WAIT_V(6); PG8_BAR;
    PG8_STAMP();
    for (;;) {
        const bool has_next = S.next(ui + 1, nxt);
        const char* nA = has_next ? (const char*)(nxt.sel ? g.A2 : g.A) + (size_t)nxt.pm * tstep : cA; const char* nB = has_next ? (const char*)(nxt.sel ? g.Bt2 : g.Bt) + (size_t)nxt.pn * tstep : cB;
        for (int t = 0; t < nt; t += 2) {
            const bool last = (t == nt - 2);
            const char* a1 = cA + (size_t)(t + 1) * kstep;
            const char* a2 = last ? nA : cA + (size_t)(t + 2) * kstep; const char* b2 = last ? nB : cB + (size_t)(t + 2) * kstep;
            const char* a3 = a2 + kstep; const char* b3 = b2 + kstep;
            if (last && has_next) S.a_ready(nxt);
            PG8_LDB(B0, 0, 0); PG8_SCHED; PG8_LDA(At, 0, 0); PG8_STAGE(PG8_SA(1, 1), a1 + hstep, voffA);
            PG8_WAIT_L(8); PG8_BAR; PG8_WAIT_L(0); PG8_MMA(0, 0, At, B0); PG8_BAR; PG8_SCHED;
            PG8_LDB(B1, 0, 1); PG8_STAGE(PG8_SB(0, 0), b2, voffB);
            PG8_BAR; PG8_WAIT_L(0); PG8_MMA(0, 1, At, B1); PG8_BAR;
            PG8_LDA(At, 0, 1); PG8_STAGE(PG8_SA(0, 0), a2, voffA);
            PG8_BAR; PG8_WAIT_L(0); PG8_MMA(1, 0, At, B0); PG8_BAR; PG8_SCHED;
            PG8_STAGE(PG8_SB(0, 1), b2 + hstep, voffB);
            PG8_WAIT_V(6); PG8_BAR; PG8_MMA(1, 1, At, B1); PG8_BAR;
            PG8_LDB(B0, 1, 0); PG8_SCHED; PG8_LDA(At, 1, 0); PG8_STAGE(PG8_SA(0, 1), a2 + hstep, voffA);
            PG8_WAIT_L(8); PG8_BAR; PG8_WAIT_L(0); PG8_MMA(0, 0, At, B0); PG8_BAR; PG8_SCHED;
            PG8_LDB(B1, 1, 1); PG8_STAGE(PG8_SB(1, 0), b3, voffB);
            PG8_BAR; PG8_WAIT_L(0); PG8_MMA(0, 1, At, B1); PG8_BAR;
            PG8_LDA(At, 1, 1); PG8_STAGE(PG8_SA(1, 0), a3, voffA);
            PG8_BAR; PG8_WAIT_L(0); PG8_MMA(1, 0, At, B0); PG8_BAR; PG8_SCHED;
            PG8_STAGE(PG8_SB(1, 1), b3 + hstep, voffB);
            PG8_WAIT_V(6); PG8_BAR; PG8_MMA(1, 1, At, B1); PG8_BAR;
        }
        PG8_STAMP();
        if constexpr (!Epi::AFTER_DRAIN) { E(acc, cur, wr, wc, fr, fq); S.done(cur); }
        PG8_STAMP();
        if (!has_next) break;
#pragma unroll
        for (int a = 0; a < 2; ++a)
#pragma unroll
            for (int b = 0; b < 2; ++b)
#pragma unroll
                for (int m = 0; m < 4; ++m)
#pragma unroll
                    for (int n = 0; n < 2; ++n) acc[a][b][m][n] = (f32x4){0.f, 0.f, 0.f, 0.f};
        cur = nxt; cA = nA; cB = nB; ++ui;
    }
    PG8_WAIT_V(0);
    if (wr == 0) PG8_BAR;
    PG8_BAR;
    if constexpr (Epi::AFTER_DRAIN) { E.fused(acc, cur, wr, wc, fr, fq, lds, wid, lane); S.done(cur); }
    PG8_STAMP();
    if (STAMP && wid == 0) { stamps[lane] = lane < nts ? (((unsigned long long)(unsigned)ts_hi << 32) | (unsigned)ts_lo) : 0ull;
        if (lane == 62) stamps[62] = rt_entry; if (lane == 63) stamps[63] = (unsigned long long)wall_clock64(); }
#undef PG8_STAMP
#undef PG8_SA
#undef PG8_SB
#undef PG8_STAGE
#undef PG8_LDA
#undef PG8_LDB
#undef PG8_MMA
#undef PG8_WAIT_V
#undef PG8_WAIT_L
#undef PG8_BAR
#undef PG8_SCHED
}
}

__device__ __forceinline__ int win_src_col(int n) {
    if (n < 4096) return n;
    if (n < C_GA) return n + 16;
    if (n < C_IK) return n + 96;
    if (n < C_IW) return 6672 + (n - C_IK);
    if (n < C_BETA) return 6736 + (n - C_IW);
    if (n < C_A) return 4096 + (n - C_BETA);
    if (n < NIN) return 4104 + (n - C_A);
    return -1;
}
__device__ __forceinline__ bf16x8 pack8f(const f32x4 a, const f32x4 b) {
    u32x4 w; w.x = pk2(a.x, a.y); w.y = pk2(a.z, a.w); w.z = pk2(b.x, b.y); w.w = pk2(b.z, b.w);
    return __builtin_bit_cast(bf16x8, w);
}
template <bool PERMUTE>
__device__ __forceinline__ void transpose_item(const float* W, int ldw, bf16_t* WT, int k0, int n0, LAS float* tile) {
    const int tid = tidx(), j = tid & 63, i0 = tid >> 6;
    const int sc = PERMUTE ? win_src_col(n0 + j) : (n0 + j);
    const int scc = sc >= 0 ? sc : 0;
    float tv[8];
#pragma unroll
    for (int m = 0; m < 8; ++m) tv[m] = W[(size_t)(k0 + i0 + 8 * m) * ldw + scc];
#pragma unroll
    for (int m = 0; m < 8; ++m) { const int i = i0 + 8 * m; tile[i * 65 + j] = sc >= 0 ? tv[m] : 0.f; }
    lds_barrier();
    const int jn = tid >> 3, c = tid & 7;
    u32x4 o;
    o.x = pk2(tile[(8 * c + 0) * 65 + jn], tile[(8 * c + 1) * 65 + jn]); o.y = pk2(tile[(8 * c + 2) * 65 + jn], tile[(8 * c + 3) * 65 + jn]);
    o.z = pk2(tile[(8 * c + 4) * 65 + jn], tile[(8 * c + 5) * 65 + jn]); o.w = pk2(tile[(8 * c + 6) * 65 + jn], tile[(8 * c + 7) * 65 + jn]);
    *(u32x4*)(WT + (size_t)(n0 + jn) * 1024 + k0 + 8 * c) = o;
    lds_barrier();
}
__device__ __forceinline__ void cvt_stream(const Params& p, const float* src, bf16_t* dst, long n8) {
    for (long it = (long)blockIdx.x * 512 + tidx(); it < n8; it += (long)p.G * 512) {
        const f32x4 a = *(const f32x4*)(src + it * 8), b = *(const f32x4*)(src + it * 8 + 4);
        u32x4 o; o.x = pk2(a.x, a.y); o.y = pk2(a.z, a.w); o.z = pk2(b.x, b.y); o.w = pk2(b.z, b.w);
        *(u32x4*)(dst + it * 8) = o;
    }
}
__device__ __forceinline__ void phase0(const Params& p, LAS unsigned char* lds) {
    {
        const long NITEM = (long)DBATCH * PAST * (IDIM / 8), stride = (long)p.G * 512;
        for (long it0 = (long)blockIdx.x * 512 + tidx(); it0 < NITEM; it0 += 4 * stride) {
            f32x4 a[4], b[4];
#pragma unroll
            for (int k = 0; k < 4; ++k) {
                const long it = it0 + k * stride; const long itc = it < NITEM ? it : 0;
                const int c8 = (int)(itc & 7) * 8, s = (int)((itc >> 3) & (PAST - 1)), sb = (int)(itc >> 14);
                const int page = p.page_table[sb * NPAGES + (s >> 7)];
                const float* src = p.cache_ik + ((size_t)page * PAGE + (s & 127)) * IDIM + c8;
                a[k] = *(const f32x4*)src; b[k] = *(const f32x4*)(src + 4);
            }
#pragma unroll
            for (int k = 0; k < 4; ++k) {
                const long it = it0 + k * stride;
                if (it < NITEM) { u32x4 o; o.x = pk2(a[k].x, a[k].y); o.y = pk2(a[k].z, a[k].w); o.z = pk2(b[k].x, b[k].y); o.w = pk2(b[k].z, b[k].w); *(u32x4*)(p.IKC + it * 8) = o; }
            }
        }
    }
    {
        const long NITEM = (long)MPAD * 128, stride = (long)p.G * 512;
        for (long it0 = (long)blockIdx.x * 512 + tidx(); it0 < NITEM; it0 += 4 * stride) {
            f32x4 a[4], b[4]; bool ok[4];
#pragma unroll
            for (int k = 0; k < 4; ++k) {
                const long it = it0 + k * stride; const long itc = it < NITEM ? it : 0;
                const int row = (int)(itc >> 7), c8 = (int)(itc & 127) * 8;
                const float* src = xrow_ptr(p, row);
                ok[k] = src != nullptr; const float* sc = src ? src : p.meta;
                a[k] = *(const f32x4*)(sc + c8); b[k] = *(const f32x4*)(sc + c8 + 4);
            }
#pragma unroll
            for (int k = 0; k < 4; ++k) {
                const long it = it0 + k * stride;
                if (it < NITEM) {
                    const int row = (int)(it >> 7), c8 = (int)(it & 127) * 8;
                    u32x4 o = {0u, 0u, 0u, 0u};
                    if (ok[k]) { o.x = pk2(a[k].x, a[k].y); o.y = pk2(a[k].z, a[k].w); o.z = pk2(b[k].x, b[k].y); o.w = pk2(b[k].z, b[k].w); }
                    *(u32x4*)(p.XB + (size_t)row * D + c8) = o;
                }
            }
        }
    }
    LAS float* tile = (LAS float*)lds;
    constexpr int I_IN = 16 * (NPAD / 64), I_SQ = 16 * 16, NIT = I_IN + 3 * I_SQ;
    for (int it = blockIdx.x; it < NIT; it += p.G) {
        int r = it;
        if (r < I_IN) { transpose_item<true>(p.w_in, NIN, p.WINT, (r & 15) * 64, (r >> 4) * 64, tile); continue; } r -= I_IN;
        if (r < I_SQ) { transpose_item<false>(p.w_bg, D, p.WBGT, (r & 15) * 64, (r >> 4) * 64, tile); continue; } r -= I_SQ;
        if (r < I_SQ) { transpose_item<false>(p.w_ba, D, p.WBAT, (r & 15) * 64, (r >> 4) * 64, tile); continue; } r -= I_SQ;
        transpose_item<false>(p.w_out, D, p.WOUTT, (r & 15) * 64, (r >> 4) * 64, tile);
    }
    {
        const int tid = tidx(), lane = tid & 63, wave = __builtin_amdgcn_readfirstlane(tid >> 6), r = lane & 15, q = lane >> 4;
        for (int u = blockIdx.x; u < 16 * 16; u += p.G) {
            const int g = u >> 4, kb = u & 15;
            bf16x8 af[4];
            const float* asrc = p.peer_sub + ((size_t)g * 128 + wave * 16 + r) * 128 + 8 * q;
#pragma unroll
            for (int ks = 0; ks < 4; ++ks) { const f32x4 x0 = *(const f32x4*)(asrc + ks * 32), x1 = *(const f32x4*)(asrc + ks * 32 + 4); af[ks] = pack8f(x0, x1); }
            bf16x8 bfr[4][4];
#pragma unroll
            for (int kt = 0; kt < 4; ++kt) {
                const float* bsrc = p.peer_wq + (size_t)(kb * 64 + kt * 16 + r) * 2048 + g * 128 + 8 * q;
#pragma unroll
                for (int ks = 0; ks < 4; ++ks) { const f32x4 x0 = *(const f32x4*)(bsrc + ks * 32), x1 = *(const f32x4*)(bsrc + ks * 32 + 4); bfr[kt][ks] = pack8f(x0, x1); }
            }
#pragma unroll
            for (int kt = 0; kt < 4; ++kt) {
                f32x4 acc = {0.f, 0.f, 0.f, 0.f};
#pragma unroll
                for (int ks = 0; ks < 4; ++ks) acc = __builtin_amdgcn_mfma_f32_16x16x32_bf16(af[ks], bfr[kt][ks], acc, 0, 0, 0);
#pragma unroll
                for (int i = 0; i < 4; ++i) p.WQT[(size_t)(g * 128 + wave * 16 + 4 * q + i) * D + kb * 64 + kt * 16 + r] = f2bf(acc[i]);
            }
        }
    }
    {
        const int lane = tidx() & 63, gw = blockIdx.x * 8 + __builtin_amdgcn_readfirstlane(tidx() >> 6), ngw = p.G * 8;
        for (int e = gw; e < NEXP; e += ngw) {
            float x[2][16];
#pragma unroll
            for (int k = 0; k < 2; ++k) {
                const float* src = (k ? p.peer_v : p.peer_u) + (size_t)e * D + lane * 16;
#pragma unroll
                for (int i = 0; i < 16; i += 4) { const f32x4 a = *(const f32x4*)(src + i); x[k][i] = a.x; x[k][i + 1] = a.y; x[k][i + 2] = a.z; x[k][i + 3] = a.w; }
            }
            unsigned w[4];
#pragma unroll
            for (int k = 0; k < 2; ++k) {
                float am = 0.f, ss = 0.f;
#pragma unroll
                for (int i = 0; i < 16; ++i) { am = fmaxf(am, fabsf(x[k][i])); ss += x[k][i] * x[k][i]; }
                am = wave_max(am); ss = wave_sum(ss);
                const float rms = sqrtf(ss * (1.f / D));
                const float sc0 = k ? fminf(am * (1.f / 6.f), 0.49f * rms) : fminf(am * (1.f / 7.f), 0.345f * rms), sc = sc0 > 0.f ? sc0 : 1.f, inv = 1.f / sc;
#pragma unroll
                for (int dw = 0; dw < 2; ++dw) {
                    unsigned ww = 0u;
#pragma unroll
                    for (int j = 0; j < 8; ++j) {
                        const float y = x[k][8 * dw + j] * inv;
                        if (k) {
                            const float a = fabsf(y);
                            const int code = (a > 0.25f) + (a > 0.75f) + (a > 1.25f) + (a > 1.75f) + (a > 2.5f) + (a > 3.5f) + (a > 5.f);
                            ww |= (unsigned)(code | (y < 0.f ? 8 : 0)) << (4 * j);
                        } else {
                            int qv = (int)rintf(y); qv = qv > 7 ? 7 : (qv < -7 ? -7 : qv);
                            const int pos = j < 4 ? 2 * j : 2 * (j - 4) + 1;
                            ww |= (unsigned)(qv & 0xF) << (4 * pos);
                        }
                    }
                    w[2 * k + dw] = ww;
                }
                if (lane == 0) (k ? p.SV : p.SU)[e] = sc;
            }
            *(u32x4*)(p.PU8 + (size_t)e * D + lane * 16) = (u32x4){w[0], w[1], w[2], w[3]};
        }
    }
}

struct EpiInProj {
    static constexpr bool PERM = true, AFTER_DRAIN = false;
    bf16_t* parts; float* out; float* small_; bf16_t *kidx, *akc, *avc;
    __device__ __forceinline__ void operator()(const pg8::f32x4 (&acc)[2][2][4][2], const pg8::Unit& u, int wr, int wc, int fr, int fq) const {
        const int row0 = u.pm * 256 + wr * 64 + fr, col0 = u.pn * 256 + wc * 32 + 8 * fq;
#pragma unroll
        for (int ai = 0; ai < 2; ++ai)
#pragma unroll
            for (int m = 0; m < 4; ++m) {
                const int row = row0 + ai * 128 + m * 16;
#pragma unroll
                for (int bj = 0; bj < 2; ++bj) {
                    const int col = col0 + bj * 128;
                    const pg8::f32x4 v0 = acc[ai][bj][m][0], v1 = acc[ai][bj][m][1];
                    u32x4 w; w.x = pg8::cvt_pk_bf16(v0[0], v0[1]); w.y = pg8::cvt_pk_bf16(v0[2], v0[3]); w.z = pg8::cvt_pk_bf16(v1[0], v1[1]); w.w = pg8::cvt_pk_bf16(v1[2], v1[3]);
                    *(u32x4*)(parts + (size_t)row * NPAD + col) = w;
                    if (u.pn == 20 || u.pn == 21) {
                        *(u32x4*)((u.pn == 20 ? akc : avc) + (size_t)row * 256 + (col - u.pn * 256)) = w;
                        if (row < MR) {
                            const int c = col - u.pn * 256;
                            float* dst = (row < MP) ? out + (u.pn == 20 ? O_PK : O_PV) + (size_t)row * 256 + c : out + (u.pn == 20 ? O_SK : O_SV) + (size_t)(row - MP) * 256 + c;
                            *(pg8::f32x4*)dst = v0; *(pg8::f32x4*)(dst + 4) = v1;
                        }
                    } else if (u.pn == 34) {
                        const int c = col - C_IK;
                        if (c < 64) {
                            *(u32x4*)(kidx + (size_t)row * 64 + c) = w;
                            if (row < MR) { float* dst = (row < MP) ? out + O_PIK + (size_t)row * 64 + c : out + O_SIK + (size_t)(row - MP) * 64 + c; *(pg8::f32x4*)dst = v0; *(pg8::f32x4*)(dst + 4) = v1; }
                        } else if (c < 96) { float* dst = small_ + (size_t)row * 32 + (c - 64); *(pg8::f32x4*)dst = v0; *(pg8::f32x4*)(dst + 4) = v1; }
                    }
                }
            }
    }
};
__device__ __forceinline__ void phase1(const Params& p, LAS unsigned char* lds) {
    pg8::Gemm g; g.A = p.XB; g.Bt = p.WINT; g.M = MPAD; g.N = NPAD; g.K = D; g.A2 = p.XB; g.Bt2 = p.WINT;
    pg8::StaticOrder S; S.init(MPAD, NPAD, p.G, blockIdx.x);
    EpiInProj E; E.parts = p.PARTS; E.out = p.out; E.small_ = p.SMALL; E.kidx = p.KIDX; E.akc = p.AKC; E.avc = p.AVC;
    pg8::gemm_phase<EpiInProj, pg8::StaticOrder, false>(lds, g, S, E, nullptr);
}

template <int K>
__device__ __forceinline__ f32x4 mm_tile(const LAS bf16_t* A, int sa, const LAS bf16_t* Bt, int sb, int m0, int n0, f32x4 acc, int lane) {
    const int r = lane & 15, q = lane >> 4;
    const LAS bf16_t* ap = A + (m0 + r) * sa + 8 * q;
    const LAS bf16_t* bp = Bt + (n0 + r) * sb + 8 * q;
#pragma unroll
    for (int ks = 0; ks < K / 32; ++ks) {
        const bf16x8 a = *(const LAS bf16x8*)(ap + ks * 32);
        const bf16x8 b = *(const LAS bf16x8*)(bp + ks * 32);
        acc = __builtin_amdgcn_mfma_f32_16x16x32_bf16(a, b, acc, 0, 0, 0);
    }
    return acc;
}
__device__ __forceinline__ void st4_bf16(LAS bf16_t* p, f32x4 v) { u32x2 w; w.x = pk2(v[0], v[1]); w.y = pk2(v[2], v[3]); *(LAS u32x2*)p = w; }
__device__ __forceinline__ void st4_bf16_g(bf16_t* p, f32x4 v) { u32x2 w; w.x = pk2(v[0], v[1]); w.y = pk2(v[2], v[3]); *(u32x2*)p = w; }

template <int C> struct GBlob {
    static constexpr int KP = C < 32 ? 32 : C, JS = KP + 8;
    static constexpr int W = 64, QE = W + C * 272, P = QE + C * 272, KDT = P + C * JS * 2, U0T = KDT + 128 * JS * 2, END = U0T + 128 * JS * 2;
    static constexpr int MAIN_BYTES = U0T;
};

template <int C>
__device__ __forceinline__ void gdn_chunk_local(const Params& p, LAS unsigned char* lds, int rowbase, int nreal, int tok0, const float* sconv, int h, unsigned char* blob) {
    typedef GBlob<C> GB;
    constexpr int KP = GB::KP, JS = GB::JS;
    const int tid = tidx(), lane = tid & 63, wave = __builtin_amdgcn_readfirstlane(tid >> 6);
    LAS bf16_t* Kn = (LAS bf16_t*)lds;
    LAS bf16_t* Qn = Kn + C * 136;
    LAS bf16_t* KbT = Qn + C * 136;
    LAS bf16_t* VbT = KbT + 128 * JS;
    LAS bf16_t* KdT = VbT + 128 * JS;
    LAS bf16_t* Xa = KdT + 128 * JS;
    LAS bf16_t* XaT = Xa + C * JS;
    LAS bf16_t* Xb = XaT + C * JS;
    LAS bf16_t* XbT = Xb + C * JS;
    LAS bf16_t* Ta = XbT + C * JS;
    LAS bf16_t* Tb = Ta + C * JS;
    LAS float* gv = (LAS float*)(Tb + C * JS);
    LAS float* betav = gv + C;
    LAS float* lav = betav + C;

    if (C < 32) {
        LAS unsigned* z = (LAS unsigned*)KbT; const int nz = (3 * 128 * JS + 6 * C * JS) / 2;
        for (int i = tid; i < nz; i += 512) z[i] = 0u;
        lds_barrier();
    }
    float g_b = 0.f, g_a = 0.f;
    { const int t_ = tid >> 3; if ((tid & 7) == 0 && t_ < C && t_ < nreal) { const float* sm = p.SMALL + (size_t)(rowbase + t_) * 32; g_b = sm[16 + h]; g_a = sm[24 + h]; } }
    LAS bf16_t* raw = (C == 64) ? Xa : (LAS bf16_t*)(lds + 102400);
    LAS float* cw = lav + C;
    {
        constexpr int NPIECE = (C + 3) * 48, NIT = (NPIECE + 511) / 512;
        u32x4 pv[NIT]; f32x4 fa[NIT], fb[NIT];
#pragma unroll
        for (int k = 0; k < NIT; ++k) {
            const int i = tid + k * 512, ic = i < NPIECE ? i : 0;
            const int rr = ic / 48, c48 = ic % 48, ti = c48 >> 4, ch = (c48 & 15) * 8, dt = rr - 3;
            const int cb = ti * 1024 + h * 128 + ch;
            const bool inpast = dt < 0, have = dt < nreal && (sconv != nullptr || tok0 + dt >= 0);
            const int rowc = (have && !(sconv && inpast)) ? rowbase + dt : rowbase;
            pv[k] = *(const u32x4*)(p.PARTS + (size_t)rowc * NPAD + cb);
            if (sconv) { const float* src = sconv + (size_t)(inpast ? 3 + dt : 0) * CONVD + cb; fa[k] = *(const f32x4*)src; fb[k] = *(const f32x4*)(src + 4); }
        }
        float cwv[3];
#pragma unroll
        for (int k = 0; k < 3; ++k) { const int i = tid + k * 512, tap = i / 384, c = i % 384; cwv[k] = p.conv_w[(size_t)tap * CONVD + (c >> 7) * 1024 + h * 128 + (c & 127)]; }
#pragma unroll
        for (int k = 0; k < NIT; ++k) {
            const int i = tid + k * 512;
            if (i < NPIECE) {
                const int rr = i / 48, c48 = i % 48, ti = c48 >> 4, ch = (c48 & 15) * 8, dt = rr - 3;
                const bool inpast = dt < 0, have = dt < nreal && (sconv != nullptr || tok0 + dt >= 0);
                u32x4 v = pv[k];
                if (sconv && inpast) { v.x = pk2(fa[k].x, fa[k].y); v.y = pk2(fa[k].z, fa[k].w); v.z = pk2(fb[k].x, fb[k].y); v.w = pk2(fb[k].z, fb[k].w); }
                if (!have) v = (u32x4){0u, 0u, 0u, 0u};
                *(LAS u32x4*)(raw + rr * 392 + ti * 128 + ch) = v;
            }
        }
#pragma unroll
        for (int k = 0; k < 3; ++k) cw[tid + k * 512] = cwv[k];
    }
    lds_barrier();
    const int t = tid >> 3, part = tid & 7, ch0 = part * 16;
    float qv[16], kv[16], vv[16];
    const bool active = t < C;
    const bool real = active && t < nreal;
#pragma unroll
    for (int i = 0; i < 16; ++i) { qv[i] = 0.f; kv[i] = 0.f; vv[i] = 0.f; }
    if (real) {
#pragma unroll
        for (int ti = 0; ti < 3; ++ti) {
            float acc[16];
#pragma unroll
            for (int i = 0; i < 16; ++i) acc[i] = 0.f;
#pragma unroll
            for (int tap = 0; tap < 4; ++tap) {
                const LAS bf16_t* src = raw + (t + tap) * 392 + ti * 128 + ch0;
                const u32x4 a = *(const LAS u32x4*)src, b = *(const LAS u32x4*)(src + 8);
                const float xs[16] = {bflo(a.x), bfhi(a.x), bflo(a.y), bfhi(a.y), bflo(a.z), bfhi(a.z), bflo(a.w), bfhi(a.w), bflo(b.x), bfhi(b.x), bflo(b.y), bfhi(b.y), bflo(b.z), bfhi(b.z), bflo(b.w), bfhi(b.w)};
                const LAS float* wsrc = cw + tap * 384 + ti * 128 + ch0;
#pragma unroll
                for (int i = 0; i < 16; i += 4) { const f32x4 w = *(const LAS f32x4*)(wsrc + i); acc[i] += xs[i] * w.x; acc[i + 1] += xs[i + 1] * w.y; acc[i + 2] += xs[i + 2] * w.z; acc[i + 3] += xs[i + 3] * w.w; }
            }
#pragma unroll
            for (int i = 0; i < 16; ++i) { const float sv = acc[i] * sigmoidf_(acc[i]); if (ti == 0) qv[i] = sv; else if (ti == 1) kv[i] = sv; else vv[i] = sv; }
        }
    }
    float ssq = 0.f, ssk = 0.f;
#pragma unroll
    for (int i = 0; i < 16; ++i) { ssq += qv[i] * qv[i]; ssk += kv[i] * kv[i]; }
    {
        const int ln = tid & 63;
        ssq += __uint_as_float(lane_xor<1>(__float_as_uint(ssq), ln)); ssq += __uint_as_float(lane_xor<2>(__float_as_uint(ssq), ln)); ssq += __uint_as_float(lane_xor<4>(__float_as_uint(ssq), ln));
        ssk += __uint_as_float(lane_xor<1>(__float_as_uint(ssk), ln)); ssk += __uint_as_float(lane_xor<2>(__float_as_uint(ssk), ln)); ssk += __uint_as_float(lane_xor<4>(__float_as_uint(ssk), ln));
    }
    const float rq = rsqrtf(ssq + RMS_EPS) * 0.08838834764831845f, rk = rsqrtf(ssk + RMS_EPS);
#pragma unroll
    for (int i = 0; i < 16; ++i) { qv[i] *= rq; kv[i] *= rk; }
    if (active && part == 0) {
        float be = 0.f, la = 0.f;
        if (real) {
            be = sigmoidf_(g_b);
            const float xa = g_a + p.dt_bias[h];
            const float sp = xa > 20.f ? xa : log1pf(__expf(xa));
            la = -__expf(p.a_log[h]) * sp;
        }
        betav[t] = be; lav[t] = la;
    }
    lds_barrier();
    if (tid < 64) {
        float sv = tid < C ? lav[tid] : 0.f;
#pragma unroll
        for (int o = 1; o < 64; o <<= 1) { const float up = __shfl_up(sv, o); if (tid >= o) sv += up; }
        if (tid < C) gv[tid] = sv;
    }
    lds_barrier();
    const float glast = gv[C - 1];
    if (active) {
        const float g = gv[t], be = betav[t], eg = __expf(g), bk = be * eg, kd = __expf(glast - g);
        u32x4 w0, w1;
        w0.x = pk2(kv[0], kv[1]); w0.y = pk2(kv[2], kv[3]); w0.z = pk2(kv[4], kv[5]); w0.w = pk2(kv[6], kv[7]);
        w1.x = pk2(kv[8], kv[9]); w1.y = pk2(kv[10], kv[11]); w1.z = pk2(kv[12], kv[13]); w1.w = pk2(kv[14], kv[15]);
        *(LAS u32x4*)(Kn + t * 136 + ch0) = w0; *(LAS u32x4*)(Kn + t * 136 + ch0 + 8) = w1;
        w0.x = pk2(qv[0], qv[1]); w0.y = pk2(qv[2], qv[3]); w0.z = pk2(qv[4], qv[5]); w0.w = pk2(qv[6], qv[7]);
        w1.x = pk2(qv[8], qv[9]); w1.y = pk2(qv[10], qv[11]); w1.z = pk2(qv[12], qv[13]); w1.w = pk2(qv[14], qv[15]);
        *(LAS u32x4*)(Qn + t * 136 + ch0) = w0; *(LAS u32x4*)(Qn + t * 136 + ch0 + 8) = w1;
        w0.x = pk2(eg * qv[0], eg * qv[1]); w0.y = pk2(eg * qv[2], eg * qv[3]); w0.z = pk2(eg * qv[4], eg * qv[5]); w0.w = pk2(eg * qv[6], eg * qv[7]);
        w1.x = pk2(eg * qv[8], eg * qv[9]); w1.y = pk2(eg * qv[10], eg * qv[11]); w1.z = pk2(eg * qv[12], eg * qv[13]); w1.w = pk2(eg * qv[14], eg * qv[15]);
        bf16_t* qe = (bf16_t*)(blob + GB::QE) + t * 136 + ch0;
        *(u32x4*)qe = w0; *(u32x4*)(qe + 8) = w1;
#pragma unroll
        for (int i = 0; i < 16; ++i) {
            KbT[(ch0 + i) * JS + t] = f2bf(bk * kv[i]);
            VbT[(ch0 + i) * JS + t] = f2bf(be * vv[i]);
            KdT[(ch0 + i) * JS + t] = f2bf(kd * kv[i]);
        }
    }
    if (tid == 0) *(float*)blob = __expf(glast);
    lds_barrier();
    { const LAS u32x4* s = (const LAS u32x4*)KdT; u32x4* d = (u32x4*)(blob + GB::KDT);
      for (int i = tid; i < 128 * JS * 2 / 16; i += 512) d[i] = s[i]; }
    if (C < 32) {
        bf16_t* P = (bf16_t*)(blob + GB::P);
        for (int i = tid; i < C * (JS - C); i += 512) P[(i / (JS - C)) * JS + C + i % (JS - C)] = 0;
    }
    constexpr int NT = C / 16;
    LAS float* LT = (LAS float*)Xa;
    LAS bf16_t* Tc = (LAS bf16_t*)(LT + C * 68);
    for (int tl = wave; tl < NT * NT; tl += 8) {
        const int tm = tl / NT, tn = tl % NT, r = lane & 15, q = lane >> 4;
        f32x4 acc = {0.f, 0.f, 0.f, 0.f};
        acc = mm_tile<128>(Kn, 136, Kn, 136, tm * 16, tn * 16, acc, lane);
        const int j = tn * 16 + r; const float gj = gv[j];
        f32x4 x;
#pragma unroll
        for (int i = 0; i < 4; ++i) { const int tt = tm * 16 + 4 * q + i; x[i] = (j < tt) ? betav[tt] * __expf(gv[tt] - gj) * acc[i] : 0.f; }
        *(LAS f32x4*)(LT + j * 68 + tm * 16 + 4 * q) = x;
        f32x4 pc = {0.f, 0.f, 0.f, 0.f};
        pc = mm_tile<128>(Kn, 136, Qn, 136, tm * 16, tn * 16, pc, lane);
        const int t2 = tn * 16 + r; const float gt = gv[t2];
        f32x4 pv;
#pragma unroll
        for (int i = 0; i < 4; ++i) { const int jj = tm * 16 + 4 * q + i; pv[i] = (jj <= t2) ? __expf(gt - gv[jj]) * pc[i] : 0.f; }
        st4_bf16_g((bf16_t*)(blob + GB::P) + t2 * JS + tm * 16 + 4 * q, pv);
    }
    lds_barrier();
    if (wave * 8 < C) {
        const int c0 = __builtin_amdgcn_readfirstlane(wave) * 8;
        float x[8];
#pragma unroll
        for (int k = 0; k < 8; ++k) x[k] = (lane == c0 + k) ? 1.f : 0.f;
        const int lcol = lane < C ? lane : 0;
        float lc[4], lnx[4];
#pragma unroll
        for (int u = 0; u < 4; ++u) { const int jj = c0 + u < C ? c0 + u : C - 1; lc[u] = LT[jj * 68 + lcol]; }
#pragma unroll 1
        for (int j = c0; j < C - 1; j += 4) {
#pragma unroll
            for (int u = 0; u < 4; ++u) { const int jj = j + 4 + u < C ? j + 4 + u : C - 1; lnx[u] = LT[jj * 68 + lcol]; }
#pragma unroll
            for (int u = 0; u < 4; ++u) {
                if (j + u < C - 1) {
                    const float l = lc[u];
#pragma unroll
                    for (int k = 0; k < 8; ++k) { const float xj = __uint_as_float((unsigned)__builtin_amdgcn_readlane((int)__float_as_uint(x[k]), j + u)); x[k] = fmaf(-l, xj, x[k]); }
                }
            }
#pragma unroll
            for (int u = 0; u < 4; ++u) lc[u] = lnx[u];
        }
        if (lane < C) {
            u32x4 w; w.x = pk2(x[0], x[1]); w.y = pk2(x[2], x[3]); w.z = pk2(x[4], x[5]); w.w = pk2(x[6], x[7]);
            *(LAS u32x4*)(Tc + lane * JS + c0) = w;
        }
    }
    lds_barrier();
    for (int tl = wave; tl < 2 * 8 * NT; tl += 8) {
        const int which = tl / (8 * NT), tt = tl % (8 * NT), r = lane & 15, q = lane >> 4;
        f32x4 acc = {0.f, 0.f, 0.f, 0.f};
        if (which == 0) {
            const int tm = tt / NT, tn = tt % NT;
            acc = mm_tile<KP>(KbT, JS, Tc, JS, tm * 16, tn * 16, acc, lane);
            st4_bf16_g((bf16_t*)(blob + GB::W) + (tn * 16 + r) * 136 + tm * 16 + 4 * q, acc);
        } else {
            const int tm = tt / 8, tn = tt % 8;
            acc = mm_tile<KP>(Tc, JS, VbT, JS, tm * 16, tn * 16, acc, lane);
            st4_bf16_g((bf16_t*)(blob + GB::U0T) + (tn * 16 + r) * JS + tm * 16 + 4 * q, acc);
        }
    }
    if (C < 32) {
        bf16_t* U = (bf16_t*)(blob + GB::U0T);
        for (int i = tid; i < 128 * (JS - C); i += 512) U[(i / (JS - C)) * JS + C + i % (JS - C)] = 0;
    }
    lds_barrier();
}

__device__ __forceinline__ void phase2(const Params& p, LAS unsigned char* lds) {
    for (int it = blockIdx.x * 512 + tidx(); it < (NB + DBATCH) * 3 * (CONVD / 8); it += p.G * 512) {
        const int c8 = (it % (CONVD / 8)) * 8, ri = it / (CONVD / 8), i = ri % 3, bb = ri / 3;
        const int row = bb < NB ? bb * LP + (LP - 3) + i : MP + (bb - NB) * TS + (TS - 3) + i;
        float* dst = bb < NB ? p.out + O_PCONV + ((size_t)bb * 3 + i) * CONVD + c8 : p.out + O_SCONV + ((size_t)(bb - NB) * 3 + i) * CONVD + c8;
        const u32x4 a = *(const u32x4*)(p.PARTS + (size_t)row * NPAD + c8);
        *(f32x4*)dst = (f32x4){bflo(a.x), bfhi(a.x), bflo(a.y), bfhi(a.y)}; *(f32x4*)(dst + 4) = (f32x4){bflo(a.z), bfhi(a.z), bflo(a.w), bfhi(a.w)};
    }
    const int NU = NB * GH * NCHUNK + DBATCH * GH;
    for (int u = blockIdx.x; u < NU; u += p.G) {
        if (u < NB * GH * NCHUNK) {
            const int bh = u / NCHUNK, c = u % NCHUNK, b = bh >> 3, h = bh & 7;
            unsigned char* blob = p.GOPS + (size_t)u * BLOB64;
            if (c == 0) gdn_chunk_local<16>(p, lds, b * LP, 16, 0, nullptr, h, blob);
            else gdn_chunk_local<64>(p, lds, b * LP + 16 + 64 * (c - 1), 64, 16 + 64 * (c - 1), nullptr, h, blob);
        } else {
            const int v = u - NB * GH * NCHUNK, sb = v >> 3, h = v & 7;
            gdn_chunk_local<16>(p, lds, MP + sb * TS, TS, 0, p.state_conv + (size_t)sb * 3 * CONVD, h, p.GOPS_S + (size_t)v * BLOB16);
        }
    }
}

template <int C, int DVS>
__device__ __forceinline__ void gdn_scan_step(const LAS unsigned char* ops, LAS bf16_t* ST, LAS bf16_t* UT, f32x4 (&accS)[DVS / 16], float decay,
                                              bf16_t* orow  , int nreal, int wave, int lane) {
    typedef GBlob<C> GB;
    constexpr int KP = GB::KP, JS = GB::JS, NTN = DVS / 16, NT1 = (C / 16) * NTN;
    const LAS bf16_t* W = (const LAS bf16_t*)(ops + GB::W);
    const LAS bf16_t* QE = (const LAS bf16_t*)(ops + GB::QE);
    const LAS bf16_t* P = (const LAS bf16_t*)(ops + GB::P);
    const LAS bf16_t* KDT = (const LAS bf16_t*)(ops + GB::KDT);
    const LAS bf16_t* U0T = (const LAS bf16_t*)(ops + GB::U0T);
    const int r = lane & 15, q = lane >> 4;
    const int tm = wave / NTN, tn = wave % NTN;
    f32x4 acco = {0.f, 0.f, 0.f, 0.f};
    if (wave < NT1) {
        f32x4 ws = {0.f, 0.f, 0.f, 0.f};
        ws = mm_tile<128>(W, 136, ST, 136, tm * 16, tn * 16, ws, lane);
        const LAS u32x2* up = (const LAS u32x2*)(U0T + (tn * 16 + r) * JS + tm * 16 + 4 * q);
        const u32x2 u0 = *up;
        f32x4 u; u[0] = bflo(u0.x) - ws[0]; u[1] = bfhi(u0.x) - ws[1]; u[2] = bflo(u0.y) - ws[2]; u[3] = bfhi(u0.y) - ws[3];
        st4_bf16(UT + (tn * 16 + r) * JS + tm * 16 + 4 * q, u);
        acco = mm_tile<128>(QE, 136, ST, 136, tm * 16, tn * 16, acco, lane);
    }
    lds_barrier();
    if (wave < NT1) {
        acco = mm_tile<KP>(P, JS, UT, JS, tm * 16, tn * 16, acco, lane);
#pragma unroll
        for (int i = 0; i < 4; ++i) { const int t = tm * 16 + 4 * q + i; if (t < nreal) orow[(size_t)t * D + tn * 16 + r] = f2bf(acco[i]); }
    }
#pragma unroll
    for (int n = 0; n < NTN; ++n) {
        f32x4 a = accS[n] * decay;
        a = mm_tile<KP>(KDT, JS, UT, JS, wave * 16, n * 16, a, lane);
        accS[n] = a;
        st4_bf16(ST + (n * 16 + r) * 136 + wave * 16 + 4 * q, a);
    }
}

template <int C, int DVS, int NR>
__device__ __forceinline__ void gdn_ops_load(const unsigned char* blob, int dv0, u32x4 (&regs)[NR], int tid) {
    typedef GBlob<C> GB;
    constexpr int MAINB = GB::MAIN_BYTES, UB = DVS * GB::JS * 2, TOT = MAINB + UB;
    static_assert(NR * 512 * 16 >= TOT, "NR too small");
#pragma unroll
    for (int i = 0; i < NR; ++i) {
        const int off = (tid + i * 512) * 16;
        const int offc = off < TOT ? off : 0;
        const int so = offc < MAINB ? offc : (GB::U0T + dv0 * GB::JS * 2 + (offc - MAINB));
        regs[i] = *(const u32x4*)(blob + so);
    }
}
template <int C, int DVS, int NR>
__device__ __forceinline__ void gdn_ops_store(LAS unsigned char* ops, const u32x4 (&regs)[NR], int tid) {
    typedef GBlob<C> GB;
    constexpr int TOT = GB::MAIN_BYTES + DVS * GB::JS * 2;
#pragma unroll
    for (int i = 0; i < NR; ++i) { const int off = (tid + i * 512) * 16; if (off < TOT) *(LAS u32x4*)(ops + off) = regs[i]; }
}

__device__ __forceinline__ void phase3(const Params& p, LAS unsigned char* lds) {
    const int tid = tidx(), lane = tid & 63, wave = __builtin_amdgcn_readfirstlane(tid >> 6), r = lane & 15, q = lane >> 4;
    constexpr int OPS64 = GBlob<64>::MAIN_BYTES + 32 * GBlob<64>::JS * 2;
    LAS unsigned char* ops0 = lds;
    LAS unsigned char* ops1 = lds + 67584;
    LAS bf16_t* ST = (LAS bf16_t*)(lds + 2 * 67584);
    LAS bf16_t* UT = (LAS bf16_t*)(lds + 2 * 67584 + 8704);
    for (int vu = blockIdx.x; vu < 256; vu += p.G) {
        const int xg = vu & 7, idx = vu >> 3, bh = xg * 8 + (idx >> 2), sl = idx & 3, b = bh >> 3, h = bh & 7, dv0 = sl * 32;
        f32x4 accS[2] = {{0.f, 0.f, 0.f, 0.f}, {0.f, 0.f, 0.f, 0.f}};
        for (int i = tid; i < 32 * 136 / 2; i += 512) ((LAS unsigned*)ST)[i] = 0u;
        for (int i = tid; i < 32 * 72 / 2; i += 512) ((LAS unsigned*)UT)[i] = 0u;
        const unsigned char* blob0 = p.GOPS + (size_t)(bh * NCHUNK) * BLOB64;
        u32x4 regs[9];
        { u32x4 r16[4]; gdn_ops_load<16, 32, 4>(blob0, dv0, r16, tid); gdn_ops_store<16, 32, 4>(ops0, r16, tid); }
        gdn_ops_load<64, 32, 9>(blob0 + BLOB64, dv0, regs, tid);
        lds_barrier();
        gdn_scan_step<16, 32>(ops0, ST, UT, accS, *(const LAS float*)ops0, p.ORAW + (size_t)(b * LP) * D + h * 128 + dv0, 16, wave, lane);
        gdn_ops_store<64, 32, 9>(ops1, regs, tid);
        lds_barrier();
#pragma unroll 1
        for (int c = 1; c < NCHUNK; ++c) {
            const unsigned char* blob = blob0 + (size_t)c * BLOB64;
            LAS unsigned char* cur = (c & 1) ? ops1 : ops0;
            LAS unsigned char* nxt = (c & 1) ? ops0 : ops1;
            if (c + 1 < NCHUNK) gdn_ops_load<64, 32, 9>(blob + BLOB64, dv0, regs, tid);
            gdn_scan_step<64, 32>(cur, ST, UT, accS, *(const LAS float*)cur, p.ORAW + (size_t)(b * LP + 16 + 64 * (c - 1)) * D + h * 128 + dv0, 64, wave, lane);
            if (c + 1 < NCHUNK) gdn_ops_store<64, 32, 9>(nxt, regs, tid);
            lds_barrier();
        }
#pragma unroll
        for (int n = 0; n < 2; ++n)
#pragma unroll
            for (int i = 0; i < 4; ++i) p.out[O_PDELTA + ((size_t)bh * 128 + wave * 16 + 4 * q + i) * 128 + dv0 + n * 16 + r] = accS[n][i];
        lds_barrier();
    }
    LAS bf16_t* STs = (LAS bf16_t*)(lds + 32768);
    LAS bf16_t* UTs = (LAS bf16_t*)(lds + 32768 + 34816);
    for (int v = blockIdx.x; v < DBATCH * GH; v += p.G) {
        const int sb = v >> 3, h = v & 7;
        const unsigned char* blob = p.GOPS_S + (size_t)v * BLOB16;
        u32x4 r16[4]; gdn_ops_load<16, 128, 4>(blob, 0, r16, tid); gdn_ops_store<16, 128, 4>(ops0, r16, tid);
        for (int i = tid; i < 128 * 40 / 2; i += 512) ((LAS unsigned*)UTs)[i] = 0u;
        f32x4 accS[8];
        const float* s0 = p.state_delta + (size_t)v * 128 * 128;
#pragma unroll
        for (int n = 0; n < 8; ++n) {
#pragma unroll
            for (int i = 0; i < 4; ++i) accS[n][i] = s0[(size_t)(wave * 16 + 4 * q + i) * 128 + n * 16 + r];
            st4_bf16(STs + (n * 16 + r) * 136 + wave * 16 + 4 * q, accS[n]);
        }
        lds_barrier();
        gdn_scan_step<16, 128>(ops0, STs, UTs, accS, *(const LAS float*)ops0, p.ORAW + (size_t)(MP + sb * TS) * D + h * 128, TS, wave, lane);
#pragma unroll
        for (int n = 0; n < 8; ++n)
#pragma unroll
            for (int i = 0; i < 4; ++i) p.out[O_SDELTA + ((size_t)v * 128 + wave * 16 + 4 * q + i) * 128 + n * 16 + r] = accS[n][i];
        lds_barrier();
    }
}

__device__ __forceinline__ void phase4(const Params& p, LAS unsigned char* lds) {
    const int lane = tidx() & 63, gw = blockIdx.x * 8 + __builtin_amdgcn_readfirstlane(tidx() >> 6), ngw = p.G * 8;
    const float* gn = p.gnorm + (lane & 7) * 16;
    float gnv[16];
#pragma unroll
    for (int i = 0; i < 16; ++i) gnv[i] = gn[i];
    for (int row0 = gw; row0 < MF; row0 += 2 * ngw) {
        u32x4 oa[2], ob[2], za[2], zb[2];
#pragma unroll
        for (int k = 0; k < 2; ++k) {
            const int row = full_row(row0 + k * ngw < MF ? row0 + k * ngw : row0);
            oa[k] = *(const u32x4*)(p.ORAW + (size_t)row * D + lane * 16); ob[k] = *(const u32x4*)(p.ORAW + (size_t)row * D + lane * 16 + 8);
            za[k] = *(const u32x4*)(p.PARTS + (size_t)row * NPAD + C_Z + lane * 16); zb[k] = *(const u32x4*)(p.PARTS + (size_t)row * NPAD + C_Z + lane * 16 + 8);
        }
#pragma unroll
        for (int k = 0; k < 2; ++k) {
            const int row = row0 + k * ngw;
            if (row < MF) {
                const u32x4 a = oa[k], b = ob[k];
                float o[16] = {bflo(a.x), bfhi(a.x), bflo(a.y), bfhi(a.y), bflo(a.z), bfhi(a.z), bflo(a.w), bfhi(a.w), bflo(b.x), bfhi(b.x), bflo(b.y), bfhi(b.y), bflo(b.z), bfhi(b.z), bflo(b.w), bfhi(b.w)};
                float ss = 0.f;
#pragma unroll
                for (int i = 0; i < 16; ++i) ss += o[i] * o[i];
                ss += __uint_as_float(lane_xor<1>(__float_as_uint(ss), lane)); ss += __uint_as_float(lane_xor<2>(__float_as_uint(ss), lane)); ss += __uint_as_float(lane_xor<4>(__float_as_uint(ss), lane));
                const float rs = rsqrtf(ss * (1.f / 128.f) + RMS_EPS);
                const u32x4 zx = za[k], zy = zb[k];
                const float z[16] = {bflo(zx.x), bfhi(zx.x), bflo(zx.y), bfhi(zx.y), bflo(zx.z), bfhi(zx.z), bflo(zx.w), bfhi(zx.w), bflo(zy.x), bfhi(zy.x), bflo(zy.y), bfhi(zy.y), bflo(zy.z), bfhi(zy.z), bflo(zy.w), bfhi(zy.w)};
                float y[16];
#pragma unroll
                for (int i = 0; i < 16; ++i) y[i] = o[i] * rs * gnv[i] * (z[i] * sigmoidf_(z[i]));
                u32x4 w0, w1;
                w0.x = pk2(y[0], y[1]); w0.y = pk2(y[2], y[3]); w0.z = pk2(y[4], y[5]); w0.w = pk2(y[6], y[7]);
                w1.x = pk2(y[8], y[9]); w1.y = pk2(y[10], y[11]); w1.z = pk2(y[12], y[13]); w1.w = pk2(y[14], y[15]);
                *(u32x4*)(p.OGDN + (size_t)row * D + lane * 16) = w0; *(u32x4*)(p.OGDN + (size_t)row * D + lane * 16 + 8) = w1;
            }
        }
    }
}

constexpr int SCS = 2116;
__device__ __forceinline__ bf16x8 pack8(const f32x4 a, const f32x4 b) {
    u32x4 w; w.x = pk2(a.x, a.y); w.y = pk2(a.z, a.w); w.z = pk2(b.x, b.y); w.w = pk2(b.z, b.w);
    return __builtin_bit_cast(bf16x8, w);
}
template <bool SAMPLE>
__device__ __forceinline__ void indexer_unit(const Params& p, LAS unsigned char* lds, int qrow0, int nq, int qpos0, int krow0, int sb) {
    const int tid = tidx(), lane = tid & 63, wave = __builtin_amdgcn_readfirstlane(tid >> 6), r = lane & 15, q = lane >> 4;
    LAS float* sc = (LAS float*)lds;
    SEG_DECL
    const int lastq = qpos0 + 15;
    const int nkt = SAMPLE ? (PAST + TS + 15) / 16 : (lastq / 16 + 1);
#pragma unroll 1
    for (int pass = 0; pass < 2; ++pass) {
        bf16x8 qf[8][2];
        float wq[8];
        {
            const bf16_t* qsrc = p.PARTS + (size_t)(qrow0 + r) * NPAD + C_IQ + pass * 512 + 8 * q;
#pragma unroll
            for (int hd = 0; hd < 8; ++hd)
#pragma unroll
                for (int ks = 0; ks < 2; ++ks) qf[hd][ks] = *(const bf16x8*)(qsrc + hd * 64 + ks * 32);
            const float* wsrc = p.SMALL + (size_t)(qrow0 + r) * 32 + pass * 8;
#pragma unroll
            for (int hd = 0; hd < 8; ++hd) wq[hd] = wsrc[hd] * 0.03125f;
        }
        auto load_kf = [&](int kt_, bf16x8 (&kf)[2]) {
            const int kt = kt_ < nkt ? kt_ : nkt - 1;
            const int s = kt * 16 + r;
            if (SAMPLE) {
                if (kt * 16 < PAST) {
                    const bf16_t* src = p.IKC + ((size_t)sb * PAST + s) * IDIM + 8 * q;
#pragma unroll
                    for (int ks = 0; ks < 2; ++ks) kf[ks] = *(const bf16x8*)(src + ks * 32);
                } else {
                    const int sn = s - PAST < TS ? s - PAST : TS - 1;
                    const bf16_t* src = p.PARTS + (size_t)(MP + sb * TS + sn) * NPAD + C_IK + 8 * q;
#pragma unroll
                    for (int ks = 0; ks < 2; ++ks) kf[ks] = *(const bf16x8*)(src + ks * 32);
                }
            } else {
                const int sc_ = s < LP ? s : LP - 1;
                const bf16_t* src = p.KIDX + (size_t)(krow0 + sc_) * 64 + 8 * q;
#pragma unroll
                for (int ks = 0; ks < 2; ++ks) kf[ks] = *(const bf16x8*)(src + ks * 32);
            }
        };
        bf16x8 kcur[4][2], knxt[4][2];
#pragma unroll
        for (int j = 0; j < 4; ++j) load_kf(wave + 8 * j, kcur[j]);
#pragma unroll 1
        for (int kb = wave; kb < nkt; kb += 32) {
#pragma unroll
            for (int j = 0; j < 4; ++j) load_kf(kb + 32 + 8 * j, knxt[j]);
#pragma unroll
            for (int j = 0; j < 4; ++j) {
                const int kt = kb + 8 * j;
                if (kt < nkt) {
                    f32x4 acc[8];
#pragma unroll
                    for (int hd = 0; hd < 8; ++hd) acc[hd] = __builtin_amdgcn_mfma_f32_16x16x32_bf16(kcur[j][0], qf[hd][0], (f32x4){0.f, 0.f, 0.f, 0.f}, 0, 0, 0);
#pragma unroll
                    for (int hd = 0; hd < 8; ++hd) acc[hd] = __builtin_amdgcn_mfma_f32_16x16x32_bf16(kcur[j][1], qf[hd][1], acc[hd], 0, 0, 0);
                    f32x4 tot = {0.f, 0.f, 0.f, 0.f};
#pragma unroll
                    for (int hd = 0; hd < 8; ++hd)
#pragma unroll
                        for (int i = 0; i < 4; ++i) tot[i] = fmaf(wq[hd], __builtin_amdgcn_fmed3f(acc[hd][i], 0.f, 3.0e38f), tot[i]);
                    LAS f32x4* dst = (LAS f32x4*)(sc + r * SCS + kt * 16 + 4 * q);
                    if (pass == 0) *dst = tot; else *dst = *dst + tot;
                }
            }
#pragma unroll
            for (int j = 0; j < 4; ++j) { kcur[j][0] = knxt[j][0]; kcur[j][1] = knxt[j][1]; }
        }
    }
    lds_barrier();
    SEG(SAMPLE ? 2 : 0);
#pragma unroll 1
    for (int qq = 0; qq < 2; ++qq) {
        const int qi = wave * 2 + qq;
        if (qi >= nq) continue;
        const int tpos = qpos0 + qi;
        LAS int* hist = (LAS int*)(lds + 16 * SCS * 4 + wave * 3344);
        LAS float* cval = (LAS float*)(hist + 256);
        LAS int* cidx = (LAS int*)(hist + 512);
        LAS unsigned* cbits = (LAS unsigned*)(hist + 768);
        float val[33];
#pragma unroll
        for (int j = 0; j < 33; ++j) { const int s = lane + 64 * j; val[j] = (s <= tpos) ? sc[qi * SCS + s] : -3.0e38f; }
        unsigned long long mymask = 0ull;
        if (tpos < TOPK) {
#pragma unroll
            for (int j = 0; j < 33; ++j) { const unsigned long long m = __ballot(lane + 64 * j <= tpos); if (lane == j) mymask = m; }
        } else {
            float vmx = -3.0e38f, vmn = 3.0e38f;
#pragma unroll
            for (int j = 0; j < 33; ++j) { vmx = fmaxf(vmx, val[j]); vmn = fminf(vmn, (lane + 64 * j <= tpos) ? val[j] : 3.0e38f); }
            vmx = wave_max(vmx); vmn = -wave_max(-vmn);
            const float scale = vmx > vmn ? 255.99f / (vmx - vmn) : 0.f;
            *(LAS f32x4*)(hist + 4 * lane) = (f32x4){0.f, 0.f, 0.f, 0.f};
            if (lane < 33) { cbits[2 * lane] = 0u; cbits[2 * lane + 1] = 0u; }
            if (lane == 0) cidx[255] = 0;
            __builtin_amdgcn_fence(__ATOMIC_SEQ_CST, "wavefront");
            int bk[33];
#pragma unroll
            for (int j = 0; j < 33; ++j) {
                int b = (int)((val[j] - vmn) * scale); b = b < 0 ? 0 : (b > 255 ? 255 : b);
                bk[j] = (lane + 64 * j <= tpos) ? b : -1;
                if (bk[j] >= 0) __hip_atomic_fetch_add((LAS int*)hist + bk[j], 1, __ATOMIC_RELAXED, __HIP_MEMORY_SCOPE_WAVEFRONT);
            }
            __builtin_amdgcn_fence(__ATOMIC_SEQ_CST, "wavefront");
            int bstar, need, nc;
            {
                const int h0 = hist[4 * lane], h1 = hist[4 * lane + 1], h2 = hist[4 * lane + 2], h3 = hist[4 * lane + 3];
                const int tl = h0 + h1 + h2 + h3;
                int sfx = tl;
#pragma unroll
                for (int o = 1; o < 64; o <<= 1) { const int v = __shfl_down(sfx, o); if (lane + o < 64) sfx += v; }
                const int above = sfx - tl;
                const bool mine = above < TOPK && TOPK <= sfx;
                int bsel, asel, hsel;
                if (above + h3 >= TOPK) { bsel = 3; asel = above; hsel = h3; }
                else if (above + h3 + h2 >= TOPK) { bsel = 2; asel = above + h3; hsel = h2; }
                else if (above + h3 + h2 + h1 >= TOPK) { bsel = 1; asel = above + h3 + h2; hsel = h1; }
                else { bsel = 0; asel = above + h3 + h2 + h1; hsel = h0; }
                const unsigned long long bm = __ballot(mine);
                const int src = bm ? (int)__ffsll((long long)bm) - 1 : 0;
                bstar = __shfl(4 * lane + bsel, src); need = TOPK - __shfl(asel, src); nc = __shfl(hsel, src);
            }
            if (nc > need && nc <= 255) {
#pragma unroll
                for (int j = 0, base = 0; j < 33; ++j) {
                    const bool hit = bk[j] == bstar;
                    const unsigned long long mm = __ballot(hit);
                    if (mm) {
                        if (hit) { const int pos = base + (int)__builtin_amdgcn_mbcnt_hi((unsigned)(mm >> 32), __builtin_amdgcn_mbcnt_lo((unsigned)mm, 0u)); cval[pos] = val[j]; cidx[pos] = lane + 64 * j; }
                        base += __popcll(mm);
                    }
                }
                __builtin_amdgcn_fence(__ATOMIC_SEQ_CST, "wavefront");
                for (int c0 = 0; c0 < nc; c0 += 64) {
                    const int c = c0 + lane;
                    if (c < nc) {
                        const float v = cval[c]; const int ix = cidx[c]; int rank = 0;
                        for (int k = 0; k < nc; ++k) { const float w = cval[k]; const int wi = cidx[k]; rank += (w > v || (w == v && wi < ix)) ? 1 : 0; }
                        if (rank < need) __hip_atomic_fetch_or((LAS unsigned*)cbits + (ix >> 5), 1u << (ix & 31), __ATOMIC_RELAXED, __HIP_MEMORY_SCOPE_WAVEFRONT);
                    }
                }
                __builtin_amdgcn_fence(__ATOMIC_SEQ_CST, "wavefront");
#pragma unroll
                for (int j = 0; j < 33; ++j) { const unsigned long long mg = __ballot(bk[j] > bstar); if (lane == j) mymask = mg; }
                if (lane < 33) mymask |= (unsigned long long)cbits[2 * lane] | ((unsigned long long)cbits[2 * lane + 1] << 32);
            } else if (nc == need) {
#pragma unroll
                for (int j = 0; j < 33; ++j) { const unsigned long long mg = __ballot(bk[j] >= bstar); if (lane == j) mymask = mg; }
            } else {
                unsigned key[33];
#pragma unroll
                for (int j = 0; j < 33; ++j) { const unsigned u = __float_as_uint(val[j]); const unsigned srt = (u & 0x80000000u) ? ~u : (u | 0x80000000u); key[j] = (lane + 64 * j <= tpos) ? srt : 0u; }
                unsigned prefix = 0u, himask = 0u; int need2 = TOPK;
#pragma unroll 1
                for (int pass = 3; pass >= 0; --pass) {
                    const int sh = 8 * pass;
                    __builtin_amdgcn_fence(__ATOMIC_SEQ_CST, "wavefront");
                    *(LAS f32x4*)(hist + 4 * lane) = (f32x4){0.f, 0.f, 0.f, 0.f};
                    __builtin_amdgcn_fence(__ATOMIC_SEQ_CST, "wavefront");
#pragma unroll
                    for (int j = 0; j < 33; ++j) if ((key[j] & himask) == prefix) __hip_atomic_fetch_add((LAS int*)hist + ((key[j] >> sh) & 255u), 1, __ATOMIC_RELAXED, __HIP_MEMORY_SCOPE_WAVEFRONT);
                    __builtin_amdgcn_fence(__ATOMIC_SEQ_CST, "wavefront");
                    const int h0 = hist[4 * lane], h1 = hist[4 * lane + 1], h2 = hist[4 * lane + 2], h3 = hist[4 * lane + 3];
                    const int tl = h0 + h1 + h2 + h3;
                    int sfx = tl;
#pragma unroll
                    for (int o = 1; o < 64; o <<= 1) { const int v = __shfl_down(sfx, o); if (lane + o < 64) sfx += v; }
                    const int above = sfx - tl;
                    const bool mine = above < need2 && need2 <= sfx;
                    int bsel, asel;
                    if (above + h3 >= need2) { bsel = 3; asel = above; }
                    else if (above + h3 + h2 >= need2) { bsel = 2; asel = above + h3; }
                    else if (above + h3 + h2 + h1 >= need2) { bsel = 1; asel = above + h3 + h2; }
                    else { bsel = 0; asel = above + h3 + h2 + h1; }
                    const unsigned long long bm = __ballot(mine);
                    const int src = bm ? (int)__ffsll((long long)bm) - 1 : 0;
                    const int bs = __shfl(4 * lane + bsel, src), aab = __shfl(asel, src);
                    prefix |= (unsigned)bs << sh; himask |= 255u << sh; need2 -= aab;
                }
#pragma unroll
                for (int j = 0; j < 33; ++j) {
                    const unsigned long long mg = __ballot(key[j] > prefix);
                    unsigned long long me = __ballot(key[j] == prefix);
                    const int ne = __popcll(me);
                    if (ne <= need2) need2 -= ne;
                    else { while (__popcll(me) > need2) me &= ~(1ull << (63 - __clzll(me))); need2 = 0; }
                    if (lane == j) mymask = mg | me;
                }
            }
        }
        if (lane < 33) p.MASK[(size_t)(qrow0 + qi) * 33 + lane] = mymask;
    }
    lds_barrier();
    SEG(SAMPLE ? 3 : 1);
#if STAMPS == 2
    if (blockIdx.x == 0 && threadIdx.x == 0) atomicAdd(&p.bar[3620 + (SAMPLE ? 5 : 4)], 100u);
#endif
}
__device__ __forceinline__ void phase5(const Params& p, LAS unsigned char* lds) {
    constexpr int NQT = LP / 16;
    const int NU = NB * NQT + DBATCH;
    LAS int* slot = (LAS int*)(lds + 163840 - 32);
    for (;;) {
        lds_barrier();
        if (tidx() == 0) *slot = (int)__hip_atomic_fetch_add(p.bar + 3700, 1u, __ATOMIC_RELAXED, __HIP_MEMORY_SCOPE_AGENT);
        lds_barrier();
        const int u = *slot;
        if (u >= NU) break;
        if (u < DBATCH) indexer_unit<true>(p, lds, MP + u * TS, TS, PAST, 0, u);
        else { const int v = u - DBATCH, b = v % NB, qt = NQT - 1 - v / NB; indexer_unit<false>(p, lds, b * LP + qt * 16, 16, qt * 16, b * LP, 0); }
    }
}

typedef short s16x4 __attribute__((ext_vector_type(4)));
constexpr int VS = 144;
template <int NRT, bool QLDS>
__device__ __forceinline__ void attn_tile32(const LAS bf16_t* Ks, const LAS bf16_t* Vt, const bf16x8 (&qfr)[NRT][4], const LAS bf16x8* qlds, const unsigned (&mbits)[NRT], float (&m)[NRT], float (&l)[NRT], f32x4 (&acco)[NRT][8], int lane) {
    const int r = lane & 15, q = lane >> 4;
    constexpr float CSC = 0.12751743082459868f;
    bf16x8 qf[NRT][4];
#pragma unroll
    for (int rt = 0; rt < NRT; ++rt)
#pragma unroll
        for (int ks = 0; ks < 4; ++ks) qf[rt][ks] = QLDS ? qlds[(rt * 4 + ks) * 64 + lane] : qfr[rt][ks];
    f32x4 s[NRT][2];
#pragma unroll
    for (int sub = 0; sub < 2; ++sub) {
        const LAS bf16_t* kp = Ks + (sub * 16 + r) * 136 + 8 * q;
#pragma unroll
        for (int rt = 0; rt < NRT; ++rt) s[rt][sub] = (f32x4){0.f, 0.f, 0.f, 0.f};
#pragma unroll
        for (int ks = 0; ks < 4; ++ks) {
            const bf16x8 kf = *(const LAS bf16x8*)(kp + ks * 32);
#pragma unroll
            for (int rt = 0; rt < NRT; ++rt) s[rt][sub] = __builtin_amdgcn_mfma_f32_16x16x32_bf16(kf, qf[rt][ks], s[rt][sub], 0, 0, 0);
        }
    }
#if !defined(ATTN_OVERLAP) || ATTN_OVERLAP < 2
    __builtin_amdgcn_sched_barrier(0);
#endif
    bf16x8 pf[NRT];
#pragma unroll
    for (int rt = 0; rt < NRT; ++rt) {
        float tmax;
        asm("v_max3_f32 %0, %1, %2, %3" : "=v"(tmax) : "v"(s[rt][0][0]), "v"(s[rt][0][1]), "v"(s[rt][0][2]));
        asm("v_max3_f32 %0, %1, %2, %3" : "=v"(tmax) : "v"(tmax), "v"(s[rt][0][3]), "v"(s[rt][1][0]));
        asm("v_max3_f32 %0, %1, %2, %3" : "=v"(tmax) : "v"(tmax), "v"(s[rt][1][1]), "v"(s[rt][1][2]));
        asm("v_max_f32 %0, %1, %2" : "=v"(tmax) : "v"(tmax), "v"(s[rt][1][3]));
        tmax = fmaxf(tmax, __uint_as_float(lane_xor<16>(__float_as_uint(tmax), lane))); tmax = fmaxf(tmax, __uint_as_float(lane_xor<32>(__float_as_uint(tmax), lane)));
        const bool big = (tmax - m[rt]) * CSC > 8.f;
        if (__any(big)) {
            const float mn = big ? tmax : m[rt];
            const float alpha = __builtin_amdgcn_exp2f((m[rt] - mn) * CSC);
            m[rt] = mn; l[rt] *= alpha;
#pragma unroll
            for (int dt = 0; dt < 8; ++dt) acco[rt][dt] *= alpha;
        }
        const float nb = -m[rt] * CSC;
        const int mq = (int)(mbits[rt] >> (4 * q));
        float psum = 0.f;
#pragma unroll
        for (int sub = 0; sub < 2; ++sub)
#pragma unroll
            for (int i = 0; i < 4; ++i) {
                const float e = __builtin_amdgcn_exp2f(fmaf(s[rt][sub][i], CSC, nb));
                int mk; asm("v_bfe_i32 %0, %1, %2, 1" : "=v"(mk) : "v"(mq), "n"(sub * 16 + i));
                const float pv = __uint_as_float(__float_as_uint(e) & (unsigned)mk);
                s[rt][sub][i] = pv; psum += pv;
            }
        l[rt] += psum;
        {
            u32x4 w;
            asm("v_cvt_pk_bf16_f32 %0, %1, %2" : "=v"(w.x) : "v"(s[rt][0][0]), "v"(s[rt][0][1]));
            asm("v_cvt_pk_bf16_f32 %0, %1, %2" : "=v"(w.y) : "v"(s[rt][0][2]), "v"(s[rt][0][3]));
            asm("v_cvt_pk_bf16_f32 %0, %1, %2" : "=v"(w.z) : "v"(s[rt][1][0]), "v"(s[rt][1][1]));
            asm("v_cvt_pk_bf16_f32 %0, %1, %2" : "=v"(w.w) : "v"(s[rt][1][2]), "v"(s[rt][1][3]));
            pf[rt] = __builtin_bit_cast(bf16x8, w);
        }
    }
#if !defined(ATTN_OVERLAP) || ATTN_OVERLAP < 2
    __builtin_amdgcn_sched_barrier(0);
#endif
    const LAS bf16_t* vbase = Vt + (4 * q + (r >> 2)) * VS + 4 * (r & 3);
#pragma unroll
    for (int dt = 0; dt < 8; ++dt) {
        const s16x4 v0 = __builtin_amdgcn_ds_read_tr16_b64_v4i16((LAS s16x4*)(vbase + dt * 16));
        const s16x4 v1 = __builtin_amdgcn_ds_read_tr16_b64_v4i16((LAS s16x4*)(vbase + 16 * VS + dt * 16));
        bf16x8 vf; vf[0] = v0[0]; vf[1] = v0[1]; vf[2] = v0[2]; vf[3] = v0[3]; vf[4] = v1[0]; vf[5] = v1[1]; vf[6] = v1[2]; vf[7] = v1[3];
#pragma unroll
        for (int rt = 0; rt < NRT; ++rt) acco[rt][dt] = __builtin_amdgcn_mfma_f32_16x16x32_bf16(vf, pf[rt], acco[rt][dt], 0, 0, 0);
    }
#ifndef ATTN_OVERLAP
    __builtin_amdgcn_sched_barrier(0);
#endif
}
__device__ __forceinline__ void attn_finish(const f32x4 (&acco)[8], float l, bf16_t* orow  , int lane) {
    const int q = lane >> 4;
    l += __uint_as_float(lane_xor<16>(__float_as_uint(l), lane)); l += __uint_as_float(lane_xor<32>(__float_as_uint(l), lane));
    const float inv = 1.f / l;
    if (orow) {
#pragma unroll
        for (int dt = 0; dt < 8; ++dt) st4_bf16_g(orow + dt * 16 + 4 * q, acco[dt] * inv);
    }
}

constexpr int KS_BYTES = 64 * 136 * 2, VT_BYTES = 64 * VS * 2;

__device__ __forceinline__ void attn_prompt_unit(const Params& p, LAS unsigned char* lds, int b, int qb) {
    const int tid = tidx(), lane = tid & 63, wave = __builtin_amdgcn_readfirstlane(tid >> 6), r = lane & 15, q = lane >> 4;
    const int head = wave, kvh = wave >> 2;
    LAS bf16_t* Ks0 = (LAS bf16_t*)lds;
    LAS bf16_t* Vt0 = (LAS bf16_t*)(lds + 2 * KS_BYTES);
    const int t0 = qb * 32, nkt = (t0 + 31) / 64 + 1;
    const int rowb = b * LP;
    float m[2] = {-1e30f, -1e30f}, l[2] = {0.f, 0.f}; f32x4 acco[2][8];
    LAS bf16x8* qlds = (LAS bf16x8*)(lds + 2 * KS_BYTES + 2 * VT_BYTES) + wave * 512;
#pragma unroll
    for (int rt = 0; rt < 2; ++rt) {
        const bf16_t* qsrc = p.PARTS + (size_t)(rowb + t0 + rt * 16 + r) * NPAD + C_AQ + head * 128 + 8 * q;
#pragma unroll
        for (int ks = 0; ks < 4; ++ks) qlds[(rt * 4 + ks) * 64 + lane] = *(const bf16x8*)(qsrc + ks * 32);
#pragma unroll
        for (int dt = 0; dt < 8; ++dt) acco[rt][dt] = (f32x4){0.f, 0.f, 0.f, 0.f};
    }
    const bf16x8 qdummy[2][4] = {};
    u32x4 kreg[2][2], vreg[2][2];
    auto load_k = [&](int kt) {
#pragma unroll
        for (int kh = 0; kh < 2; ++kh)
#pragma unroll
            for (int it = 0; it < 2; ++it) {
                const int id = tid + 512 * it, key = id >> 4, ch = id & 15;
                kreg[kh][it] = *(const u32x4*)(p.AKC + (size_t)(rowb + kt * 64 + key) * 256 + kh * 128 + ch * 8);
            }
    };
    auto load_v = [&](int kt) {
#pragma unroll
        for (int kh = 0; kh < 2; ++kh)
#pragma unroll
            for (int it = 0; it < 2; ++it) {
                const int id = tid + 512 * it, vkey = id >> 4, vch = id & 15;
                vreg[kh][it] = *(const u32x4*)(p.AVC + (size_t)(rowb + kt * 64 + vkey) * 256 + kh * 128 + vch * 8);
            }
    };
    auto store_tile = [&]() {
#pragma unroll
        for (int kh = 0; kh < 2; ++kh)
#pragma unroll
            for (int it = 0; it < 2; ++it) {
                const int id = tid + 512 * it, key = id >> 4, ch = id & 15;
                *(LAS u32x4*)((LAS unsigned char*)Ks0 + kh * KS_BYTES + (key * 136 + ch * 8) * 2) = kreg[kh][it];
                *(LAS u32x4*)((LAS unsigned char*)Vt0 + kh * VT_BYTES + (key * VS + ch * 8) * 2) = vreg[kh][it];
            }
    };
    load_k(0); load_v(0);
    const unsigned long long* mrow0 = p.MASK + (size_t)(rowb + t0 + r) * 33;
    const unsigned long long* mrow1 = mrow0 + 16 * 33;
    unsigned long long mn0 = mrow0[0], mn1 = mrow1[0];
#pragma unroll 1
    for (int kt = 0; kt < nkt; ++kt) {
        store_tile();
        lds_barrier();
        const unsigned long long mw0 = mn0, mw1 = mn1;
        if (kt + 1 < nkt) { load_k(kt + 1); load_v(kt + 1); mn0 = mrow0[kt + 1]; mn1 = mrow1[kt + 1]; }
        const LAS bf16_t* Ks = (const LAS bf16_t*)((LAS unsigned char*)Ks0 + kvh * KS_BYTES);
        const LAS bf16_t* Vt = (const LAS bf16_t*)((LAS unsigned char*)Vt0 + kvh * VT_BYTES);
        { const unsigned mb[2] = {(unsigned)mw0, (unsigned)mw1}; attn_tile32<2, true>(Ks, Vt, qdummy, qlds, mb, m, l, acco, lane); }
        { const unsigned mb[2] = {(unsigned)(mw0 >> 32), (unsigned)(mw1 >> 32)}; attn_tile32<2, true>(Ks + 32 * 136, Vt + 32 * VS, qdummy, qlds, mb, m, l, acco, lane); }
        lds_barrier();
    }
#pragma unroll
    for (int rt = 0; rt < 2; ++rt) {
        const int t = t0 + rt * 16 + r;
        attn_finish(acco[rt], l[rt], (t >= NMETA && t < LP) ? p.OATT + (size_t)(b * SEQ + t - NMETA) * D + head * 128 : nullptr, lane);
    }
}

__device__ __forceinline__ void attn_sample_unit(const Params& p, LAS unsigned char* lds, int sb, int kvh) {
    const int tid = tidx(), lane = tid & 63, wave = __builtin_amdgcn_readfirstlane(tid >> 6), r = lane & 15, q = lane >> 4;
    LAS bf16_t* Ks = (LAS bf16_t*)lds;
    LAS bf16_t* Vt = (LAS bf16_t*)(lds + KS_BYTES);
    const int rowq = MP + sb * TS;
    constexpr int nkt = (PAST + TS + 63) / 64;
    const int tok = r & 7, head = kvh * 4 + (wave & 1) * 2 + (r >> 3);
    bf16x8 qf[1][4]; float m[1] = {-1e30f}, l[1] = {0.f}; f32x4 acco[1][8];
    {
        const bf16_t* qsrc = p.PARTS + (size_t)(rowq + tok) * NPAD + C_AQ + head * 128 + 8 * q;
#pragma unroll
        for (int ks = 0; ks < 4; ++ks) qf[0][ks] = *(const bf16x8*)(qsrc + ks * 32);
#pragma unroll
        for (int dt = 0; dt < 8; ++dt) acco[0][dt] = (f32x4){0.f, 0.f, 0.f, 0.f};
    }
    f32x4 kA[2][2], vA[2][2], kB[2][2], vB[2][2];
    LAS int* pages = (LAS int*)(lds + KS_BYTES + VT_BYTES);
    if (tid < NPAGES) pages[tid] = p.page_table[sb * NPAGES + tid];
    lds_barrier();
    auto src_row = [&](const float* cache, int s, int c_new) -> const float* {
        const int page = pages[s >> 7];
        return cache + (((size_t)page * PAGE + (s & 127)) * AKV + kvh) * ADH;
    };
    auto load_tile = [&](int kt, f32x4 (&kreg)[2][2], f32x4 (&vreg)[2][2]) {
        if (kt * 64 < PAST) {
#pragma unroll
            for (int it = 0; it < 2; ++it) {
                const int id = tid + 512 * it, key = id >> 4, ch = id & 15, s = kt * 64 + key;
                const float* a = src_row(p.cache_k, s, 0) + ch * 8; kreg[it][0] = *(const f32x4*)a; kreg[it][1] = *(const f32x4*)(a + 4);
                const float* b = src_row(p.cache_v, s, 0) + ch * 8; vreg[it][0] = *(const f32x4*)b; vreg[it][1] = *(const f32x4*)(b + 4);
            }
        } else {
#pragma unroll
            for (int it = 0; it < 2; ++it) {
                const int id = tid + 512 * it, key = id >> 4, ch = id & 15, s = kt * 64 + key;
                const int sn = s - PAST < TS ? s - PAST : TS - 1;
                const u32x4 w = *(const u32x4*)(p.PARTS + (size_t)(rowq + sn) * NPAD + C_AK + kvh * 128 + ch * 8);
                kreg[it][0] = (f32x4){bflo(w.x), bfhi(w.x), bflo(w.y), bfhi(w.y)}; kreg[it][1] = (f32x4){bflo(w.z), bfhi(w.z), bflo(w.w), bfhi(w.w)};
                const u32x4 x = *(const u32x4*)(p.PARTS + (size_t)(rowq + sn) * NPAD + C_AV + kvh * 128 + ch * 8);
                vreg[it][0] = (f32x4){bflo(x.x), bfhi(x.x), bflo(x.y), bfhi(x.y)}; vreg[it][1] = (f32x4){bflo(x.z), bfhi(x.z), bflo(x.w), bfhi(x.w)};
            }
        }
    };
    auto store_tile = [&](const f32x4 (&kreg)[2][2], const f32x4 (&vreg)[2][2]) {
#pragma unroll
        for (int it = 0; it < 2; ++it) {
            const int id = tid + 512 * it, key = id >> 4, ch = id & 15;
            const bf16x8 kw = pack8(kreg[it][0], kreg[it][1]);
            *(LAS bf16x8*)(Ks + key * 136 + ch * 8) = kw;
            *(LAS bf16x8*)(Vt + key * VS + ch * 8) = pack8(vreg[it][0], vreg[it][1]);
        }
    };
    load_tile(0, kA, vA); load_tile(1, kB, vB);
    const unsigned long long* mrow = p.MASK + (size_t)(rowq + tok) * 33;
    unsigned long long mnx = mrow[0];
    auto compute = [&](unsigned long long mw0) {
        if (wave < 2) {
            { const unsigned mb[1] = {(unsigned)mw0}; attn_tile32<1, false>(Ks, Vt, qf, nullptr, mb, m, l, acco, lane); }
            { const unsigned mb[1] = {(unsigned)(mw0 >> 32)}; attn_tile32<1, false>(Ks + 32 * 136, Vt + 32 * VS, qf, nullptr, mb, m, l, acco, lane); }
        }
    };
#pragma unroll 1
    for (int kt = 0; kt < nkt; kt += 2) {
        store_tile(kA, vA);
        lds_barrier();
        unsigned long long mw0 = mnx;
        if (kt + 1 < nkt) mnx = mrow[kt + 1];
        if (kt + 2 < nkt) load_tile(kt + 2, kA, vA);
        compute(mw0);
        lds_barrier();
        if (kt + 1 < nkt) {
            store_tile(kB, vB);
            lds_barrier();
            mw0 = mnx;
            if (kt + 2 < nkt) mnx = mrow[kt + 2];
            if (kt + 3 < nkt) load_tile(kt + 3, kB, vB);
            compute(mw0);
            lds_barrier();
        }
    }
    if (wave < 2) attn_finish(acco[0], l[0], p.OATT + (size_t)(MFB + sb * TS + tok) * D + head * 128, lane);
}

__device__ __forceinline__ void phase6(const Params& p, LAS unsigned char* lds) {
    constexpr int NQB = (LP + 31) / 32;
    constexpr int NU = NB * NQB;
    const int G = p.G;
    if (blockIdx.x & 1) for (int u = blockIdx.x; u < DBATCH * AKV; u += G) attn_sample_unit(p, lds, u >> 1, u & 1);
    for (int i = blockIdx.x, round = 0; ; ++round) {
        int li;
        if (round == 0) li = blockIdx.x; else if (round == 1) li = 2 * G - 1 - blockIdx.x; else li = round * G + blockIdx.x;
        if (round >= 2 && li >= NU) break;
        if (li < NU) { const int qb = NQB - 1 - li / NB, b = li % NB; attn_prompt_unit(p, lds, b, qb); }
        (void)i;
    }
    if (!(blockIdx.x & 1)) for (int u = blockIdx.x; u < DBATCH * AKV; u += G) attn_sample_unit(p, lds, u >> 1, u & 1);
}

__device__ __forceinline__ void unpack8(const u32x4 w, float (&o)[8]) {
    o[0] = bflo(w.x); o[1] = bfhi(w.x); o[2] = bflo(w.y); o[3] = bfhi(w.y); o[4] = bflo(w.z); o[5] = bfhi(w.z); o[6] = bflo(w.w); o[7] = bfhi(w.w);
}
template <int MODE> struct EpiFin {
    static constexpr bool PERM = true, AFTER_DRAIN = false;
    Params p;
    struct Grp { u32x4 gate[2]; f32x4 t[2][2]; u32x4 mg[2]; };
    __device__ __forceinline__ void load_grp(Grp& G, int row, int col0) const {
        const int frow = full_row(row);
#pragma unroll
        for (int bj = 0; bj < 2; ++bj) {
            const int col = col0 + bj * 128;
            if (MODE == 0 || MODE == 1) G.gate[bj] = *(const u32x4*)(p.PARTS + (size_t)frow * NPAD + (MODE == 0 ? C_GA : C_GB) + col);
            if (MODE == 1) G.mg[bj] = *(const u32x4*)(p.MERGED + (size_t)row * D + col);
            if (MODE == 2) { const float* src = (row < MFB ? p.x_prompt + (size_t)row * D : p.x_sample + (size_t)(row - MFB) * D) + col; G.t[bj][0] = *(const f32x4*)src; G.t[bj][1] = *(const f32x4*)(src + 4); }
        }
    }
    __device__ __forceinline__ void operator()(const pg8::f32x4 (&acc)[2][2][4][2], const pg8::Unit& u, int wr, int wc, int fr, int fq) const {
        const int row0 = u.pm * 256 + wr * 64 + fr, col0 = u.pn * 256 + wc * 32 + 8 * fq;
        Grp cur, nxt;
        if (MODE != 3) load_grp(cur, row0, col0);
#pragma unroll
        for (int gi = 0; gi < 8; ++gi) {
            const int ai = gi >> 2, m = gi & 3;
            const int row = row0 + ai * 128 + m * 16;
            if (MODE != 3 && gi < 7) load_grp(nxt, row0 + ((gi + 1) >> 2) * 128 + ((gi + 1) & 3) * 16, col0);
#pragma unroll
            for (int bj = 0; bj < 2; ++bj) {
                const int col = col0 + bj * 128;
                float v[8] = {acc[ai][bj][m][0][0], acc[ai][bj][m][0][1], acc[ai][bj][m][0][2], acc[ai][bj][m][0][3], acc[ai][bj][m][1][0], acc[ai][bj][m][1][1], acc[ai][bj][m][1][2], acc[ai][bj][m][1][3]};
                if (MODE == 0 || MODE == 1) {
                    float g[8]; unpack8(cur.gate[bj], g);
#pragma unroll
                    for (int i = 0; i < 8; ++i) v[i] *= sigmoidf_(g[i]);
                }
                if (MODE == 0) {
                    u32x4 w; w.x = pk2(v[0], v[1]); w.y = pk2(v[2], v[3]); w.z = pk2(v[4], v[5]); w.w = pk2(v[6], v[7]);
                    *(u32x4*)(p.MERGED + (size_t)row * D + col) = w;
                } else if (MODE == 1) {
                    float a[8]; unpack8(cur.mg[bj], a);
                    u32x4 w; w.x = pk2(v[0] + a[0], v[1] + a[1]); w.y = pk2(v[2] + a[2], v[3] + a[3]); w.z = pk2(v[4] + a[4], v[5] + a[5]); w.w = pk2(v[6] + a[6], v[7] + a[7]);
                    *(u32x4*)(p.MERGED + (size_t)row * D + col) = w;
                } else if (MODE == 2) {
                    const f32x4 a = cur.t[bj][0], b = cur.t[bj][1];
                    float* dst = p.V1 + (size_t)row * D + col;
                    *(f32x4*)dst = (f32x4){DN_ALPHA * a.x + v[0], DN_ALPHA * a.y + v[1], DN_ALPHA * a.z + v[2], DN_ALPHA * a.w + v[3]};
                    *(f32x4*)(dst + 4) = (f32x4){DN_ALPHA * b.x + v[4], DN_ALPHA * b.y + v[5], DN_ALPHA * b.z + v[6], DN_ALPHA * b.w + v[7]};
                } else {
                    u32x4 w; w.x = pk2h(v[0], v[1]); w.y = pk2h(v[2], v[3]); w.z = pk2h(v[4], v[5]); w.w = pk2h(v[6], v[7]);
                    *(u32x4*)(p.QRY + (size_t)row * 2048 + col) = w;
                }
            }
            if (MODE != 3) cur = nxt;
        }
    }
};
template <int MODE>
__device__ __forceinline__ void fin_gemm(const Params& p, LAS unsigned char* lds, const bf16_t* A, const bf16_t* Bt, int N) {
    pg8::Gemm g; g.A = A; g.Bt = Bt; g.M = MFB; g.N = N; g.K = D; g.A2 = A; g.Bt2 = Bt;
    pg8::StaticOrder S; S.init(MFB, N, p.G, blockIdx.x);
    EpiFin<MODE> E; E.p = p;
    pg8::gemm_phase<EpiFin<MODE>, pg8::StaticOrder, false>(lds, g, S, E, nullptr);
}
constexpr int SG_LD = 520;
__device__ __forceinline__ void sg_load(const bf16_t* A, const bf16_t* B, int kh, u32x4 (&ra)[8], u32x4 (&rb)[8], int tid) {
#pragma unroll
    for (int i = 0; i < 8; ++i) {
        const int pc = tid + i * 512, row = pc >> 6, ch = pc & 63;
        ra[i] = *(const u32x4*)(A + (size_t)row * D + kh * 512 + ch * 8);
        rb[i] = *(const u32x4*)(B + (size_t)row * D + kh * 512 + ch * 8);
    }
}
__device__ __forceinline__ void sg_store(LAS bf16_t* sA, LAS bf16_t* sB, const u32x4 (&ra)[8], const u32x4 (&rb)[8], int tid) {
#pragma unroll
    for (int i = 0; i < 8; ++i) {
        const int pc = tid + i * 512, row = pc >> 6, ch = pc & 63;
        *(LAS u32x4*)(sA + row * SG_LD + ch * 8) = ra[i];
        *(LAS u32x4*)(sB + row * SG_LD + ch * 8) = rb[i];
    }
}
template <int KIND>
__device__ __forceinline__ void small_gemm(const Params& p, LAS unsigned char* lds, int ncols) {
    constexpr int NG = KIND == 0 ? 2 : 1;
    const int tid = tidx(), lane = tid & 63, wave = __builtin_amdgcn_readfirstlane(tid >> 6), r = lane & 15, q = lane >> 4, wm = wave >> 1, wn = wave & 1;
    LAS bf16_t* sA = (LAS bf16_t*)lds;
    LAS bf16_t* sB = sA + 64 * SG_LD;
    const int ntn = ncols / 64, ntiles = (MS / 64) * ntn;
    for (int tl = blockIdx.x; tl < ntiles; tl += p.G) {
        const int tm = tl / ntn, tn = tl % ntn;
        const bf16_t* A[2]; const bf16_t* B[2];
        A[0] = (KIND == 0 ? p.OGDN : KIND == 1 ? p.MERGED : p.HB) + (size_t)(MFB + tm * 64) * D;
        B[0] = (KIND == 0 ? p.WBGT : KIND == 1 ? p.WOUTT : p.WQT) + (size_t)(tn * 64) * D;
        A[1] = p.OATT + (size_t)(MFB + tm * 64) * D; B[1] = p.WBAT + (size_t)(tn * 64) * D;
        f32x4 acc[2][2];
#pragma unroll
        for (int g = 0; g < 2; ++g) { acc[g][0] = (f32x4){0.f, 0.f, 0.f, 0.f}; acc[g][1] = (f32x4){0.f, 0.f, 0.f, 0.f}; }
        u32x4 ra[8], rb[8];
        sg_load(A[0], B[0], 0, ra, rb, tid);
#pragma unroll
        for (int st = 0; st < 2 * NG; ++st) {
            const int g = st >> 1;
            lds_barrier();
            sg_store(sA, sB, ra, rb, tid);
            lds_barrier();
            if (st + 1 < 2 * NG) sg_load(A[(st + 1) >> 1], B[(st + 1) >> 1], (st + 1) & 1, ra, rb, tid);
            const LAS bf16_t* ap = sA + (wm * 16 + r) * SG_LD + 8 * q;
            const LAS bf16_t* bp = sB + (wn * 32 + r) * SG_LD + 8 * q;
#pragma unroll
            for (int ks = 0; ks < 16; ++ks) {
                const bf16x8 a = *(const LAS bf16x8*)(ap + ks * 32);
                acc[g][0] = __builtin_amdgcn_mfma_f32_16x16x32_bf16(a, *(const LAS bf16x8*)(bp + ks * 32), acc[g][0], 0, 0, 0);
                acc[g][1] = __builtin_amdgcn_mfma_f32_16x16x32_bf16(a, *(const LAS bf16x8*)(bp + 16 * SG_LD + ks * 32), acc[g][1], 0, 0, 0);
            }
        }
        float ga[2][4], gb[2][4];
#pragma unroll
        for (int n = 0; n < 2; ++n)
#pragma unroll
            for (int i = 0; i < 4; ++i) {
                const int fr = MFB + tm * 64 + wm * 16 + 4 * q + i, col = tn * 64 + wn * 32 + n * 16 + r;
                if (KIND == 0) { const bf16_t* gp = p.PARTS + (size_t)(fr + (MP - MFB)) * NPAD; ga[n][i] = bf2f(gp[C_GA + col]); gb[n][i] = bf2f(gp[C_GB + col]); }
                if (KIND == 1) ga[n][i] = p.x_sample[(size_t)(fr - MFB) * D + col];
            }
#pragma unroll
        for (int n = 0; n < 2; ++n)
#pragma unroll
            for (int i = 0; i < 4; ++i) {
                const int fr = MFB + tm * 64 + wm * 16 + 4 * q + i, col = tn * 64 + wn * 32 + n * 16 + r;
                if (KIND == 0) p.MERGED[(size_t)fr * D + col] = f2bf(sigmoidf_(ga[n][i]) * acc[0][n][i] + sigmoidf_(gb[n][i]) * acc[1][n][i]);
                else if (KIND == 1) p.V1[(size_t)fr * D + col] = DN_ALPHA * ga[n][i] + acc[0][n][i];
                else p.QRY[(size_t)fr * 2048 + col] = __builtin_bit_cast(bf16_t, (_Float16)acc[0][n][i]);
            }
    }
    lds_barrier();
}
struct PairOrder : pg8::StaticOrder {
    __device__ bool next(int i, pg8::Unit& u) const { if (!pg8::StaticOrder::next(i >> 1, u)) return false; u.sel = i & 1; return true; }
};
struct EpiPair {
    static constexpr bool PERM = true, AFTER_DRAIN = false; static constexpr int MIDK = 0;
    EpiFin<0> e0; EpiFin<1> e1;
    __device__ __forceinline__ void operator()(const pg8::f32x4 (&acc)[2][2][4][2], const pg8::Unit& u, int wr, int wc, int fr, int fq) const {
        if (u.sel == 0) e0(acc, u, wr, wc, fr, fq); else e1(acc, u, wr, wc, fr, fq);
    }
};
__device__ __forceinline__ void phase7(const Params& p, LAS unsigned char* lds) {
    {
        pg8::Gemm g; g.A = p.OGDN; g.Bt = p.WBGT; g.A2 = p.OATT; g.Bt2 = p.WBAT; g.M = MFB; g.N = D; g.K = D;
        PairOrder S; S.init(MFB, D, p.G, blockIdx.x);
        EpiPair E; E.e0.p = p; E.e1.p = p;
        pg8::gemm_phase<EpiPair, PairOrder, false>(lds, g, S, E, nullptr);
    }
    small_gemm<0>(p, lds, D);
}
__device__ __forceinline__ void phase8(const Params& p, LAS unsigned char* lds) { fin_gemm<2>(p, lds, p.MERGED, p.WOUTT, D); small_gemm<1>(p, lds, D); }

__device__ __forceinline__ void ln_row(float (&v)[16], const float* g, const float* b, int lane) {
    float s = 0.f;
#pragma unroll
    for (int i = 0; i < 16; ++i) s += v[i];
    const float mu = wave_sum(s) * (1.f / D);
    float s2 = 0.f;
#pragma unroll
    for (int i = 0; i < 16; ++i) { v[i] -= mu; s2 += v[i] * v[i]; }
    const float rstd = rsqrtf(wave_sum(s2) * (1.f / D) + LN_EPS);
#pragma unroll
    for (int i = 0; i < 16; i += 4) {
        const f32x4 gg = *(const f32x4*)(g + lane * 16 + i), bb = *(const f32x4*)(b + lane * 16 + i);
        v[i] = v[i] * rstd * gg.x + bb.x; v[i + 1] = v[i + 1] * rstd * gg.y + bb.y; v[i + 2] = v[i + 2] * rstd * gg.z + bb.z; v[i + 3] = v[i + 3] * rstd * gg.w + bb.w;
    }
}
__device__ __forceinline__ void phase9(const Params& p, LAS unsigned char* lds) {
    const int lane = tidx() & 63, gw = blockIdx.x * 8 + __builtin_amdgcn_readfirstlane(tidx() >> 6), ngw = p.G * 8;
    for (int row0 = gw; row0 < MF; row0 += 2 * ngw) {
        f32x4 in[2][4];
#pragma unroll
        for (int k = 0; k < 2; ++k) {
            const int row = row0 + k * ngw < MF ? row0 + k * ngw : row0;
            const float* src = p.V1 + (size_t)row * D + lane * 16;
#pragma unroll
            for (int i = 0; i < 4; ++i) in[k][i] = *(const f32x4*)(src + 4 * i);
        }
#pragma unroll
        for (int k = 0; k < 2; ++k) {
            const int row = row0 + k * ngw;
            if (row < MF) {
                float v[16];
#pragma unroll
                for (int i = 0; i < 4; ++i) { v[4 * i] = in[k][i].x; v[4 * i + 1] = in[k][i].y; v[4 * i + 2] = in[k][i].z; v[4 * i + 3] = in[k][i].w; }
                ln_row(v, p.ln1_g, p.ln1_b, lane);
                float* dst = p.V1 + (size_t)row * D + lane * 16;
#pragma unroll
                for (int i = 0; i < 16; i += 4) *(f32x4*)(dst + i) = (f32x4){v[i], v[i + 1], v[i + 2], v[i + 3]};
                u32x4 w0, w1;
                w0.x = pk2(v[0], v[1]); w0.y = pk2(v[2], v[3]); w0.z = pk2(v[4], v[5]); w0.w = pk2(v[6], v[7]);
                w1.x = pk2(v[8], v[9]); w1.y = pk2(v[10], v[11]); w1.z = pk2(v[12], v[13]); w1.w = pk2(v[14], v[15]);
                *(u32x4*)(p.HB + (size_t)row * D + lane * 16) = w0; *(u32x4*)(p.HB + (size_t)row * D + lane * 16 + 8) = w1;
            }
        }
    }
}
__device__ __forceinline__ void phase10(const Params& p, LAS unsigned char* lds) { fin_gemm<3>(p, lds, p.HB, p.WQT, 2048); small_gemm<2>(p, lds, 2048); }

template <int N> __device__ __forceinline__ void bitonic_sort_desc(float (&v)[N]) {
#pragma unroll
    for (int k = 2; k <= N; k <<= 1)
#pragma unroll
        for (int j = k >> 1; j > 0; j >>= 1)
#pragma unroll
            for (int i = 0; i < N; ++i) {
                const int l = i ^ j;
                if (l > i) {
                    const bool desc = ((i & k) == 0);
                    const float a = v[i], b = v[l];
                    v[i] = desc ? fmaxf(a, b) : fminf(a, b);
                    v[l] = desc ? fminf(a, b) : fmaxf(a, b);
                }
            }
}
template <int N> __device__ __forceinline__ void bitonic_merge_desc(float (&v)[N]) {
#pragma unroll
    for (int j = N >> 1; j > 0; j >>= 1)
#pragma unroll
        for (int i = 0; i < N; ++i) { const int l = i ^ j; if (l > i) { const float a = v[i], b = v[l]; v[i] = fmaxf(a, b); v[l] = fminf(a, b); } }
}
__device__ __forceinline__ void merge_top16(float (&a)[16], int mask) {
    float b[16];
#pragma unroll
    for (int i = 0; i < 16; ++i) b[i] = __shfl_xor(a[15 - i], mask);
#pragma unroll
    for (int i = 0; i < 16; ++i) a[i] = fmaxf(a[i], b[i]);
    bitonic_merge_desc<16>(a);
}
__device__ __forceinline__ void ce_kp(float& ka, int& pa, float& kb, int& pb) {
    const bool sw = kb > ka;
    const float k0 = sw ? kb : ka, k1 = sw ? ka : kb; const int p0 = sw ? pb : pa, p1 = sw ? pa : pb;
    ka = k0; kb = k1; pa = p0; pb = p1;
}
__device__ __forceinline__ void bitonic_sort_desc_kp16(float (&v)[16], int (&pl)[16]) {
#pragma unroll
    for (int k = 2; k <= 16; k <<= 1)
#pragma unroll
        for (int j = k >> 1; j > 0; j >>= 1)
#pragma unroll
            for (int i = 0; i < 16; ++i) { const int l = i ^ j; if (l > i) { if ((i & k) == 0) ce_kp(v[i], pl[i], v[l], pl[l]); else ce_kp(v[l], pl[l], v[i], pl[i]); } }
}
__device__ __forceinline__ void merge_top16_kp(float (&a)[16], int (&pa)[16], int mask) {
#pragma unroll
    for (int i = 0; i < 16; ++i) {
        const float bk = __shfl_xor(a[15 - i], mask); const int bp = __shfl_xor(pa[15 - i], mask);
        const bool takeb = (bk > a[i]) || (bk == a[i] && bp < pa[i]);
        a[i] = takeb ? bk : a[i]; pa[i] = takeb ? bp : pa[i];
    }
#pragma unroll
    for (int j = 8; j > 0; j >>= 1)
#pragma unroll
        for (int i = 0; i < 16; ++i) { const int l = i ^ j; if (l > i) ce_kp(a[i], pa[i], a[l], pa[l]); }
}

__device__ __forceinline__ void phase11(const Params& p, LAS unsigned char* lds) {
    const int lane = tidx() & 63, h = __builtin_amdgcn_readfirstlane(tidx() >> 6), r = lane & 15, q = lane >> 4;
    for (int ut = blockIdx.x; ut < MF / 16; ut += p.G) {
        const int row0 = ut * 16;
        float top[2][16];
        u32x4 sraw[2][4];
#pragma unroll
        for (int c = 0; c < 2; ++c) {
            const bf16_t* ssrc = p.QRY + (size_t)(row0 + r) * 2048 + (2 * h + c) * 128 + 32 * q;
#pragma unroll
            for (int j = 0; j < 4; ++j) sraw[c][j] = *(const u32x4*)(ssrc + 8 * j);
        }
#pragma unroll
        for (int c = 0; c < 2; ++c) {
            float sv[32];
#pragma unroll
            for (int j = 0; j < 4; ++j) {
                const u32x4 w = sraw[c][j];
                const float t8[8] = {hlo(w.x), hhi(w.x), hlo(w.y), hhi(w.y), hlo(w.z), hhi(w.z), hlo(w.w), hhi(w.w)};
#pragma unroll
                for (int i = 0; i < 8; ++i) sv[8 * j + i] = __uint_as_float((__float_as_uint(t8[i]) & ~127u) | (unsigned)(32 * q + 8 * j + i));
            }
            bitonic_sort_desc<32>(sv);
#pragma unroll
            for (int i = 0; i < 16; ++i) top[c][i] = sv[i];
            merge_top16(top[c], 16);
            merge_top16(top[c], 32);
        }
        float ck[16]; int cp[16];
        {
            constexpr int PI[50] = {0,0,0,0,0,0,0,0,0,0,0,0,0,0,0,0, 1,1,1,1,1,1,1,1, 2,2,2,2,2, 3,3,3,3, 4,4,4, 5,5, 6,6, 7,7, 8,9,10,11,12,13,14,15};
            constexpr int PJ[50] = {0,1,2,3,4,5,6,7,8,9,10,11,12,13,14,15, 0,1,2,3,4,5,6,7, 0,1,2,3,4, 0,1,2,3, 0,1,2, 0,1, 0,1, 0,1, 0,0,0,0,0,0,0,0};
#pragma unroll
            for (int k = 0; k < 16; ++k) { ck[k] = -3.0e38f; cp[k] = 0x7fffffff; }
#pragma unroll
            for (int pi = 0; pi < 50; ++pi) {
                const float a = top[0][PI[pi]], b = top[1][PJ[pi]];
                const float sum = __uint_as_float(__float_as_uint(a) & ~127u) + __uint_as_float(__float_as_uint(b) & ~127u);
                const int e = (int)((__float_as_uint(a) & 127u) * 128u + (__float_as_uint(b) & 127u));
                if ((pi & 3) == q) { ck[pi >> 2] = sum; cp[pi >> 2] = e; }
            }
        }
        bitonic_sort_desc_kp16(ck, cp);
        merge_top16_kp(ck, cp, 16);
        merge_top16_kp(ck, cp, 32);
        float e[16], es = 0.f;
#pragma unroll
        for (int k = 0; k < 16; ++k) { e[k] = __expf(ck[k] - ck[0]); es += e[k]; }
        const float inv = 1.f / es;
        const int row = row0 + r;
        if (row < MF) {
#pragma unroll
            for (int k = 0; k < 16; ++k) if ((k >> 2) == q) {
                p.EIDX[(size_t)row * 128 + h * 16 + k] = (unsigned short)cp[k];
                p.EGATE[(size_t)row * 128 + h * 16 + k] = e[k] * inv;
            }
        }
    }
}

__device__ __forceinline__ float byte_f(unsigned w, int b) { return (float)((w >> (8 * b)) & 0xFFu); }
constexpr int PEER_TOKB = 2560;
__device__ __forceinline__ void peer_ids(LAS const unsigned char* tl, int c, int (&eid)[8]) {
    LAS const unsigned* El = (LAS const unsigned*)tl + c * 8;
    const u32x4 ev0 = *(LAS const u32x4*)El, ev1 = *(LAS const u32x4*)(El + 4);
    const int e[8] = {(int)ev0.x, (int)ev0.y, (int)ev0.z, (int)ev0.w, (int)ev1.x, (int)ev1.y, (int)ev1.z, (int)ev1.w};
#pragma unroll
    for (int k = 0; k < 8; ++k) eid[k] = __builtin_amdgcn_readfirstlane(e[k]);
}
__device__ __forceinline__ void peer_load(__amdgpu_buffer_rsrc_t tab, const int (&eid)[8], int lane, u32x4 (&r)[8]) {
#pragma unroll
    for (int k = 0; k < 8; ++k) r[k] = __builtin_amdgcn_raw_buffer_load_b128(tab, lane * 16, eid[k] << 10, 0);
}
__device__ __forceinline__ void peer_fetch(__amdgpu_buffer_rsrc_t tab, LAS const unsigned char* tl, int c, int lane, u32x4 (&r)[8]) {
    int eid[8]; peer_ids(tl, c, eid); peer_load(tab, eid, lane, r);
}
typedef float f32x2 __attribute__((ext_vector_type(2)));
__device__ __forceinline__ void peer_axpy(f32x2 (&f)[8], const u32x4 (&r)[8], const float (&cc)[8]) {
#pragma unroll
    for (int k = 0; k < 8; ++k) {
        const unsigned w[2] = {r[k].z, r[k].w};
        const f32x2 c2 = {cc[k], cc[k]};
#pragma unroll
        for (int dw = 0; dw < 2; ++dw) {
            f[4 * dw + 0] += c2 * __builtin_amdgcn_cvt_scalef32_pk_f32_fp4(w[dw], 1.0f, 0);
            f[4 * dw + 1] += c2 * __builtin_amdgcn_cvt_scalef32_pk_f32_fp4(w[dw], 1.0f, 1);
            f[4 * dw + 2] += c2 * __builtin_amdgcn_cvt_scalef32_pk_f32_fp4(w[dw], 1.0f, 2);
            f[4 * dw + 3] += c2 * __builtin_amdgcn_cvt_scalef32_pk_f32_fp4(w[dw], 1.0f, 3);
        }
        asm volatile("" : "+v"(f[0]), "+v"(f[1]), "+v"(f[2]), "+v"(f[3]), "+v"(f[4]), "+v"(f[5]), "+v"(f[6]), "+v"(f[7]));
    }
}
__device__ __forceinline__ void peer_chunk(LAS const unsigned char* tl, int c, int lane, int myk, const u32x4 (&r)[8], f32x2 (&f)[8]) {
    const u32x4 hq = *(LAS const u32x4*)(tl + 1536 + lane * 16);
    const float gvs = ((LAS const float*)(tl + 512))[c * 8 + myk], sus = ((LAS const float*)(tl + 1024))[c * 8 + myk];
    int x[8];
#pragma unroll
    for (int k = 0; k < 8; ++k) {
        int hi = __builtin_amdgcn_sdot8((int)r[k].x, (int)hq.x, 0, false);
        hi = __builtin_amdgcn_sdot8((int)r[k].y, (int)hq.y, hi, false);
        int lo = __builtin_amdgcn_sdot8((int)r[k].x, (int)hq.z, 0, false);
        lo = __builtin_amdgcn_sdot8((int)r[k].y, (int)hq.w, lo, false);
        x[k] = (hi << 4) + lo;
    }
    int y4[4], y2[2], y1;
#pragma unroll
    for (int j = 0; j < 4; ++j) { const auto q = __builtin_amdgcn_permlane32_swap((unsigned)x[j], (unsigned)x[j + 4], false, false); y4[j] = (int)(q[0] + q[1]); }
#pragma unroll
    for (int j = 0; j < 2; ++j) { const auto q = __builtin_amdgcn_permlane16_swap((unsigned)y4[j], (unsigned)y4[j + 2], false, false); y2[j] = (int)(q[0] + q[1]); }
    { const int snd = (lane & 8) ? y2[0] : y2[1], kp = (lane & 8) ? y2[1] : y2[0]; y1 = kp + __builtin_amdgcn_update_dpp(0, snd, 0x128, 0xF, 0xF, false); }
    y1 += __builtin_amdgcn_update_dpp(0, y1, 0xB1, 0xF, 0xF, false);
    y1 += __builtin_amdgcn_update_dpp(0, y1, 0x4E, 0xF, 0xF, false);
    y1 += __builtin_amdgcn_update_dpp(0, y1, 0x141, 0xF, 0xF, false);
    const float d = (float)y1 * sus;
    const float z = fabsf(d) * 0.70710678118654752f;
    const float t = __builtin_amdgcn_rcpf(fmaf(0.3275911f, z, 1.f));
    const float poly = t * fmaf(t, fmaf(t, fmaf(t, fmaf(t, 1.061405429f, -1.453152027f), 1.421413741f), -0.284496736f), 0.254829592f);
    const float q = poly * __builtin_amdgcn_exp2f(-1.4426950408889634f * z * z);
    const float cmine = gvs * 0.5f * d * (d >= 0.f ? 2.f - q : q);
    float cc[8];
#pragma unroll
    for (int k = 0; k < 8; ++k) cc[k] = __uint_as_float(__builtin_amdgcn_readlane(__float_as_uint(cmine), ((k & 4) ? 32 : 0) + ((k & 2) ? 16 : 0) + ((k & 1) ? 8 : 0)));
    peer_axpy(f, r, cc);
}
__device__ __forceinline__ int peer_row(int b, int w, int k, int G) {
    const int base = k * G * 8, rem = MF - base;
    if (rem >= G * 8) return base + b * 8 + w;
    if (rem <= 0) return MF;
    const int wpb = (rem + G - 1) / G, r = b * wpb + w;
    return (w < wpb && r < rem) ? base + r : MF;
}
struct PeerRaw { f32x4 h[4]; int e0, e1; float g0, g1; };
__device__ __forceinline__ void peer_raw_load(const Params& p, int row, int lane, PeerRaw& r) {
    const float* hsrc = p.V1 + (size_t)row * D + lane * 16;
#pragma unroll
    for (int j = 0; j < 4; ++j) r.h[j] = *(const f32x4*)(hsrc + 4 * j);
    r.e0 = p.EIDX[(size_t)row * 128 + lane]; r.e1 = p.EIDX[(size_t)row * 128 + 64 + lane];
    r.g0 = p.EGATE[(size_t)row * 128 + lane]; r.g1 = p.EGATE[(size_t)row * 128 + 64 + lane];
}
__device__ __forceinline__ void peer_setup(const Params& p, LAS unsigned char* tl, int lane, const PeerRaw& r) {
    LAS int* El = (LAS int*)tl; LAS float* GVl = (LAS float*)(tl + 512); LAS float* SUl = (LAS float*)(tl + 1024);
    unsigned a = ((unsigned)r.e0 << 7) | (unsigned)lane, b = ((unsigned)r.e1 << 7) | (unsigned)(64 + lane);
    auto cx = [&](auto jc, int k) {
        constexpr int j = decltype(jc)::value;
        const unsigned pa = lane_xor<j>(a, lane), pb = lane_xor<j>(b, lane);
        const bool lower = (lane & j) == 0, upa = (lane & k) == 0, upb = ((64 + lane) & k) == 0;
        a = (lower == upa) ? (a < pa ? a : pa) : (a < pa ? pa : a);
        b = (lower == upb) ? (b < pb ? b : pb) : (b < pb ? pb : b);
    };
#pragma unroll
    for (int k = 2; k <= 128; k <<= 1) {
        if (k == 128) { const unsigned lo = a < b ? a : b, hi = a < b ? b : a; a = lo; b = hi; }
        if (k >= 64) cx(std::integral_constant<int, 32>{}, k);
        if (k >= 32) cx(std::integral_constant<int, 16>{}, k);
        if (k >= 16) cx(std::integral_constant<int, 8>{}, k);
        if (k >= 8) cx(std::integral_constant<int, 4>{}, k);
        if (k >= 4) cx(std::integral_constant<int, 2>{}, k);
        cx(std::integral_constant<int, 1>{}, k);
    }
    const int e0 = (int)(a >> 7), e1 = (int)(b >> 7);
    const float sv0 = p.SV[e0], sv1 = p.SV[e1], suv0 = p.SU[e0], suv1 = p.SU[e1];
    const int sa = a & 127, sb = b & 127;
    const float ga0 = __shfl(r.g0, sa & 63), ga1 = __shfl(r.g1, sa & 63), gb0 = __shfl(r.g0, sb & 63), gb1 = __shfl(r.g1, sb & 63);
    const float gA = (sa & 64) ? ga1 : ga0, gB = (sb & 64) ? gb1 : gb0;
    float am = 0.f;
#pragma unroll
    for (int j = 0; j < 4; ++j) am = fmaxf(am, fmaxf(fmaxf(fabsf(r.h[j].x), fabsf(r.h[j].y)), fmaxf(fabsf(r.h[j].z), fabsf(r.h[j].w))));
    am = wave_max(am);
    const float sh = am > 0.f ? am * (1.f / 119.f) : 1.f, ish = 1.f / sh;
    unsigned hw[4] = {0u, 0u, 0u, 0u};
#pragma unroll
    for (int j = 0; j < 16; ++j) {
        const float hv = (j & 3) == 0 ? r.h[j >> 2].x : ((j & 3) == 1 ? r.h[j >> 2].y : ((j & 3) == 2 ? r.h[j >> 2].z : r.h[j >> 2].w));
        const int q = (int)rintf(hv * ish);
        const int bq = ((q + 8) & 15) - 8, aq = (q - bq) >> 4;
        const int jj = j & 7, pos = jj < 4 ? 2 * jj : 2 * (jj - 4) + 1;
        hw[j >> 3] |= (unsigned)(aq & 0xF) << (4 * pos);
        hw[2 + (j >> 3)] |= (unsigned)(bq & 0xF) << (4 * pos);
    }
    *(LAS u32x4*)(tl + 1536 + lane * 16) = (u32x4){hw[0], hw[1], hw[2], hw[3]};
    El[lane] = e0; El[64 + lane] = e1;
    GVl[lane] = gA * sv0; GVl[64 + lane] = gB * sv1; SUl[lane] = suv0 * sh; SUl[64 + lane] = suv1 * sh;
}
__device__ __forceinline__ void phase12(const Params& p, LAS unsigned char* lds, const XcdBarrier* gb = nullptr) {
    const int lane = tidx() & 63, wv = __builtin_amdgcn_readfirstlane(tidx() >> 6);
    const int myk = ((lane >> 5) & 1) * 4 + ((lane >> 4) & 1) * 2 + ((lane >> 3) & 1);
    LAS unsigned char* wl = lds + wv * 20352;
    const __amdgpu_buffer_rsrc_t rt = __builtin_amdgcn_make_buffer_rsrc((void*)p.PU8, (short)0, NEXP * D, 0x00020000);
    const int ktrips = (MF + p.G * 8 - 1) / (p.G * 8);
    int ntok = 0;
    for (int k = 0; k < ktrips; ++k) ntok += peer_row(blockIdx.x, wv, k, p.G) < MF ? 1 : 0;
    if (ntok == 0) return;
    const int row0 = peer_row(blockIdx.x, wv, 0, p.G);
    PeerRaw raw;
    peer_raw_load(p, row0, lane, raw);
    peer_setup(p, wl, lane, raw);
    u32x4 B0[8], B1[8], B2[8], B3[8];
    peer_fetch(rt, wl, 0, lane, B0); peer_fetch(rt, wl, 1, lane, B1); peer_fetch(rt, wl, 2, lane, B2);
#pragma unroll 1
    for (int j = 0; j < ntok; ++j) {
        LAS unsigned char* tl = wl + (j & 1) * PEER_TOKB;
        LAS unsigned char* tn = wl + ((j + 1) & 1) * PEER_TOKB;
        const bool hasn = j + 1 < ntok;
        if (hasn) { PeerRaw rw; peer_raw_load(p, peer_row(blockIdx.x, wv, j + 1, p.G), lane, rw); peer_setup(p, tn, lane, rw); }
        f32x2 f[8];
#pragma unroll
        for (int i = 0; i < 8; ++i) f[i] = (f32x2){0.f, 0.f};
        auto ahead = [&](int q, u32x4 (&r)[8]) { const bool nx = q >= 16; peer_fetch(rt, nx ? (hasn ? tn : tl) : tl, nx ? q - 16 : q, lane, r); };
#pragma unroll 1
        for (int c = 0; c < 12; c += 4) {
            ahead(c + 3, B3); peer_chunk(tl, c, lane, myk, B0, f); __builtin_amdgcn_sched_barrier(0);
            ahead(c + 4, B0); peer_chunk(tl, c + 1, lane, myk, B1, f); __builtin_amdgcn_sched_barrier(0);
            ahead(c + 5, B1); peer_chunk(tl, c + 2, lane, myk, B2, f); __builtin_amdgcn_sched_barrier(0);
            ahead(c + 6, B2); peer_chunk(tl, c + 3, lane, myk, B3, f); __builtin_amdgcn_sched_barrier(0);
        }
        const int row = peer_row(blockIdx.x, wv, j, p.G);
        const float* hsrc = p.V1 + (size_t)row * D + lane * 16;
        f32x4 hh[4];
#pragma unroll
        for (int i = 0; i < 4; ++i) hh[i] = *(const f32x4*)(hsrc + 4 * i);
        ahead(15, B3); peer_chunk(tl, 12, lane, myk, B0, f); __builtin_amdgcn_sched_barrier(0);
        ahead(16, B0); peer_chunk(tl, 13, lane, myk, B1, f); __builtin_amdgcn_sched_barrier(0);
        ahead(17, B1); peer_chunk(tl, 14, lane, myk, B2, f); __builtin_amdgcn_sched_barrier(0);
        ahead(18, B2); peer_chunk(tl, 15, lane, myk, B3, f); __builtin_amdgcn_sched_barrier(0);
        float* yout = p.out + O_YP + (size_t)row * D;
        float v[16];
#pragma unroll
        for (int i = 0; i < 4; ++i) { v[4 * i] = DN_ALPHA * hh[i].x + f[2 * i][0]; v[4 * i + 1] = DN_ALPHA * hh[i].y + f[2 * i][1]; v[4 * i + 2] = DN_ALPHA * hh[i].z + f[2 * i + 1][0]; v[4 * i + 3] = DN_ALPHA * hh[i].w + f[2 * i + 1][1]; }
        ln_row(v, p.ln2_g, p.ln2_b, lane);
#pragma unroll
        for (int i = 0; i < 16; i += 4) *(f32x4*)(yout + lane * 16 + i) = (f32x4){v[i], v[i + 1], v[i + 2], v[i + 3]};
    }
}

#ifndef MEGA
#define MEGA 1
#endif
template <int PHX> __device__ __forceinline__ void run_phase(const Params& p, LAS unsigned char* lds) {
    if constexpr (PHX == 0) phase0(p, lds);
    else if constexpr (PHX == 1) phase1(p, lds);
    else if constexpr (PHX == 2) phase2(p, lds);
    else if constexpr (PHX == 3) phase3(p, lds);
    else if constexpr (PHX == 4) phase4(p, lds);
    else if constexpr (PHX == 5) phase5(p, lds);
    else if constexpr (PHX == 6) phase6(p, lds);
#ifdef DIAG_ATTN
    else if constexpr (PHX == 7) phase_diag(p, lds);
    else if constexpr (PHX == 8) phase_report(p);
    else if constexpr (PHX >= 9) {}
#endif
    else if constexpr (PHX == 7) phase7(p, lds);
    else if constexpr (PHX == 8) phase8(p, lds);
    else if constexpr (PHX == 9) phase9(p, lds);
    else if constexpr (PHX == 10) phase10(p, lds);
    else if constexpr (PHX == 11) phase11(p, lds);
    else if constexpr (PHX == 12) phase12(p, lds);
}
#define FOR_PHASES(X) X(0) X(1) X(2) X(3) X(4) X(5) X(6) X(7) X(8) X(9) X(10) X(11) X(12)

constexpr int LDS_BYTES = 163840;
constexpr int LDS_BAR_OFF = LDS_BYTES - 16;

constexpr size_t al256(size_t x) { return (x + 255) & ~(size_t)255; }
constexpr size_t WS_BAR = 0;
constexpr size_t WS_XB = WS_BAR + 16384;
constexpr size_t WS_WINT = WS_XB + al256((size_t)MPAD * D * 2);
constexpr size_t WS_WBGT = WS_WINT + al256((size_t)NPAD * D * 2);
constexpr size_t WS_WBAT = WS_WBGT + al256((size_t)D * D * 2);
constexpr size_t WS_WOUTT = WS_WBAT + al256((size_t)D * D * 2);
constexpr size_t WS_WQT = WS_WOUTT + al256((size_t)D * D * 2);
constexpr size_t WS_SUBK = WS_WQT + al256((size_t)2048 * D * 2);
constexpr size_t WS_PARTS = WS_SUBK + al256((size_t)16 * 128 * 128 * 2);
constexpr size_t WS_SMALL = WS_PARTS + al256((size_t)MPAD * NPAD * 2);
constexpr size_t WS_GOPS = WS_SMALL + al256((size_t)MPAD * 32 * 4);
constexpr size_t WS_GOPS_S = WS_GOPS + al256((size_t)NB * GH * NCHUNK * BLOB64);
constexpr size_t WS_ORAW = WS_GOPS_S + al256((size_t)DBATCH * GH * BLOB16);
constexpr size_t WS_OGDN = WS_ORAW + al256((size_t)MPAD * D * 2);
constexpr size_t WS_OATT = WS_OGDN + al256((size_t)MPAD * D * 2);
constexpr size_t WS_MASK = WS_OATT + al256((size_t)MPAD * D * 2);
constexpr size_t WS_TMPA = WS_MASK + al256((size_t)MR * 33 * 8);
constexpr size_t WS_MERGED = WS_TMPA + al256((size_t)MPAD * D * 4);
constexpr size_t WS_V1 = WS_MERGED + al256((size_t)MPAD * D * 2);
constexpr size_t WS_HB = WS_V1 + al256((size_t)MPAD * D * 4);
constexpr size_t WS_QRY = WS_HB + al256((size_t)MPAD * D * 2);
constexpr size_t WS_EIDX = WS_QRY + al256((size_t)MPAD * 2048 * 2);
constexpr size_t WS_EGATE = WS_EIDX + al256((size_t)MR * 128 * 2);
constexpr size_t WS_PU8 = WS_EGATE + al256((size_t)MR * 128 * 4);
constexpr size_t WS_PV8 = WS_PU8 + al256((size_t)NEXP * D);
constexpr size_t WS_SU = WS_PV8 + al256((size_t)NEXP * D);
constexpr size_t WS_SV = WS_SU + al256((size_t)NEXP * 4);
constexpr size_t WS_KIDX = WS_SV + al256((size_t)NEXP * 4);
constexpr size_t WS_AKC = WS_KIDX + al256((size_t)MPAD * 64 * 2);
constexpr size_t WS_AVC = WS_AKC + al256((size_t)MPAD * 256 * 2);
constexpr size_t WS_ESU = WS_AVC + al256((size_t)MPAD * 256 * 2);
constexpr size_t WS_IKC = WS_ESU + al256((size_t)MR * 128 * 4);
constexpr size_t WS_END = WS_IKC + al256((size_t)DBATCH * PAST * IDIM * 2);

struct KArgs {
    const float *x_prompt, *x_sample, *cache_k, *cache_v, *cache_ik, *state_conv, *state_delta; const int* page_table;
    const float *meta, *w_in, *conv_w, *a_log, *dt_bias, *gnorm, *w_bg, *w_ba, *w_out, *ln1_g, *ln1_b, *peer_wq, *peer_sub, *peer_u, *peer_v, *ln2_g, *ln2_b;
    float* out; unsigned char* ws;
    int G; int pad_;
};
__device__ __forceinline__ Params make_params(const KArgs& a) {
    Params p;
    p.x_prompt = a.x_prompt; p.x_sample = a.x_sample; p.cache_k = a.cache_k; p.cache_v = a.cache_v; p.cache_ik = a.cache_ik; p.state_conv = a.state_conv; p.state_delta = a.state_delta;
    p.page_table = a.page_table; p.meta = a.meta; p.w_in = a.w_in; p.conv_w = a.conv_w; p.a_log = a.a_log; p.dt_bias = a.dt_bias; p.gnorm = a.gnorm; p.w_bg = a.w_bg; p.w_ba = a.w_ba;
    p.w_out = a.w_out; p.ln1_g = a.ln1_g; p.ln1_b = a.ln1_b; p.peer_wq = a.peer_wq; p.peer_sub = a.peer_sub; p.peer_u = a.peer_u; p.peer_v = a.peer_v; p.ln2_g = a.ln2_g; p.ln2_b = a.ln2_b;
    p.out = a.out; p.G = a.G;
    unsigned char* ws = a.ws;
    p.bar = (unsigned*)(ws + WS_BAR); p.XB = (bf16_t*)(ws + WS_XB); p.WINT = (bf16_t*)(ws + WS_WINT); p.WBGT = (bf16_t*)(ws + WS_WBGT); p.WBAT = (bf16_t*)(ws + WS_WBAT);
    p.WOUTT = (bf16_t*)(ws + WS_WOUTT); p.WQT = (bf16_t*)(ws + WS_WQT); p.SUBK = (bf16_t*)(ws + WS_SUBK); p.PU = nullptr; p.PV = nullptr; p.PARTS = (bf16_t*)(ws + WS_PARTS);
    p.SMALL = (float*)(ws + WS_SMALL); p.GOPS = ws + WS_GOPS; p.GOPS_S = ws + WS_GOPS_S; p.ORAW = (bf16_t*)(ws + WS_ORAW); p.OGDN = (bf16_t*)(ws + WS_OGDN); p.OATT = (bf16_t*)(ws + WS_OATT);
    p.MASK = (unsigned long long*)(ws + WS_MASK); p.TMPA = (float*)(ws + WS_TMPA); p.MERGED = (bf16_t*)(ws + WS_MERGED); p.V1 = (float*)(ws + WS_V1); p.HB = (bf16_t*)(ws + WS_HB);
    p.QRY = (bf16_t*)(ws + WS_QRY); p.EIDX = (unsigned short*)(ws + WS_EIDX); p.EGATE = (float*)(ws + WS_EGATE); p.PU8 = ws + WS_PU8; p.PV8 = ws + WS_PV8; p.SU = (float*)(ws + WS_SU); p.SV = (float*)(ws + WS_SV);
    p.ESU = (float*)(ws + WS_ESU); p.KIDX = (bf16_t*)(ws + WS_KIDX); p.AKC = (bf16_t*)(ws + WS_AKC); p.AVC = (bf16_t*)(ws + WS_AVC); p.IKC = (bf16_t*)(ws + WS_IKC);
    return p;
}

template <int PHX> __global__ __launch_bounds__(512, 2) void k_phase(KArgs ka) {
    extern __shared__ __attribute__((aligned(16))) unsigned char smem[];
    LAS unsigned char* lds = (LAS unsigned char*)smem;
    const Params p = make_params(ka);
    run_phase<PHX>(p, lds);
}

#if MEGA
#ifndef MEGA_MASK
#define MEGA_MASK 0xFFFF
#endif
#if STAMPS
#define RUNP(i) do { if (blockIdx.x == 0 && threadIdx.x == 0) p.bar[3600 + (i)] = (unsigned)(wall_clock64() - t_start); if ((MEGA_MASK >> (i)) & 1) run_phase<i>(p, lds); } while (0)
#else
#define RUNP(i) do { if ((MEGA_MASK >> (i)) & 1) run_phase<i>(p, lds); } while (0)
#endif
__global__ __launch_bounds__(512, 2) void k_mega(KArgs ka) {
    extern __shared__ __attribute__((aligned(16))) unsigned char smem[];
    LAS unsigned char* lds = (LAS unsigned char*)smem;
    const Params p = make_params(ka);
    if (threadIdx.x == 0) *(LAS u32x4*)(lds + LDS_BAR_OFF) = (u32x4){0u, 0u, 0u, 0u};
    __syncthreads();
    XcdBarrier bar = xcd_barrier_post(p.bar, (volatile LAS unsigned*)(lds + LDS_BAR_OFF), p.G);
#if STAMPS
    const unsigned long long t_start = wall_clock64();
#endif
    RUNP(0);  xcd_barrier(bar);
    RUNP(1);  xcd_barrier(bar);
    RUNP(2);  RUNP(5);  xcd_barrier(bar);
    RUNP(3);  xcd_barrier(bar);
    RUNP(4);  RUNP(6);  xcd_barrier(bar);
    RUNP(7);  xcd_barrier(bar);
    RUNP(8);  xcd_barrier(bar);
    RUNP(9);  xcd_barrier(bar);
    RUNP(10); xcd_barrier(bar);
    RUNP(11); xcd_barrier(bar);
#if STAMPS
    if (blockIdx.x == 0 && threadIdx.x == 0) p.bar[3600 + 12] = (unsigned)(wall_clock64() - t_start);
#endif
    phase12(p, lds, &bar);
#if STAMPS
    xcd_barrier(bar);
    if (blockIdx.x == 0) {
        LAS unsigned* dur = (LAS unsigned*)lds;
        if (threadIdx.x == 0) {
            unsigned t[14]; for (int i = 0; i < 13; ++i) t[i] = p.bar[3600 + i]; t[13] = (unsigned)(wall_clock64() - t_start);
            unsigned d[13]; for (int i = 0; i < 13; ++i) d[i] = (t[i + 1] - t[i]) / 100u;
            dur[0] = d[0]; dur[1] = d[1]; dur[2] = d[2]; dur[3] = d[3]; dur[4] = d[4] + d[9]; dur[5] = d[5]; dur[6] = d[6]; dur[7] = d[7]; dur[8] = d[8]; dur[9] = d[10]; dur[10] = d[11]; dur[11] = d[12];
#if STAMPS == 2
            { for (int i = 0; i < 12; ++i) dur[i] = p.bar[3620 + i] / 100u; }
#endif
        }
        __syncthreads();
        const long offs[12] = {O_YP, O_YS, O_PCONV, O_PDELTA, O_PK, O_PV, O_PIK, O_SCONV, O_SDELTA, O_SK, O_SV, O_SIK};
        for (int ch = 0; ch < 12; ++ch) for (unsigned i = threadIdx.x; i < 8192u; i += 512) ((unsigned*)p.out)[offs[ch] + i] = (i < dur[ch]) ? 0xAAAAAAAAu : 0u;
    }
#endif
}
#endif

extern "C" void kernel_launch(void* const* d_in, const int* in_sizes, int n_in, void* d_out, int out_size, void* d_ws, size_t ws_size, hipStream_t stream) {
    KArgs p{};
    p.x_prompt = (const float*)d_in[0]; p.x_sample = (const float*)d_in[1]; p.cache_k = (const float*)d_in[2]; p.cache_v = (const float*)d_in[3];
    p.cache_ik = (const float*)d_in[4]; p.state_conv = (const float*)d_in[5]; p.state_delta = (const float*)d_in[6]; p.page_table = (const int*)d_in[7];
    p.meta = (const float*)d_in[8]; p.w_in = (const float*)d_in[9]; p.conv_w = (const float*)d_in[10]; p.a_log = (const float*)d_in[11]; p.dt_bias = (const float*)d_in[12];
    p.gnorm = (const float*)d_in[13]; p.w_bg = (const float*)d_in[14]; p.w_ba = (const float*)d_in[15]; p.w_out = (const float*)d_in[16];
    p.ln1_g = (const float*)d_in[17]; p.ln1_b = (const float*)d_in[18]; p.peer_wq = (const float*)d_in[19]; p.peer_sub = (const float*)d_in[20];
    p.peer_u = (const float*)d_in[21]; p.peer_v = (const float*)d_in[22]; p.ln2_g = (const float*)d_in[23]; p.ln2_b = (const float*)d_in[24];
    p.out = (float*)d_out; p.ws = (unsigned char*)d_ws;
    if (WS_END > ws_size || n_in != 25) { fprintf(stderr, "kernel_launch: workspace too small (%zu > %zu) or n_in %d != 25\n", (size_t)WS_END, ws_size, n_in); return; }

    static int grid = 0;
    if (grid == 0) {
        int dev = 0, cus = 0;
        (void)hipGetDevice(&dev); (void)hipDeviceGetAttribute(&cus, hipDeviceAttributeMultiprocessorCount, dev);
        grid = cus > 0 ? cus : 256;
#if MEGA
        (void)hipFuncSetAttribute((const void*)k_mega, hipFuncAttributeMaxDynamicSharedMemorySize, LDS_BYTES);
        int per_cu = 0;
        if (hipOccupancyMaxActiveBlocksPerMultiprocessor(&per_cu, (const void*)k_mega, 512, LDS_BYTES) != hipSuccess || per_cu < 1)
            fprintf(stderr, "kernel_launch: note: the occupancy query reports %d workgroups per CU for k_mega (512 threads, %d bytes of LDS); launching one per CU anyway\n", per_cu, LDS_BYTES);
#else
#define X_ATTR(i) (void)hipFuncSetAttribute((const void*)k_phase<i>, hipFuncAttributeMaxDynamicSharedMemorySize, LDS_BYTES);
        FOR_PHASES(X_ATTR)
#endif
        (void)hipGetLastError();
    }
    p.G = grid; p.pad_ = 0;
    (void)hipMemsetAsync(p.ws + WS_BAR, 0, 16384, stream);
#if MEGA
    hipLaunchKernelGGL(k_mega, dim3(grid), dim3(512), LDS_BYTES, stream, p);
#else
#define X_LAUNCH(i) hipLaunchKernelGGL(k_phase<i>, dim3(grid), dim3(512), LDS_BYTES, stream, p);
    FOR_PHASES(X_LAUNCH)
#endif
}
```

```cpp
#include <hip/hip_runtime.h>
#include <stdint.h>
#include <stdio.h>

#define LAS __attribute__((address_space(3)))
typedef unsigned short bf16_t;
typedef short bf16x8 __attribute__((ext_vector_type(8)));
typedef float f32x4 __attribute__((ext_vector_type(4)));
typedef unsigned u32x4 __attribute__((ext_vector_type(4)));
typedef unsigned u32x2 __attribute__((ext_vector_type(2)));

constexpr int D = 1024, NB = 8, SEQ = 2048, NMETA = 16, LP = 2064, DBATCH = 128, TS = 8, PAST = 2048, PAGE = 128, NPAGES = 16;
constexpr int MP = NB * LP  , MS = DBATCH * TS  , MR = MP + MS  , MPAD = 17664;
constexpr int NIN = 8800, NPAD = 8960;
constexpr int MFB = NB * SEQ  , MF = MFB + MS  ;
constexpr int GH = 8, GDK = 128, GDV = 128, CONVD = 3072;
constexpr int AH = 8, AKV = 2, ADH = 128, IH = 16, IDIM = 64, TOPK = 256;
constexpr int PH = 8, PNK = 128, PQD = 256, PTOPK = 16, NEXP = 16384;
constexpr float DN_ALPHA = 1.189207115002721f;
constexpr float LN_EPS = 1e-5f, RMS_EPS = 1e-6f;
constexpr int C_QKV = 0, C_Z = 3072, C_AQ = 4096, C_AK = 5120, C_AV = 5376, C_IQ = 5632, C_GA = 6656, C_GB = 7680, C_IK = 8704, C_IW = 8768, C_BETA = 8784, C_A = 8792;
constexpr long O_YP = 0, O_YS = 16777216, O_PCONV = 17825792, O_PDELTA = 17899520, O_PK = 18948096, O_PV = 23175168, O_PIK = 27402240,
               O_SCONV = 28459008, O_SDELTA = 29638656, O_SK = 46415872, O_SV = 46678016, O_SIK = 46940160;
constexpr int NCHUNK = 33;
constexpr int BLOB64 = 81920, BLOB16 = 32768;

struct Params {
    const float *x_prompt, *x_sample, *cache_k, *cache_v, *cache_ik, *state_conv, *state_delta; const int* page_table;
    const float *meta, *w_in, *conv_w, *a_log, *dt_bias, *gnorm, *w_bg, *w_ba, *w_out, *ln1_g, *ln1_b, *peer_wq, *peer_sub, *peer_u, *peer_v, *ln2_g, *ln2_b;
    float* out;
    unsigned* bar;
    bf16_t *XB, *WINT, *WBGT, *WBAT, *WOUTT, *WQT, *SUBK, *PU, *PV, *PARTS;
    float* SMALL;
    unsigned char *GOPS, *GOPS_S;
    bf16_t *ORAW, *OGDN, *OATT;
    unsigned long long* MASK;
    float* TMPA; bf16_t* MERGED; float* V1; bf16_t* HB; bf16_t* QRY;
    unsigned short* EIDX; float* EGATE;
    unsigned char *PU8, *PV8; float *SU, *SV;
    float* ESU;
    bf16_t *KIDX, *AKC, *AVC;
    bf16_t *IKC;
    int G;
};

#ifndef STAMPS
#define STAMPS 0
#endif
#if STAMPS == 2
#define SEG_DECL unsigned long long seg_t0 = wall_clock64();
#define SEG(i) do { if (blockIdx.x == 0 && threadIdx.x == 0) { const unsigned long long _t = wall_clock64(); atomicAdd(&p.bar[3620 + (i)], (unsigned)(_t - seg_t0)); seg_t0 = _t; } } while (0)
#else
#define SEG_DECL
#define SEG(i) do {} while (0)
#endif
__device__ __forceinline__ void lds_barrier() { asm volatile("s_waitcnt lgkmcnt(0)" ::: "memory"); __builtin_amdgcn_s_barrier(); asm volatile("" ::: "memory"); }
__device__ __forceinline__ int tidx() { int t = threadIdx.x; asm volatile("" : "+v"(t)); return t; }
typedef __bf16 bf16v2 __attribute__((ext_vector_type(2)));
__device__ __forceinline__ bf16_t f2bf(float f) { return __builtin_bit_cast(bf16_t, (__bf16)f); }
__device__ __forceinline__ float bf2f(bf16_t b) { return __uint_as_float(((unsigned)b) << 16); }
__device__ __forceinline__ unsigned pk2(float lo, float hi) { bf16v2 v; v.x = (__bf16)lo; v.y = (__bf16)hi; return __builtin_bit_cast(unsigned, v); }
typedef _Float16 f16v2 __attribute__((ext_vector_type(2)));
__device__ __forceinline__ unsigned pk2h(float lo, float hi) { f16v2 v; v.x = (_Float16)lo; v.y = (_Float16)hi; return __builtin_bit_cast(unsigned, v); }
__device__ __forceinline__ float hlo(unsigned w) { return (float)__builtin_bit_cast(f16v2, w).x; }
__device__ __forceinline__ float hhi(unsigned w) { return (float)__builtin_bit_cast(f16v2, w).y; }
__device__ __forceinline__ float bflo(unsigned w) { return __uint_as_float(w << 16); }
__device__ __forceinline__ float bfhi(unsigned w) { return __uint_as_float(w & 0xFFFF0000u); }
__device__ __forceinline__ float sigmoidf_(float x) { return __builtin_amdgcn_rcpf(1.0f + __expf(-x)); }
template <int CTRL> __device__ __forceinline__ unsigned dpp_u(unsigned v) { return (unsigned)__builtin_amdgcn_update_dpp(0, (int)v, CTRL, 0xF, 0xF, false); }
template <int J> __device__ __forceinline__ unsigned lane_xor(unsigned v, int lane) {
    if constexpr (J == 1) return dpp_u<0xB1>(v);
    else if constexpr (J == 2) return dpp_u<0x4E>(v);
    else if constexpr (J == 4) return dpp_u<0x1B>(dpp_u<0x141>(v));
    else if constexpr (J == 8) return dpp_u<0x128>(v);
    else if constexpr (J == 16) { const auto r = __builtin_amdgcn_permlane16_swap(v, v, false, false); return (lane & 16) ? r[0] : r[1]; }
    else { const auto r = __builtin_amdgcn_permlane32_swap(v, v, false, false); return (lane & 32) ? r[0] : r[1]; }
}
__device__ __forceinline__ float wave_sum(float v) {
    v += __uint_as_float(dpp_u<0xB1>(__float_as_uint(v))); v += __uint_as_float(dpp_u<0x4E>(__float_as_uint(v)));
    v += __uint_as_float(dpp_u<0x141>(__float_as_uint(v))); v += __uint_as_float(dpp_u<0x140>(__float_as_uint(v)));
    { const auto r = __builtin_amdgcn_permlane16_swap(__float_as_uint(v), __float_as_uint(v), false, false); v = __uint_as_float(r[0]) + __uint_as_float(r[1]); }
    { const auto r = __builtin_amdgcn_permlane32_swap(__float_as_uint(v), __float_as_uint(v), false, false); v = __uint_as_float(r[0]) + __uint_as_float(r[1]); }
    return v;
}
__device__ __forceinline__ float wave_max(float v) {
    v = fmaxf(v, __uint_as_float(dpp_u<0xB1>(__float_as_uint(v)))); v = fmaxf(v, __uint_as_float(dpp_u<0x4E>(__float_as_uint(v))));
    v = fmaxf(v, __uint_as_float(dpp_u<0x141>(__float_as_uint(v)))); v = fmaxf(v, __uint_as_float(dpp_u<0x140>(__float_as_uint(v))));
    { const auto r = __builtin_amdgcn_permlane16_swap(__float_as_uint(v), __float_as_uint(v), false, false); v = fmaxf(__uint_as_float(r[0]), __uint_as_float(r[1])); }
    { const auto r = __builtin_amdgcn_permlane32_swap(__float_as_uint(v), __float_as_uint(v), false, false); v = fmaxf(__uint_as_float(r[0]), __uint_as_float(r[1])); }
    return v;
}
__device__ __forceinline__ int full_row(int fr) { return fr < MFB ? fr + NMETA * ((fr >> 11) + 1) : fr + (MP - MFB); }
__device__ __forceinline__ const float* xrow_ptr(const Params& p, int row) {
    if (row < MP) { const int b = row / LP, t = row - b * LP; return t < NMETA ? p.meta + (size_t)t * D : p.x_prompt + ((size_t)b * SEQ + (t - NMETA)) * D; }
    if (row < MR) return p.x_sample + (size_t)(row - MP) * D;
    return nullptr;
}

#define XB_TMO      128
#define XB_XCNT(j)  (256  + 64 * (j))
#define XB_XSUB(j)  (1280 + 64 * (j))
#define XB_XGEN(j)  (2304 + 64 * (j))
#define XB_TOP      3328
#define XB_TOPGEN   3392
#define XCD_BAR_WORDS 3456
#define XB_SPIN_CAP (1u << 22)

__device__ __forceinline__ unsigned xb_ld(unsigned* p)              { return __hip_atomic_load(p, __ATOMIC_RELAXED, __HIP_MEMORY_SCOPE_AGENT); }
__device__ __forceinline__ unsigned xb_add(unsigned* p, unsigned v) { return __hip_atomic_fetch_add(p, v, __ATOMIC_RELAXED, __HIP_MEMORY_SCOPE_AGENT); }
__device__ __forceinline__ unsigned xb_xcc_id() { return (unsigned)__builtin_amdgcn_s_getreg((3 << 11) | 20) & 0xFu; }
#define XB_SPIN(cond, bar) do { unsigned _sp = 0; while (cond) { __builtin_amdgcn_s_sleep(1); \
    if ((++_sp & 255u) == 0u) { if (xb_ld(&(bar)[XB_TMO])) break; if (_sp > XB_SPIN_CAP) { atomicAdd(&(bar)[XB_TMO], 1u); break; } } } } while (0)

struct XcdBarrier { unsigned* bar; unsigned x; volatile LAS unsigned* st; int G; };

__device__ __forceinline__ XcdBarrier xcd_barrier_post(unsigned* bar, volatile LAS unsigned* st, int G) {
    XcdBarrier b; b.bar = bar; b.x = xb_xcc_id(); b.st = st; b.G = G;
    if (threadIdx.x == 0) (void)xb_add(&bar[XB_XCNT(b.x)], 1u);
    return b;
}
__device__ __forceinline__ void xcd_barrier_complete(unsigned* bar, unsigned x, unsigned& nloc, unsigned& nx, int gridsz) {
    const unsigned G = (unsigned)gridsz;
    unsigned sum, cnt, mine, sp = 0u;
    for (;;) {
        sum = 0u; cnt = 0u; mine = 0u;
#pragma unroll
        for (unsigned j = 0; j < 16; ++j) { const unsigned c = xb_ld(&bar[XB_XCNT(j)]); sum += c; cnt += (c > 0u) ? 1u : 0u; mine = (j == x) ? c : mine; }
        if (sum == G) break;
        __builtin_amdgcn_s_sleep(1);
        if ((++sp & 255u) == 0u) { if (xb_ld(&bar[XB_TMO])) break; if (sp > XB_SPIN_CAP) { atomicAdd(&bar[XB_TMO], 1u); break; } }
    }
    nloc = mine > 0u ? mine : 1u; nx = cnt > 0u ? cnt : 1u;
}
__device__ __forceinline__ void xcd_barrier(const XcdBarrier& b) {
    asm volatile("s_waitcnt vmcnt(0)" ::: "memory");
    __syncthreads();
    if (threadIdx.x == 0) {
        unsigned* bar = b.bar;
        unsigned bx = b.x; asm volatile("" : "+s"(bx));
        __builtin_amdgcn_s_waitcnt(0);
        unsigned nloc = b.st[0], nx = b.st[1];
        if (nloc == 0u) { xcd_barrier_complete(bar, bx, nloc, nx, b.G); b.st[0] = nloc; b.st[1] = nx; }
        const unsigned old = xb_add(&bar[XB_XSUB(bx)], 1u);
        const unsigned gen = old / nloc;
        if (old + 1u == (gen + 1u) * nloc) {
            __builtin_amdgcn_fence(__ATOMIC_RELEASE, "agent");
            asm volatile("s_waitcnt vmcnt(0)" ::: "memory");
            const unsigned og = xb_add(&bar[XB_TOP], 1u);
            const unsigned tg = og / nx;
            if (og + 1u == (tg + 1u) * nx) xb_add(&bar[XB_TOPGEN], 1u);
            else XB_SPIN(xb_ld(&bar[XB_TOPGEN]) == tg, bar);
            __builtin_amdgcn_fence(__ATOMIC_ACQUIRE, "agent");
            xb_add(&bar[XB_XGEN(bx)], 1u);
            asm volatile("s_waitcnt vmcnt(0)" ::: "memory");
        } else {
            XB_SPIN(xb_ld(&bar[XB_XGEN(bx)]) == gen, bar);
            __builtin_amdgcn_fence(__ATOMIC_ACQUIRE, "agent");
            asm volatile("s_waitcnt vmcnt(0)" ::: "memory");
        }
    }
    __syncthreads();
}

namespace pg8 {
#define PG8_LAS __attribute__((address_space(3)))
typedef unsigned short bf16_t;
typedef short bf16x8 __attribute__((ext_vector_type(8)));
typedef float f32x4 __attribute__((ext_vector_type(4)));
typedef unsigned u32x4 __attribute__((ext_vector_type(4)));
constexpr int BM = 256, BK = 64, HALF = 128, HTB = HALF * BK * 2  , STAGE_BYTES = 8 * HTB, NXCD = 8, WGM = 8;

__host__ __device__ __forceinline__ int lds_byte(int r, int c) { const int st = (r >> 4) * 2 + (c >> 5), rr = r & 15, cc = c & 31, ob = rr * 64 + cc * 2; return st * 1024 + (ob ^ (((ob >> 9) & 1) << 5)); }
__host__ __device__ __forceinline__ void stage_rc(int b, int& R, int& C) { const int st = b / 1024, sb = b % 1024, swz = sb ^ (((sb >> 9) & 1) << 5); R = (st >> 1) * 16 + swz / 64; C = (st & 1) * 32 + (swz % 64) / 2; }
__host__ __device__ __forceinline__ int perm32(int rho) { const int n = rho >> 4, i = rho & 15; return 8 * (i >> 2) + 4 * n + (i & 3); }

struct Unit { int pm, pn, sel; };
struct Gemm { const bf16_t* A; const bf16_t* Bt; int M, N, K; const bf16_t* A2; const bf16_t* Bt2; };

struct StaticOrder {
    int nM, nN, nwg, G, c;
    __host__ __device__ void init(int M, int N, int G_, int c_) { nM = M / BM; nN = N / BM; nwg = nM * nN; G = G_; c = c_; }
    __host__ __device__ bool next(int i, Unit& u) const {
        const long L = (long)i * G + c; if (L >= nwg) return false;
        int wgid = (int)L; { const int q = nwg / NXCD, r = nwg % NXCD, xcd = wgid % NXCD, off = wgid / NXCD; wgid = (xcd < r ? xcd * (q + 1) : r * (q + 1) + (xcd - r) * q) + off; }
        const int nig = WGM * nN, gid = wgid / nig, fm = gid * WGM, gsz = (nM - fm) < WGM ? (nM - fm) : WGM;
        u.pm = fm + ((wgid % nig) % gsz); u.pn = (wgid % nig) / gsz; u.sel = 0; return true;
    }
    __device__ __forceinline__ void a_ready(const Unit&) const {}
    __device__ __forceinline__ void done(const Unit&) const {}
};
__device__ __forceinline__ unsigned cvt_pk_bf16(float lo, float hi) { unsigned r; asm volatile("v_cvt_pk_bf16_f32 %0, %1, %2" : "=v"(r) : "v"(lo), "v"(hi)); return r; }
typedef float f32x2 __attribute__((ext_vector_type(2)));
template <class Epi, class Sched, bool STAMP = false>
__device__ __forceinline__ void gemm_phase(PG8_LAS unsigned char* lds, const Gemm g, const Sched& S, const Epi& E, unsigned long long* stamps) {
    const int tid = tidx(), wid = __builtin_amdgcn_readfirstlane(tid >> 6), lane = tid & 63, wr = wid >> 2, wc = wid & 3, fr = lane & 15, fq = lane >> 4;
    const int K = g.K, nt = K / BK;
    int ts_lo = 0, ts_hi = 0, nts = 0; const unsigned long long rt_entry = STAMP ? (unsigned long long)wall_clock64() : 0ull;
#define PG8_STAMP() do { if (STAMP && wid == 0 && nts < 64) { const unsigned long long _c = (unsigned long long)clock64(); \
        ts_lo = (lane == nts) ? (int)(unsigned)_c : ts_lo; ts_hi = (lane == nts) ? (int)(unsigned)(_c >> 32) : ts_hi; ++nts; } } while (0)
    PG8_STAMP();
    unsigned voffA[2], voffB[2];
#pragma unroll
    for (int i = 0; i < 2; ++i) { int R, C; stage_rc(tid * 16 + i * 8192, R, C); const int Rb = Epi::PERM ? ((R & ~31) + perm32(R & 31)) : R;
        voffA[i] = (unsigned)(R * K + C) * 2u; voffB[i] = (unsigned)(Rb * K + C) * 2u; }
    const size_t kstep = (size_t)(BK * 2);
    const size_t hstep = (size_t)HALF * K * 2;
    const size_t tstep = 2 * hstep;
    const unsigned ldsw = (unsigned)wid * 1024u;
    const int aoff = lds_byte(wr * 64 + fr, fq * 8), boff = lds_byte(wc * 32 + fr, fq * 8);
#define PG8_SA(b, h) (((b) * 2 + (h)) * HTB)
#define PG8_SB(b, h) ((4 + (b) * 2 + (h)) * HTB)
#define PG8_STAGE(bufoff, gbase, voff) do { _Pragma("unroll") for (int _i = 0; _i < 2; ++_i) \
        __builtin_amdgcn_global_load_lds((const unsigned*)((const char*)(gbase) + (voff)[_i]), (PG8_LAS unsigned*)(lds + (bufoff) + ldsw + _i * 8192), 16, 0, 0); } while (0)
#define PG8_LDA(dst, b, h) do { _Pragma("unroll") for (int m = 0; m < 4; ++m) _Pragma("unroll") for (int k = 0; k < 2; ++k) dst[m][k] = *(const PG8_LAS bf16x8*)(lds + PG8_SA(b, h) + aoff + m * 2048 + k * 1024); } while (0)
#define PG8_LDB(dst, b, h) do { _Pragma("unroll") for (int n = 0; n < 2; ++n) _Pragma("unroll") for (int k = 0; k < 2; ++k) dst[n][k] = *(const PG8_LAS bf16x8*)(lds + PG8_SB(b, h) + boff + n * 2048 + k * 1024); } while (0)
#define PG8_MMA(ai, bj, At, Bt) do { __builtin_amdgcn_s_setprio(1); _Pragma("unroll") for (int m = 0; m < 4; ++m) _Pragma("unroll") for (int n = 0; n < 2; ++n) _Pragma("unroll") for (int k = 0; k < 2; ++k) \
        acc[ai][bj][m][n] = __builtin_amdgcn_mfma_f32_16x16x32_bf16(Bt[n][k], At[m][k], acc[ai][bj][m][n], 0, 0, 0); __builtin_amdgcn_s_setprio(0); } while (0)
#define PG8_WAIT_V(n) asm volatile("s_waitcnt vmcnt(" #n ")" ::: "memory")
#define PG8_WAIT_L(n) asm volatile("s_waitcnt lgkmcnt(" #n ")" ::: "memory")
#define PG8_BAR __builtin_amdgcn_s_barrier()
#define PG8_SCHED __builtin_amdgcn_sched_barrier(0)
    Unit cur, nxt; int ui = 0;
    if (!S.next(0, cur)) return;
    f32x4 acc[2][2][4][2];
#pragma unroll
    for (int a = 0; a < 2; ++a)
#pragma unroll
        for (int b = 0; b < 2; ++b)
#pragma unroll
            for (int m = 0; m < 4; ++m)
#pragma unroll
                for (int n = 0; n < 2; ++n) acc[a][b][m][n] = (f32x4){0.f, 0.f, 0.f, 0.f};
    bf16x8 At[4][2], B0[2][2], B1[2][2];
    const char* cA = (const char*)(cur.sel ? g.A2 : g.A) + (size_t)cur.pm * tstep; const char* cB = (const char*)(cur.sel ? g.Bt2 : g.Bt) + (size_t)cur.pn * tstep;
    S.a_ready(cur);
    PG8_STAGE(PG8_SB(0, 0), cB, voffB); PG8_STAGE(PG8_SA(0, 0), cA, voffA); PG8_STAGE(PG8_SB(0, 1), cB + hstep, voffB); PG8_STAGE(PG8_SA(0, 1), cA + hstep, voffA);
    if (wr == 1) PG8_BAR;
    PG8_WAIT_V(4); PG8_BAR;
    PG8_STAGE(PG8_SB(1, 0), cB + kstep, voffB); PG8_STAGE(PG8_SA(1, 0), cA + kstep, voffA); PG8_STAGE(PG8_SB(1, 1), cB + hstep + kstep, voffB);
    PG8_WAIT_V(6); PG8_BAR;
    PG8_STAMP();
    for (;;) {
        const bool has_next = S.next(ui + 1, nxt);
        const char* nA = has_next ? (const char*)(nxt.sel ? g.A2 : g.A) + (size_t)nxt.pm * tstep : cA; const char* nB = has_next ? (const char*)(nxt.sel ? g.Bt2 : g.Bt) + (size_t)nxt.pn * tstep : cB;
        for (int t = 0; t < nt; t += 2) {
            const bool last = (t == nt - 2);
            const char* a1 = cA + (size_t)(t + 1) * kstep;
            const char* a2 = last ? nA : cA + (size_t)(t + 2) * kstep; const char* b2 = last ? nB : cB + (size_t)(t + 2) * kstep;
            const char* a3 = a2 + kstep; const char* b3 = b2 + kstep;
            if (last && has_next) S.a_ready(nxt);
            PG8_LDB(B0, 0, 0); PG8_SCHED; PG8_LDA(At, 0, 0); PG8_STAGE(PG8_SA(1, 1), a1 + hstep, voffA);
            PG8_WAIT_L(8); PG8_BAR; PG8_WAIT_L(0); PG8_MMA(0, 0, At, B0); PG8_BAR; PG8_SCHED;
            PG8_LDB(B1, 0, 1); PG8_STAGE(PG8_SB(0, 0), b2, voffB);
            PG8_BAR; PG8_WAIT_L(0); PG8_MMA(0, 1, At, B1); PG8_BAR;
            PG8_LDA(At, 0, 1); PG8_STAGE(PG8_SA(0, 0), a2, voffA);
            PG8_BAR; PG8_WAIT_L(0); PG8_MMA(1, 0, At, B0); PG8_BAR; PG8_SCHED;
            PG8_STAGE(PG8_SB(0, 1), b2 + hstep, voffB);
            PG8_WAIT_V(6); PG8_BAR; PG8_MMA(1, 1, At, B1); PG8_BAR;
            PG8_LDB(B0, 1, 0); PG8_SCHED; PG8_LDA(At, 1, 0); PG8_STAGE(PG8_SA(0, 1), a2 + hstep, voffA);
            PG8_WAIT_L(8); PG8_BAR; PG8_WAIT_L(0); PG8_MMA(0, 0, At, B0); PG8_BAR; PG8_SCHED;
            PG8_LDB(B1, 1, 1); PG8_STAGE(PG8_SB(1, 0), b3, voffB);
            PG8_BAR; PG8_WAIT_L(0); PG8_MMA(0, 1, At, B1); PG8_BAR;
            PG8_LDA(At, 1, 1); PG8_STAGE(PG8_SA(1, 0), a3, voffA);
            PG8_BAR; PG8_WAIT_L(0); PG8_MMA(1, 0, At, B0); PG8_BAR; PG8_SCHED;
            PG8_STAGE(PG8_SB(1, 1), b3 + hstep, voffB);
            PG8_WAIT_V(6); PG8_BAR; PG8_MMA(1, 1, At, B1); PG8_BAR;
        }
        PG8_STAMP();
        if constexpr (!Epi::AFTER_DRAIN) { E(acc, cur, wr, wc, fr, fq); S.done(cur); }
        PG8_STAMP();
        if (!has_next) break;
#pragma unroll
        for (int a = 0; a < 2; ++a)
#pragma unroll
            for (int b = 0; b < 2; ++b)
#pragma unroll
                for (int m = 0; m < 4; ++m)
#pragma unroll
                    for (int n = 0; n < 2; ++n) acc[a][b][m][n] = (f32x4){0.f, 0.f, 0.f, 0.f};
        cur = nxt; cA = nA; cB = nB; ++ui;
    }
    PG8_WAIT_V(0);
    if (wr == 0) PG8_BAR;
    PG8_BAR;
    if constexpr (Epi::AFTER_DRAIN) { E.fused(acc, cur, wr, wc, fr, fq, lds, wid, lane); S.done(cur); }
    PG8_STAMP();
    if (STAMP && wid == 0) { stamps[lane] = lane < nts ? (((unsigned long long)(unsigned)ts_hi << 32) | (unsigned)ts_lo) : 0ull;
        if (lane == 62) stamps[62] = rt_entry; if (lane == 63) stamps[63] = (unsigned long long)wall_clock64(); }
#undef PG8_STAMP
#undef PG8_SA
#undef PG8_SB
#undef PG8_STAGE
#undef PG8_LDA
#undef PG8_LDB
#undef PG8_MMA
#undef PG8_WAIT_V
#undef PG8_WAIT_L
#undef PG8_BAR
#undef PG8_SCHED
}
}

__device__ __forceinline__ int win_src_col(int n) {
    if (n < 4096) return n;
    if (n < C_GA) return n + 16;
    if (n < C_IK) return n + 96;
    if (n < C_IW) return 6672 + (n - C_IK);
    if (n < C_BETA) return 6736 + (n - C_IW);
    if (n < C_A) return 4096 + (n - C_BETA);
    if (n < NIN) return 4104 + (n - C_A);
    return -1;
}
__device__ __forceinline__ bf16x8 pack8f(const f32x4 a, const f32x4 b) {
    u32x4 w; w.x = pk2(a.x, a.y); w.y = pk2(a.z, a.w); w.z = pk2(b.x, b.y); w.w = pk2(b.z, b.w);
    return __builtin_bit_cast(bf16x8, w);
}
template <bool PERMUTE>
__device__ __forceinline__ void transpose_item(const float* W, int ldw, bf16_t* WT, int k0, int n0, LAS float* tile) {
    const int tid = tidx(), j = tid & 63, i0 = tid >> 6;
    const int sc = PERMUTE ? win_src_col(n0 + j) : (n0 + j);
    const int scc = sc >= 0 ? sc : 0;
    float tv[8];
#pragma unroll
    for (int m = 0; m < 8; ++m) tv[m] = W[(size_t)(k0 + i0 + 8 * m) * ldw + scc];
#pragma unroll
    for (int m = 0; m < 8; ++m) { const int i = i0 + 8 * m; tile[i * 65 + j] = sc >= 0 ? tv[m] : 0.f; }
    lds_barrier();
    const int jn = tid >> 3, c = tid & 7;
    u32x4 o;
    o.x = pk2(tile[(8 * c + 0) * 65 + jn], tile[(8 * c + 1) * 65 + jn]); o.y = pk2(tile[(8 * c + 2) * 65 + jn], tile[(8 * c + 3) * 65 + jn]);
    o.z = pk2(tile[(8 * c + 4) * 65 + jn], tile[(8 * c + 5) * 65 + jn]); o.w = pk2(tile[(8 * c + 6) * 65 + jn], tile[(8 * c + 7) * 65 + jn]);
    *(u32x4*)(WT + (size_t)(n0 + jn) * 1024 + k0 + 8 * c) = o;
    lds_barrier();
}
__device__ __forceinline__ void cvt_stream(const Params& p, const float* src, bf16_t* dst, long n8) {
    for (long it = (long)blockIdx.x * 512 + tidx(); it < n8; it += (long)p.G * 512) {
        const f32x4 a = *(const f32x4*)(src + it * 8), b = *(const f32x4*)(src + it * 8 + 4);
        u32x4 o; o.x = pk2(a.x, a.y); o.y = pk2(a.z, a.w); o.z = pk2(b.x, b.y); o.w = pk2(b.z, b.w);
        *(u32x4*)(dst + it * 8) = o;
    }
}
__device__ __forceinline__ void peer_recode(const Params& p, int wg, int nwg) {
    {
        const int lane = tidx() & 63, gw = wg * 8 + __builtin_amdgcn_readfirstlane(tidx() >> 6), ngw = nwg * 8;
        for (int e = gw; e < NEXP; e += ngw) {
            float x[2][16];
#pragma unroll
            for (int k = 0; k < 2; ++k) {
                const float* src = (k ? p.peer_v : p.peer_u) + (size_t)e * D + lane * 16;
#pragma unroll
                for (int i = 0; i < 16; i += 4) { const f32x4 a = *(const f32x4*)(src + i); x[k][i] = a.x; x[k][i + 1] = a.y; x[k][i + 2] = a.z; x[k][i + 3] = a.w; }
            }
            unsigned w[4];
#pragma unroll
            for (int k = 0; k < 2; ++k) {
                float am = 0.f, ss = 0.f;
#pragma unroll
                for (int i = 0; i < 16; ++i) { am = fmaxf(am, fabsf(x[k][i])); ss += x[k][i] * x[k][i]; }
                am = wave_max(am); ss = wave_sum(ss);
                const float rms = sqrtf(ss * (1.f / D));
                const float sc0 = k ? fminf(am * (1.f / 6.f), 0.49f * rms) : fminf(am * (1.f / 7.f), 0.345f * rms), sc = sc0 > 0.f ? sc0 : 1.f, inv = 1.f / sc;
#pragma unroll
                for (int dw = 0; dw < 2; ++dw) {
                    unsigned ww = 0u;
#pragma unroll
                    for (int j = 0; j < 8; ++j) {
                        const float y = x[k][8 * dw + j] * inv;
                        if (k) {
                            const float a = fabsf(y);
                            const int code = (a > 0.25f) + (a > 0.75f) + (a > 1.25f) + (a > 1.75f) + (a > 2.5f) + (a > 3.5f) + (a > 5.f);
                            ww |= (unsigned)(code | (y < 0.f ? 8 : 0)) << (4 * j);
                        } else {
                            int qv = (int)rintf(y); qv = qv > 7 ? 7 : (qv < -7 ? -7 : qv);
                            const int pos = j < 4 ? 2 * j : 2 * (j - 4) + 1;
                            ww |= (unsigned)(qv & 0xF) << (4 * pos);
                        }
                    }
                    w[2 * k + dw] = ww;
                }
                if (lane == 0) (k ? p.SV : p.SU)[e] = sc;
            }
            *(u32x4*)(p.PU8 + (size_t)e * D + lane * 16) = (u32x4){w[0], w[1], w[2], w[3]};
        }
    }
}
__device__ __forceinline__ void phase0(const Params& p, LAS unsigned char* lds) {
    {
        const long NITEM = (long)DBATCH * PAST * (IDIM / 8), stride = (long)p.G * 512;
        for (long it0 = (long)blockIdx.x * 512 + tidx(); it0 < NITEM; it0 += 4 * stride) {
            f32x4 a[4], b[4];
#pragma unroll
            for (int k = 0; k < 4; ++k) {
                const long it = it0 + k * stride; const long itc = it < NITEM ? it : 0;
                const int c8 = (int)(itc & 7) * 8, s = (int)((itc >> 3) & (PAST - 1)), sb = (int)(itc >> 14);
                const int page = p.page_table[sb * NPAGES + (s >> 7)];
                const float* src = p.cache_ik + ((size_t)page * PAGE + (s & 127)) * IDIM + c8;
                a[k] = *(const f32x4*)src; b[k] = *(const f32x4*)(src + 4);
            }
#pragma unroll
            for (int k = 0; k < 4; ++k) {
                const long it = it0 + k * stride;
                if (it < NITEM) { u32x4 o; o.x = pk2(a[k].x, a[k].y); o.y = pk2(a[k].z, a[k].w); o.z = pk2(b[k].x, b[k].y); o.w = pk2(b[k].z, b[k].w); *(u32x4*)(p.IKC + it * 8) = o; }
            }
        }
    }
    {
        const long NITEM = (long)MPAD * 128, stride = (long)p.G * 512;
        for (long it0 = (long)blockIdx.x * 512 + tidx(); it0 < NITEM; it0 += 4 * stride) {
            f32x4 a[4], b[4]; bool ok[4];
#pragma unroll
            for (int k = 0; k < 4; ++k) {
                const long it = it0 + k * stride; const long itc = it < NITEM ? it : 0;
                const int row = (int)(itc >> 7), c8 = (int)(itc & 127) * 8;
                const float* src = xrow_ptr(p, row);
                ok[k] = src != nullptr; const float* sc = src ? src : p.meta;
                a[k] = *(const f32x4*)(sc + c8); b[k] = *(const f32x4*)(sc + c8 + 4);
            }
#pragma unroll
            for (int k = 0; k < 4; ++k) {
                const long it = it0 + k * stride;
                if (it < NITEM) {
                    const int row = (int)(it >> 7), c8 = (int)(it & 127) * 8;
                    u32x4 o = {0u, 0u, 0u, 0u};
                    if (ok[k]) { o.x = pk2(a[k].x, a[k].y); o.y = pk2(a[k].z, a[k].w); o.z = pk2(b[k].x, b[k].y); o.w = pk2(b[k].z, b[k].w); }
                    *(u32x4*)(p.XB + (size_t)row * D + c8) = o;
                }
            }
        }
    }
    LAS float* tile = (LAS float*)lds;
    constexpr int I_IN = 16 * (NPAD / 64), I_SQ = 16 * 16, NIT = I_IN + 3 * I_SQ;
    for (int it = blockIdx.x; it < NIT; it += p.G) {
        int r = it;
        if (r < I_IN) { transpose_item<true>(p.w_in, NIN, p.WINT, (r & 15) * 64, (r >> 4) * 64, tile); continue; } r -= I_IN;
        if (r < I_SQ) { transpose_item<false>(p.w_bg, D, p.WBGT, (r & 15) * 64, (r >> 4) * 64, tile); continue; } r -= I_SQ;
        if (r < I_SQ) { transpose_item<false>(p.w_ba, D, p.WBAT, (r & 15) * 64, (r >> 4) * 64, tile); continue; } r -= I_SQ;
        transpose_item<false>(p.w_out, D, p.WOUTT, (r & 15) * 64, (r >> 4) * 64, tile);
    }
    {
        const int tid = tidx(), lane = tid & 63, wave = __builtin_amdgcn_readfirstlane(tid >> 6), r = lane & 15, q = lane >> 4;
        for (int u = blockIdx.x; u < 16 * 16; u += p.G) {
            const int g = u >> 4, kb = u & 15;
            bf16x8 af[4];
            const float* asrc = p.peer_sub + ((size_t)g * 128 + wave * 16 + r) * 128 + 8 * q;
#pragma unroll
            for (int ks = 0; ks < 4; ++ks) { const f32x4 x0 = *(const f32x4*)(asrc + ks * 32), x1 = *(const f32x4*)(asrc + ks * 32 + 4); af[ks] = pack8f(x0, x1); }
            bf16x8 bfr[4][4];
#pragma unroll
            for (int kt = 0; kt < 4; ++kt) {
                const float* bsrc = p.peer_wq + (size_t)(kb * 64 + kt * 16 + r) * 2048 + g * 128 + 8 * q;
#pragma unroll
                for (int ks = 0; ks < 4; ++ks) { const f32x4 x0 = *(const f32x4*)(bsrc + ks * 32), x1 = *(const f32x4*)(bsrc + ks * 32 + 4); bfr[kt][ks] = pack8f(x0, x1); }
            }
#pragma unroll
            for (int kt = 0; kt < 4; ++kt) {
                f32x4 acc = {0.f, 0.f, 0.f, 0.f};
#pragma unroll
                for (int ks = 0; ks < 4; ++ks) acc = __builtin_amdgcn_mfma_f32_16x16x32_bf16(af[ks], bfr[kt][ks], acc, 0, 0, 0);
#pragma unroll
                for (int i = 0; i < 4; ++i) p.WQT[(size_t)(g * 128 + wave * 16 + 4 * q + i) * D + kb * 64 + kt * 16 + r] = f2bf(acc[i]);
            }
        }
    }
}

struct EpiInProj {
    static constexpr bool PERM = true, AFTER_DRAIN = false;
    bf16_t* parts; float* out; float* small_; bf16_t *kidx, *akc, *avc;
    __device__ __forceinline__ void operator()(const pg8::f32x4 (&acc)[2][2][4][2], const pg8::Unit& u, int wr, int wc, int fr, int fq) const {
        const int row0 = u.pm * 256 + wr * 64 + fr, col0 = u.pn * 256 + wc * 32 + 8 * fq;
#pragma unroll
        for (int ai = 0; ai < 2; ++ai)
#pragma unroll
            for (int m = 0; m < 4; ++m) {
                const int row = row0 + ai * 128 + m * 16;
#pragma unroll
                for (int bj = 0; bj < 2; ++bj) {
                    const int col = col0 + bj * 128;
                    const pg8::f32x4 v0 = acc[ai][bj][m][0], v1 = acc[ai][bj][m][1];
                    u32x4 w; w.x = pg8::cvt_pk_bf16(v0[0], v0[1]); w.y = pg8::cvt_pk_bf16(v0[2], v0[3]); w.z = pg8::cvt_pk_bf16(v1[0], v1[1]); w.w = pg8::cvt_pk_bf16(v1[2], v1[3]);
                    *(u32x4*)(parts + (size_t)row * NPAD + col) = w;
                    if (u.pn == 20 || u.pn == 21) {
                        *(u32x4*)((u.pn == 20 ? akc : avc) + (size_t)row * 256 + (col - u.pn * 256)) = w;
                        if (row < MR) {
                            const int c = col - u.pn * 256;
                            float* dst = (row < MP) ? out + (u.pn == 20 ? O_PK : O_PV) + (size_t)row * 256 + c : out + (u.pn == 20 ? O_SK : O_SV) + (size_t)(row - MP) * 256 + c;
                            *(pg8::f32x4*)dst = v0; *(pg8::f32x4*)(dst + 4) = v1;
                        }
                    } else if (u.pn == 34) {
                        const int c = col - C_IK;
                        if (c < 64) {
                            *(u32x4*)(kidx + (size_t)row * 64 + c) = w;
                            if (row < MR) { float* dst = (row < MP) ? out + O_PIK + (size_t)row * 64 + c : out + O_SIK + (size_t)(row - MP) * 64 + c; *(pg8::f32x4*)dst = v0; *(pg8::f32x4*)(dst + 4) = v1; }
                        } else if (c < 96) { float* dst = small_ + (size_t)row * 32 + (c - 64); *(pg8::f32x4*)dst = v0; *(pg8::f32x4*)(dst + 4) = v1; }
                    }
                }
            }
    }
};
__device__ __forceinline__ void phase1(const Params& p, LAS unsigned char* lds) {
    pg8::Gemm g; g.A = p.XB; g.Bt = p.WINT; g.M = MPAD; g.N = NPAD; g.K = D; g.A2 = p.XB; g.Bt2 = p.WINT;
    pg8::StaticOrder S; S.init(MPAD, NPAD, p.G, blockIdx.x);
    EpiInProj E; E.parts = p.PARTS; E.out = p.out; E.small_ = p.SMALL; E.kidx = p.KIDX; E.akc = p.AKC; E.avc = p.AVC;
    pg8::gemm_phase<EpiInProj, pg8::StaticOrder, false>(lds, g, S, E, nullptr);
    {
        const int nU = (MPAD / 256) * (NPAD / 256), n10 = nU % p.G;
        if (n10 == 0) peer_recode(p, blockIdx.x, p.G); else if ((int)blockIdx.x >= n10) peer_recode(p, (int)blockIdx.x - n10, p.G - n10);
    }
}

template <int K>
__device__ __forceinline__ f32x4 mm_tile(const LAS bf16_t* A, int sa, const LAS bf16_t* Bt, int sb, int m0, int n0, f32x4 acc, int lane) {
    const int r = lane & 15, q = lane >> 4;
    const LAS bf16_t* ap = A + (m0 + r) * sa + 8 * q;
    const LAS bf16_t* bp = Bt + (n0 + r) * sb + 8 * q;
#pragma unroll
    for (int ks = 0; ks < K / 32; ++ks) {
        const bf16x8 a = *(const LAS bf16x8*)(ap + ks * 32);
        const bf16x8 b = *(const LAS bf16x8*)(bp + ks * 32);
        acc = __builtin_amdgcn_mfma_f32_16x16x32_bf16(a, b, acc, 0, 0, 0);
    }
    return acc;
}
__device__ __forceinline__ void st4_bf16(LAS bf16_t* p, f32x4 v) { u32x2 w; w.x = pk2(v[0], v[1]); w.y = pk2(v[2], v[3]); *(LAS u32x2*)p = w; }
__device__ __forceinline__ void st4_bf16_g(bf16_t* p, f32x4 v) { u32x2 w; w.x = pk2(v[0], v[1]); w.y = pk2(v[2], v[3]); *(u32x2*)p = w; }

template <int C> struct GBlob {
    static constexpr int KP = C < 32 ? 32 : C, JS = KP + 8;
    static constexpr int W = 64, QE = W + C * 272, P = QE + C * 272, KDT = P + C * JS * 2, U0T = KDT + 128 * JS * 2, END = U0T + 128 * JS * 2;
    static constexpr int MAIN_BYTES = U0T;
};

template <int C>
__device__ __forceinline__ void gdn_chunk_local(const Params& p, LAS unsigned char* lds, int rowbase, int nreal, int tok0, const float* sconv, int h, unsigned char* blob) {
    typedef GBlob<C> GB;
    constexpr int KP = GB::KP, JS = GB::JS;
    const int tid = tidx(), lane = tid & 63, wave = __builtin_amdgcn_readfirstlane(tid >> 6);
    LAS bf16_t* Kn = (LAS bf16_t*)lds;
    LAS bf16_t* Qn = Kn + C * 136;
    LAS bf16_t* KbT = Qn + C * 136;
    LAS bf16_t* VbT = KbT + 128 * JS;
    LAS bf16_t* KdT = VbT + 128 * JS;
    LAS bf16_t* Xa = KdT + 128 * JS;
    LAS bf16_t* XaT = Xa + C * JS;
    LAS bf16_t* Xb = XaT + C * JS;
    LAS bf16_t* XbT = Xb + C * JS;
    LAS bf16_t* Ta = XbT + C * JS;
    LAS bf16_t* Tb = Ta + C * JS;
    LAS float* gv = (LAS float*)(Tb + C * JS);
    LAS float* betav = gv + C;
    LAS float* lav = betav + C;

    if (C < 32) {
        LAS unsigned* z = (LAS unsigned*)KbT; const int nz = (3 * 128 * JS + 6 * C * JS) / 2;
        for (int i = tid; i < nz; i += 512) z[i] = 0u;
        lds_barrier();
    }
    float g_b = 0.f, g_a = 0.f;
    { const int t_ = tid >> 3; if ((tid & 7) == 0 && t_ < C && t_ < nreal) { const float* sm = p.SMALL + (size_t)(rowbase + t_) * 32; g_b = sm[16 + h]; g_a = sm[24 + h]; } }
    LAS bf16_t* raw = (C == 64) ? Xa : (LAS bf16_t*)(lds + 102400);
    LAS float* cw = lav + C;
    {
        constexpr int NPIECE = (C + 3) * 48, NIT = (NPIECE + 511) / 512;
        u32x4 pv[NIT]; f32x4 fa[NIT], fb[NIT];
#pragma unroll
        for (int k = 0; k < NIT; ++k) {
            const int i = tid + k * 512, ic = i < NPIECE ? i : 0;
            const int rr = ic / 48, c48 = ic % 48, ti = c48 >> 4, ch = (c48 & 15) * 8, dt = rr - 3;
            const int cb = ti * 1024 + h * 128 + ch;
            const bool inpast = dt < 0, have = dt < nreal && (sconv != nullptr || tok0 + dt >= 0);
            const int rowc = (have && !(sconv && inpast)) ? rowbase + dt : rowbase;
            pv[k] = *(const u32x4*)(p.PARTS + (size_t)rowc * NPAD + cb);
            if (sconv) { const float* src = sconv + (size_t)(inpast ? 3 + dt : 0) * CONVD + cb; fa[k] = *(const f32x4*)src; fb[k] = *(const f32x4*)(src + 4); }
        }
        float cwv[3];
#pragma unroll
        for (int k = 0; k < 3; ++k) { const int i = tid + k * 512, tap = i / 384, c = i % 384; cwv[k] = p.conv_w[(size_t)tap * CONVD + (c >> 7) * 1024 + h * 128 + (c & 127)]; }
#pragma unroll
        for (int k = 0; k < NIT; ++k) {
            const int i = tid + k * 512;
            if (i < NPIECE) {
                const int rr = i / 48, c48 = i % 48, ti = c48 >> 4, ch = (c48 & 15) * 8, dt = rr - 3;
                const bool inpast = dt < 0, have = dt < nreal && (sconv != nullptr || tok0 + dt >= 0);
                u32x4 v = pv[k];
                if (sconv && inpast) { v.x = pk2(fa[k].x, fa[k].y); v.y = pk2(fa[k].z, fa[k].w); v.z = pk2(fb[k].x, fb[k].y); v.w = pk2(fb[k].z, fb[k].w); }
                if (!have) v = (u32x4){0u, 0u, 0u, 0u};
                *(LAS u32x4*)(raw + rr * 392 + ti * 128 + ch) = v;
            }
        }
#pragma unroll
        for (int k = 0; k < 3; ++k) cw[tid + k * 512] = cwv[k];
    }
    lds_barrier();
    const int t = tid >> 3, part = tid & 7, ch0 = part * 16;
    float qv[16], kv[16], vv[16];
    const bool active = t < C;
    const bool real = active && t < nreal;
#pragma unroll
    for (int i = 0; i < 16; ++i) { qv[i] = 0.f; kv[i] = 0.f; vv[i] = 0.f; }
    if (real) {
#pragma unroll
        for (int ti = 0; ti < 3; ++ti) {
            float acc[16];
#pragma unroll
            for (int i = 0; i < 16; ++i) acc[i] = 0.f;
#pragma unroll
            for (int tap = 0; tap < 4; ++tap) {
                const LAS bf16_t* src = raw + (t + tap) * 392 + ti * 128 + ch0;
                const u32x4 a = *(const LAS u32x4*)src, b = *(const LAS u32x4*)(src + 8);
                const float xs[16] = {bflo(a.x), bfhi(a.x), bflo(a.y), bfhi(a.y), bflo(a.z), bfhi(a.z), bflo(a.w), bfhi(a.w), bflo(b.x), bfhi(b.x), bflo(b.y), bfhi(b.y), bflo(b.z), bfhi(b.z), bflo(b.w), bfhi(b.w)};
                const LAS float* wsrc = cw + tap * 384 + ti * 128 + ch0;
#pragma unroll
                for (int i = 0; i < 16; i += 4) { const f32x4 w = *(const LAS f32x4*)(wsrc + i); acc[i] += xs[i] * w.x; acc[i + 1] += xs[i + 1] * w.y; acc[i + 2] += xs[i + 2] * w.z; acc[i + 3] += xs[i + 3] * w.w; }
            }
#pragma unroll
            for (int i = 0; i < 16; ++i) { const float sv = acc[i] * sigmoidf_(acc[i]); if (ti == 0) qv[i] = sv; else if (ti == 1) kv[i] = sv; else vv[i] = sv; }
        }
    }
    float ssq = 0.f, ssk = 0.f;
#pragma unroll
    for (int i = 0; i < 16; ++i) { ssq += qv[i] * qv[i]; ssk += kv[i] * kv[i]; }
    {
        const int ln = tid & 63;
        ssq += __uint_as_float(lane_xor<1>(__float_as_uint(ssq), ln)); ssq += __uint_as_float(lane_xor<2>(__float_as_uint(ssq), ln)); ssq += __uint_as_float(lane_xor<4>(__float_as_uint(ssq), ln));
        ssk += __uint_as_float(lane_xor<1>(__float_as_uint(ssk), ln)); ssk += __uint_as_float(lane_xor<2>(__float_as_uint(ssk), ln)); ssk += __uint_as_float(lane_xor<4>(__float_as_uint(ssk), ln));
    }
    const float rq = rsqrtf(ssq + RMS_EPS) * 0.08838834764831845f, rk = rsqrtf(ssk + RMS_EPS);
#pragma unroll
    for (int i = 0; i < 16; ++i) { qv[i] *= rq; kv[i] *= rk; }
    if (active && part == 0) {
        float be = 0.f, la = 0.f;
        if (real) {
            be = sigmoidf_(g_b);
            const float xa = g_a + p.dt_bias[h];
            const float sp = xa > 20.f ? xa : log1pf(__expf(xa));
            la = -__expf(p.a_log[h]) * sp;
        }
        betav[t] = be; lav[t] = la;
    }
    lds_barrier();
    if (tid < 64) {
        float sv = tid < C ? lav[tid] : 0.f;
#pragma unroll
        for (int o = 1; o < 64; o <<= 1) { const float up = __shfl_up(sv, o); if (tid >= o) sv += up; }
        if (tid < C) gv[tid] = sv;
    }
    lds_barrier();
    const float glast = gv[C - 1];
    if (active) {
        const float g = gv[t], be = betav[t], eg = __expf(g), bk = be * eg, kd = __expf(glast - g);
        u32x4 w0, w1;
        w0.x = pk2(kv[0], kv[1]); w0.y = pk2(kv[2], kv[3]); w0.z = pk2(kv[4], kv[5]); w0.w = pk2(kv[6], kv[7]);
        w1.x = pk2(kv[8], kv[9]); w1.y = pk2(kv[10], kv[11]); w1.z = pk2(kv[12], kv[13]); w1.w = pk2(kv[14], kv[15]);
        *(LAS u32x4*)(Kn + t * 136 + ch0) = w0; *(LAS u32x4*)(Kn + t * 136 + ch0 + 8) = w1;
        w0.x = pk2(qv[0], qv[1]); w0.y = pk2(qv[2], qv[3]); w0.z = pk2(qv[4], qv[5]); w0.w = pk2(qv[6], qv[7]);
        w1.x = pk2(qv[8], qv[9]); w1.y = pk2(qv[10], qv[11]); w1.z = pk2(qv[12], qv[13]); w1.w = pk2(qv[14], qv[15]);
        *(LAS u32x4*)(Qn + t * 136 + ch0) = w0; *(LAS u32x4*)(Qn + t * 136 + ch0 + 8) = w1;
        w0.x = pk2(eg * qv[0], eg * qv[1]); w0.y = pk2(eg * qv[2], eg * qv[3]); w0.z = pk2(eg * qv[4], eg * qv[5]); w0.w = pk2(eg * qv[6], eg * qv[7]);
        w1.x = pk2(eg * qv[8], eg * qv[9]); w1.y = pk2(eg * qv[10], eg * qv[11]); w1.z = pk2(eg * qv[12], eg * qv[13]); w1.w = pk2(eg * qv[14], eg * qv[15]);
        bf16_t* qe = (bf16_t*)(blob + GB::QE) + t * 136 + ch0;
        *(u32x4*)qe = w0; *(u32x4*)(qe + 8) = w1;
#pragma unroll
        for (int i = 0; i < 16; ++i) {
            KbT[(ch0 + i) * JS + t] = f2bf(bk * kv[i]);
            VbT[(ch0 + i) * JS + t] = f2bf(be * vv[i]);
            KdT[(ch0 + i) * JS + t] = f2bf(kd * kv[i]);
        }
    }
    if (tid == 0) *(float*)blob = __expf(glast);
    lds_barrier();
    { const LAS u32x4* s = (const LAS u32x4*)KdT; u32x4* d = (u32x4*)(blob + GB::KDT);
      for (int i = tid; i < 128 * JS * 2 / 16; i += 512) d[i] = s[i]; }
    if (C < 32) {
        bf16_t* P = (bf16_t*)(blob + GB::P);
        for (int i = tid; i < C * (JS - C); i += 512) P[(i / (JS - C)) * JS + C + i % (JS - C)] = 0;
    }
    constexpr int NT = C / 16;
    LAS float* LT = (LAS float*)Xa;
    LAS bf16_t* Tc = (LAS bf16_t*)(LT + C * 68);
    for (int tl = wave; tl < NT * NT; tl += 8) {
        const int tm = tl / NT, tn = tl % NT, r = lane & 15, q = lane >> 4;
        f32x4 acc = {0.f, 0.f, 0.f, 0.f};
        acc = mm_tile<128>(Kn, 136, Kn, 136, tm * 16, tn * 16, acc, lane);
        const int j = tn * 16 + r; const float gj = gv[j];
        f32x4 x;
#pragma unroll
        for (int i = 0; i < 4; ++i) { const int tt = tm * 16 + 4 * q + i; x[i] = (j < tt) ? betav[tt] * __expf(gv[tt] - gj) * acc[i] : 0.f; }
        *(LAS f32x4*)(LT + j * 68 + tm * 16 + 4 * q) = x;
        f32x4 pc = {0.f, 0.f, 0.f, 0.f};
        pc = mm_tile<128>(Kn, 136, Qn, 136, tm * 16, tn * 16, pc, lane);
        const int t2 = tn * 16 + r; const float gt = gv[t2];
        f32x4 pv;
#pragma unroll
        for (int i = 0; i < 4; ++i) { const int jj = tm * 16 + 4 * q + i; pv[i] = (jj <= t2) ? __expf(gt - gv[jj]) * pc[i] : 0.f; }
        st4_bf16_g((bf16_t*)(blob + GB::P) + t2 * JS + tm * 16 + 4 * q, pv);
    }
    lds_barrier();
    if (wave * 8 < C) {
        const int c0 = __builtin_amdgcn_readfirstlane(wave) * 8;
        float x[8];
#pragma unroll
        for (int k = 0; k < 8; ++k) x[k] = (lane == c0 + k) ? 1.f : 0.f;
        const int lcol = lane < C ? lane : 0;
        float lc[4], lnx[4];
#pragma unroll
        for (int u = 0; u < 4; ++u) { const int jj = c0 + u < C ? c0 + u : C - 1; lc[u] = LT[jj * 68 + lcol]; }
#pragma unroll 1
        for (int j = c0; j < C - 1; j += 4) {
#pragma unroll
            for (int u = 0; u < 4; ++u) { const int jj = j + 4 + u < C ? j + 4 + u : C - 1; lnx[u] = LT[jj * 68 + lcol]; }
#pragma unroll
            for (int u = 0; u < 4; ++u) {
                if (j + u < C - 1) {
                    const float l = lc[u];
#pragma unroll
                    for (int k = 0; k < 8; ++k) { const float xj = __uint_as_float((unsigned)__builtin_amdgcn_readlane((int)__float_as_uint(x[k]), j + u)); x[k] = fmaf(-l, xj, x[k]); }
                }
            }
#pragma unroll
            for (int u = 0; u < 4; ++u) lc[u] = lnx[u];
        }
        if (lane < C) {
            u32x4 w; w.x = pk2(x[0], x[1]); w.y = pk2(x[2], x[3]); w.z = pk2(x[4], x[5]); w.w = pk2(x[6], x[7]);
            *(LAS u32x4*)(Tc + lane * JS + c0) = w;
        }
    }
    lds_barrier();
    for (int tl = wave; tl < 2 * 8 * NT; tl += 8) {
        const int which = tl / (8 * NT), tt = tl % (8 * NT), r = lane & 15, q = lane >> 4;
        f32x4 acc = {0.f, 0.f, 0.f, 0.f};
        if (which == 0) {
            const int tm = tt / NT, tn = tt % NT;
            acc = mm_tile<KP>(KbT, JS, Tc, JS, tm * 16, tn * 16, acc, lane);
            st4_bf16_g((bf16_t*)(blob + GB::W) + (tn * 16 + r) * 136 + tm * 16 + 4 * q, acc);
        } else {
            const int tm = tt / 8, tn = tt % 8;
            acc = mm_tile<KP>(Tc, JS, VbT, JS, tm * 16, tn * 16, acc, lane);
            st4_bf16_g((bf16_t*)(blob + GB::U0T) + (tn * 16 + r) * JS + tm * 16 + 4 * q, acc);
        }
    }
    if (C < 32) {
        bf16_t* U = (bf16_t*)(blob + GB::U0T);
        for (int i = tid; i < 128 * (JS - C); i += 512) U[(i / (JS - C)) * JS + C + i % (JS - C)] = 0;
    }
    lds_barrier();
}

__device__ __forceinline__ void phase2(const Params& p, LAS unsigned char* lds) {
    for (int it = blockIdx.x * 512 + tidx(); it < (NB + DBATCH) * 3 * (CONVD / 8); it += p.G * 512) {
        const int c8 = (it % (CONVD / 8)) * 8, ri = it / (CONVD / 8), i = ri % 3, bb = ri / 3;
        const int row = bb < NB ? bb * LP + (LP - 3) + i : MP + (bb - NB) * TS + (TS - 3) + i;
        float* dst = bb < NB ? p.out + O_PCONV + ((size_t)bb * 3 + i) * CONVD + c8 : p.out + O_SCONV + ((size_t)(bb - NB) * 3 + i) * CONVD + c8;
        const u32x4 a = *(const u32x4*)(p.PARTS + (size_t)row * NPAD + c8);
        *(f32x4*)dst = (f32x4){bflo(a.x), bfhi(a.x), bflo(a.y), bfhi(a.y)}; *(f32x4*)(dst + 4) = (f32x4){bflo(a.z), bfhi(a.z), bflo(a.w), bfhi(a.w)};
    }
    const int NU = NB * GH * NCHUNK + DBATCH * GH;
    for (int u = blockIdx.x; u < NU; u += p.G) {
        if (u < NB * GH * NCHUNK) {
            const int bh = u / NCHUNK, c = u % NCHUNK, b = bh >> 3, h = bh & 7;
            unsigned char* blob = p.GOPS + (size_t)u * BLOB64;
            if (c == 0) gdn_chunk_local<16>(p, lds, b * LP, 16, 0, nullptr, h, blob);
            else gdn_chunk_local<64>(p, lds, b * LP + 16 + 64 * (c - 1), 64, 16 + 64 * (c - 1), nullptr, h, blob);
        } else {
            const int v = u - NB * GH * NCHUNK, sb = v >> 3, h = v & 7;
            gdn_chunk_local<16>(p, lds, MP + sb * TS, TS, 0, p.state_conv + (size_t)sb * 3 * CONVD, h, p.GOPS_S + (size_t)v * BLOB16);
        }
    }
}

template <int C, int DVS>
__device__ __forceinline__ void gdn_scan_step(const LAS unsigned char* ops, LAS bf16_t* ST, LAS bf16_t* UT, f32x4 (&accS)[DVS / 16], float decay,
                                              bf16_t* orow  , int nreal, int wave, int lane) {
    typedef GBlob<C> GB;
    constexpr int KP = GB::KP, JS = GB::JS, NTN = DVS / 16, NT1 = (C / 16) * NTN;
    const LAS bf16_t* W = (const LAS bf16_t*)(ops + GB::W);
    const LAS bf16_t* QE = (const LAS bf16_t*)(ops + GB::QE);
    const LAS bf16_t* P = (const LAS bf16_t*)(ops + GB::P);
    const LAS bf16_t* KDT = (const LAS bf16_t*)(ops + GB::KDT);
    const LAS bf16_t* U0T = (const LAS bf16_t*)(ops + GB::U0T);
    const int r = lane & 15, q = lane >> 4;
    const int tm = wave / NTN, tn = wave % NTN;
    f32x4 acco = {0.f, 0.f, 0.f, 0.f};
    if (wave < NT1) {
        f32x4 ws = {0.f, 0.f, 0.f, 0.f};
        ws = mm_tile<128>(W, 136, ST, 136, tm * 16, tn * 16, ws, lane);
        const LAS u32x2* up = (const LAS u32x2*)(U0T + (tn * 16 + r) * JS + tm * 16 + 4 * q);
        const u32x2 u0 = *up;
        f32x4 u; u[0] = bflo(u0.x) - ws[0]; u[1] = bfhi(u0.x) - ws[1]; u[2] = bflo(u0.y) - ws[2]; u[3] = bfhi(u0.y) - ws[3];
        st4_bf16(UT + (tn * 16 + r) * JS + tm * 16 + 4 * q, u);
        acco = mm_tile<128>(QE, 136, ST, 136, tm * 16, tn * 16, acco, lane);
    }
    lds_barrier();
    if (wave < NT1) {
        acco = mm_tile<KP>(P, JS, UT, JS, tm * 16, tn * 16, acco, lane);
#pragma unroll
        for (int i = 0; i < 4; ++i) { const int t = tm * 16 + 4 * q + i; if (t < nreal) orow[(size_t)t * D + tn * 16 + r] = f2bf(acco[i]); }
    }
#pragma unroll
    for (int n = 0; n < NTN; ++n) {
        f32x4 a = accS[n] * decay;
        a = mm_tile<KP>(KDT, JS, UT, JS, wave * 16, n * 16, a, lane);
        accS[n] = a;
        st4_bf16(ST + (n * 16 + r) * 136 + wave * 16 + 4 * q, a);
    }
}

template <int C, int DVS, int NR>
__device__ __forceinline__ void gdn_ops_load(const unsigned char* blob, int dv0, u32x4 (&regs)[NR], int tid) {
    typedef GBlob<C> GB;
    constexpr int MAINB = GB::MAIN_BYTES, UB = DVS * GB::JS * 2, TOT = MAINB + UB;
    static_assert(NR * 512 * 16 >= TOT, "NR too small");
#pragma unroll
    for (int i = 0; i < NR; ++i) {
        const int off = (tid + i * 512) * 16;
        const int offc = off < TOT ? off : 0;
        const int so = offc < MAINB ? offc : (GB::U0T + dv0 * GB::JS * 2 + (offc - MAINB));
        regs[i] = *(const u32x4*)(blob + so);
    }
}
template <int C, int DVS, int NR>
__device__ __forceinline__ void gdn_ops_store(LAS unsigned char* ops, const u32x4 (&regs)[NR], int tid) {
    typedef GBlob<C> GB;
    constexpr int TOT = GB::MAIN_BYTES + DVS * GB::JS * 2;
#pragma unroll
    for (int i = 0; i < NR; ++i) { const int off = (tid + i * 512) * 16; if (off < TOT) *(LAS u32x4*)(ops + off) = regs[i]; }
}

__device__ __forceinline__ void phase3(const Params& p, LAS unsigned char* lds) {
    const int tid = tidx(), lane = tid & 63, wave = __builtin_amdgcn_readfirstlane(tid >> 6), r = lane & 15, q = lane >> 4;
    constexpr int OPS64 = GBlob<64>::MAIN_BYTES + 32 * GBlob<64>::JS * 2;
    LAS unsigned char* ops0 = lds;
    LAS unsigned char* ops1 = lds + 67584;
    LAS bf16_t* ST = (LAS bf16_t*)(lds + 2 * 67584);
    LAS bf16_t* UT = (LAS bf16_t*)(lds + 2 * 67584 + 8704);
    for (int vu = blockIdx.x; vu < 256; vu += p.G) {
        const int xg = vu & 7, idx = vu >> 3, bh = xg * 8 + (idx >> 2), sl = idx & 3, b = bh >> 3, h = bh & 7, dv0 = sl * 32;
        f32x4 accS[2] = {{0.f, 0.f, 0.f, 0.f}, {0.f, 0.f, 0.f, 0.f}};
        for (int i = tid; i < 32 * 136 / 2; i += 512) ((LAS unsigned*)ST)[i] = 0u;
        for (int i = tid; i < 32 * 72 / 2; i += 512) ((LAS unsigned*)UT)[i] = 0u;
        const unsigned char* blob0 = p.GOPS + (size_t)(bh * NCHUNK) * BLOB64;
        u32x4 regs[9];
        { u32x4 r16[4]; gdn_ops_load<16, 32, 4>(blob0, dv0, r16, tid); gdn_ops_store<16, 32, 4>(ops0, r16, tid); }
        gdn_ops_load<64, 32, 9>(blob0 + BLOB64, dv0, regs, tid);
        lds_barrier();
        gdn_scan_step<16, 32>(ops0, ST, UT, accS, *(const LAS float*)ops0, p.ORAW + (size_t)(b * LP) * D + h * 128 + dv0, 16, wave, lane);
        gdn_ops_store<64, 32, 9>(ops1, regs, tid);
        lds_barrier();
#pragma unroll 1
        for (int c = 1; c < NCHUNK; ++c) {
            const unsigned char* blob = blob0 + (size_t)c * BLOB64;
            LAS unsigned char* cur = (c & 1) ? ops1 : ops0;
            LAS unsigned char* nxt = (c & 1) ? ops0 : ops1;
            if (c + 1 < NCHUNK) gdn_ops_load<64, 32, 9>(blob + BLOB64, dv0, regs, tid);
            gdn_scan_step<64, 32>(cur, ST, UT, accS, *(const LAS float*)cur, p.ORAW + (size_t)(b * LP + 16 + 64 * (c - 1)) * D + h * 128 + dv0, 64, wave, lane);
            if (c + 1 < NCHUNK) gdn_ops_store<64, 32, 9>(nxt, regs, tid);
            lds_barrier();
        }
#pragma unroll
        for (int n = 0; n < 2; ++n)
#pragma unroll
            for (int i = 0; i < 4; ++i) p.out[O_PDELTA + ((size_t)bh * 128 + wave * 16 + 4 * q + i) * 128 + dv0 + n * 16 + r] = accS[n][i];
        lds_barrier();
    }
    LAS bf16_t* STs = (LAS bf16_t*)(lds + 32768);
    LAS bf16_t* UTs = (LAS bf16_t*)(lds + 32768 + 34816);
    for (int v = blockIdx.x; v < DBATCH * GH; v += p.G) {
        const int sb = v >> 3, h = v & 7;
        const unsigned char* blob = p.GOPS_S + (size_t)v * BLOB16;
        u32x4 r16[4]; gdn_ops_load<16, 128, 4>(blob, 0, r16, tid); gdn_ops_store<16, 128, 4>(ops0, r16, tid);
        for (int i = tid; i < 128 * 40 / 2; i += 512) ((LAS unsigned*)UTs)[i] = 0u;
        f32x4 accS[8];
        const float* s0 = p.state_delta + (size_t)v * 128 * 128;
#pragma unroll
        for (int n = 0; n < 8; ++n) {
#pragma unroll
            for (int i = 0; i < 4; ++i) accS[n][i] = s0[(size_t)(wave * 16 + 4 * q + i) * 128 + n * 16 + r];
            st4_bf16(STs + (n * 16 + r) * 136 + wave * 16 + 4 * q, accS[n]);
        }
        lds_barrier();
        gdn_scan_step<16, 128>(ops0, STs, UTs, accS, *(const LAS float*)ops0, p.ORAW + (size_t)(MP + sb * TS) * D + h * 128, TS, wave, lane);
#pragma unroll
        for (int n = 0; n < 8; ++n)
#pragma unroll
            for (int i = 0; i < 4; ++i) p.out[O_SDELTA + ((size_t)v * 128 + wave * 16 + 4 * q + i) * 128 + n * 16 + r] = accS[n][i];
        lds_barrier();
    }
}

__device__ __forceinline__ void phase4(const Params& p, LAS unsigned char* lds) {
    const int lane = tidx() & 63, gw = blockIdx.x * 8 + __builtin_amdgcn_readfirstlane(tidx() >> 6), ngw = p.G * 8;
    const float* gn = p.gnorm + (lane & 7) * 16;
    float gnv[16];
#pragma unroll
    for (int i = 0; i < 16; ++i) gnv[i] = gn[i];
    for (int row0 = gw; row0 < MF; row0 += 2 * ngw) {
        u32x4 oa[2], ob[2], za[2], zb[2];
#pragma unroll
        for (int k = 0; k < 2; ++k) {
            const int row = full_row(row0 + k * ngw < MF ? row0 + k * ngw : row0);
            oa[k] = *(const u32x4*)(p.ORAW + (size_t)row * D + lane * 16); ob[k] = *(const u32x4*)(p.ORAW + (size_t)row * D + lane * 16 + 8);
            za[k] = *(const u32x4*)(p.PARTS + (size_t)row * NPAD + C_Z + lane * 16); zb[k] = *(const u32x4*)(p.PARTS + (size_t)row * NPAD + C_Z + lane * 16 + 8);
        }
#pragma unroll
        for (int k = 0; k < 2; ++k) {
            const int row = row0 + k * ngw;
            if (row < MF) {
                const u32x4 a = oa[k], b = ob[k];
                float o[16] = {bflo(a.x), bfhi(a.x), bflo(a.y), bfhi(a.y), bflo(a.z), bfhi(a.z), bflo(a.w), bfhi(a.w), bflo(b.x), bfhi(b.x), bflo(b.y), bfhi(b.y), bflo(b.z), bfhi(b.z), bflo(b.w), bfhi(b.w)};
                float ss = 0.f;
#pragma unroll
                for (int i = 0; i < 16; ++i) ss += o[i] * o[i];
                ss += __uint_as_float(lane_xor<1>(__float_as_uint(ss), lane)); ss += __uint_as_float(lane_xor<2>(__float_as_uint(ss), lane)); ss += __uint_as_float(lane_xor<4>(__float_as_uint(ss), lane));
                const float rs = rsqrtf(ss * (1.f / 128.f) + RMS_EPS);
                const u32x4 zx = za[k], zy = zb[k];
                const float z[16] = {bflo(zx.x), bfhi(zx.x), bflo(zx.y), bfhi(zx.y), bflo(zx.z), bfhi(zx.z), bflo(zx.w), bfhi(zx.w), bflo(zy.x), bfhi(zy.x), bflo(zy.y), bfhi(zy.y), bflo(zy.z), bfhi(zy.z), bflo(zy.w), bfhi(zy.w)};
                float y[16];
#pragma unroll
                for (int i = 0; i < 16; ++i) y[i] = o[i] * rs * gnv[i] * (z[i] * sigmoidf_(z[i]));
                u32x4 w0, w1;
                w0.x = pk2(y[0], y[1]); w0.y = pk2(y[2], y[3]); w0.z = pk2(y[4], y[5]); w0.w = pk2(y[6], y[7]);
                w1.x = pk2(y[8], y[9]); w1.y = pk2(y[10], y[11]); w1.z = pk2(y[12], y[13]); w1.w = pk2(y[14], y[15]);
                *(u32x4*)(p.OGDN + (size_t)row * D + lane * 16) = w0; *(u32x4*)(p.OGDN + (size_t)row * D + lane * 16 + 8) = w1;
            }
        }
    }
}

constexpr int SCS = 2116;
__device__ __forceinline__ bf16x8 pack8(const f32x4 a, const f32x4 b) {
    u32x4 w; w.x = pk2(a.x, a.y); w.y = pk2(a.z, a.w); w.z = pk2(b.x, b.y); w.w = pk2(b.z, b.w);
    return __builtin_bit_cast(bf16x8, w);
}
template <bool SAMPLE>
__device__ __forceinline__ void indexer_unit(const Params& p, LAS unsigned char* lds, int qrow0, int nq, int qpos0, int krow0, int sb) {
    const int tid = tidx(), lane = tid & 63, wave = __builtin_amdgcn_readfirstlane(tid >> 6), r = lane & 15, q = lane >> 4;
    LAS float* sc = (LAS float*)lds;
    SEG_DECL
    const int lastq = qpos0 + 15;
    const int nkt = SAMPLE ? (PAST + TS + 15) / 16 : (lastq / 16 + 1);
#pragma unroll 1
    for (int pass = 0; pass < 2; ++pass) {
        bf16x8 qf[8][2];
        float wq[8];
        {
            const bf16_t* qsrc = p.PARTS + (size_t)(qrow0 + r) * NPAD + C_IQ + pass * 512 + 8 * q;
#pragma unroll
            for (int hd = 0; hd < 8; ++hd)
#pragma unroll
                for (int ks = 0; ks < 2; ++ks) qf[hd][ks] = *(const bf16x8*)(qsrc + hd * 64 + ks * 32);
            const float* wsrc = p.SMALL + (size_t)(qrow0 + r) * 32 + pass * 8;
#pragma unroll
            for (int hd = 0; hd < 8; ++hd) wq[hd] = wsrc[hd] * 0.03125f;
        }
        auto load_kf = [&](int kt_, bf16x8 (&kf)[2]) {
            const int kt = kt_ < nkt ? kt_ : nkt - 1;
            const int s = kt * 16 + r;
            if (SAMPLE) {
                if (kt * 16 < PAST) {
                    const bf16_t* src = p.IKC + ((size_t)sb * PAST + s) * IDIM + 8 * q;
#pragma unroll
                    for (int ks = 0; ks < 2; ++ks) kf[ks] = *(const bf16x8*)(src + ks * 32);
                } else {
                    const int sn = s - PAST < TS ? s - PAST : TS - 1;
                    const bf16_t* src = p.PARTS + (size_t)(MP + sb * TS + sn) * NPAD + C_IK + 8 * q;
#pragma unroll
                    for (int ks = 0; ks < 2; ++ks) kf[ks] = *(const bf16x8*)(src + ks * 32);
                }
            } else {
                const int sc_ = s < LP ? s : LP - 1;
                const bf16_t* src = p.KIDX + (size_t)(krow0 + sc_) * 64 + 8 * q;
#pragma unroll
                for (int ks = 0; ks < 2; ++ks) kf[ks] = *(const bf16x8*)(src + ks * 32);
            }
        };
        bf16x8 kcur[4][2], knxt[4][2];
#pragma unroll
        for (int j = 0; j < 4; ++j) load_kf(wave + 8 * j, kcur[j]);
#pragma unroll 1
        for (int kb = wave; kb < nkt; kb += 32) {
#pragma unroll
            for (int j = 0; j < 4; ++j) load_kf(kb + 32 + 8 * j, knxt[j]);
#pragma unroll
            for (int j = 0; j < 4; ++j) {
                const int kt = kb + 8 * j;
                if (kt < nkt) {
                    f32x4 acc[8];
#pragma unroll
                    for (int hd = 0; hd < 8; ++hd) acc[hd] = __builtin_amdgcn_mfma_f32_16x16x32_bf16(kcur[j][0], qf[hd][0], (f32x4){0.f, 0.f, 0.f, 0.f}, 0, 0, 0);
#pragma unroll
                    for (int hd = 0; hd < 8; ++hd) acc[hd] = __builtin_amdgcn_mfma_f32_16x16x32_bf16(kcur[j][1], qf[hd][1], acc[hd], 0, 0, 0);
                    f32x4 tot = {0.f, 0.f, 0.f, 0.f};
#pragma unroll
                    for (int hd = 0; hd < 8; ++hd)
#pragma unroll
                        for (int i = 0; i < 4; ++i) tot[i] = fmaf(wq[hd], __builtin_amdgcn_fmed3f(acc[hd][i], 0.f, 3.0e38f), tot[i]);
                    LAS f32x4* dst = (LAS f32x4*)(sc + r * SCS + kt * 16 + 4 * q);
                    if (pass == 0) *dst = tot; else *dst = *dst + tot;
                }
            }
#pragma unroll
            for (int j = 0; j < 4; ++j) { kcur[j][0] = knxt[j][0]; kcur[j][1] = knxt[j][1]; }
        }
    }
    lds_barrier();
    SEG(SAMPLE ? 2 : 0);
#pragma unroll 1
    for (int qq = 0; qq < 2; ++qq) {
        const int qi = wave * 2 + qq;
        if (qi >= nq) continue;
        const int tpos = qpos0 + qi;
        LAS int* hist = (LAS int*)(lds + 16 * SCS * 4 + wave * 3344);
        LAS float* cval = (LAS float*)(hist + 256);
        LAS int* cidx = (LAS int*)(hist + 512);
        LAS unsigned* cbits = (LAS unsigned*)(hist + 768);
        float val[33];
#pragma unroll
        for (int j = 0; j < 33; ++j) { const int s = lane + 64 * j; val[j] = (s <= tpos) ? sc[qi * SCS + s] : -3.0e38f; }
        unsigned long long mymask = 0ull;
        if (tpos < TOPK) {
#pragma unroll
            for (int j = 0; j < 33; ++j) { const unsigned long long m = __ballot(lane + 64 * j <= tpos); if (lane == j) mymask = m; }
        } else {
            float vmx = -3.0e38f, vmn = 3.0e38f;
#pragma unroll
            for (int j = 0; j < 33; ++j) { vmx = fmaxf(vmx, val[j]); vmn = fminf(vmn, (lane + 64 * j <= tpos) ? val[j] : 3.0e38f); }
            vmx = wave_max(vmx); vmn = -wave_max(-vmn);
            const float scale = vmx > vmn ? 255.99f / (vmx - vmn) : 0.f;
            *(LAS f32x4*)(hist + 4 * lane) = (f32x4){0.f, 0.f, 0.f, 0.f};
            if (lane < 33) { cbits[2 * lane] = 0u; cbits[2 * lane + 1] = 0u; }
            if (lane == 0) cidx[255] = 0;
            __builtin_amdgcn_fence(__ATOMIC_SEQ_CST, "wavefront");
            int bk[33];
#pragma unroll
            for (int j = 0; j < 33; ++j) {
                int b = (int)((val[j] - vmn) * scale); b = b < 0 ? 0 : (b > 255 ? 255 : b);
                bk[j] = (lane + 64 * j <= tpos) ? b : -1;
                if (bk[j] >= 0) __hip_atomic_fetch_add((LAS int*)hist + bk[j], 1, __ATOMIC_RELAXED, __HIP_MEMORY_SCOPE_WAVEFRONT);
            }
            __builtin_amdgcn_fence(__ATOMIC_SEQ_CST, "wavefront");
            int bstar, need, nc;
            {
                const int h0 = hist[4 * lane], h1 = hist[4 * lane + 1], h2 = hist[4 * lane + 2], h3 = hist[4 * lane + 3];
                const int tl = h0 + h1 + h2 + h3;
                int sfx = tl;
#pragma unroll
                for (int o = 1; o < 64; o <<= 1) { const int v = __shfl_down(sfx, o); if (lane + o < 64) sfx += v; }
                const int above = sfx - tl;
                const bool mine = above < TOPK && TOPK <= sfx;
                int bsel, asel, hsel;
                if (above + h3 >= TOPK) { bsel = 3; asel = above; hsel = h3; }
                else if (above + h3 + h2 >= TOPK) { bsel = 2; asel = above + h3; hsel = h2; }
                else if (above + h3 + h2 + h1 >= TOPK) { bsel = 1; asel = above + h3 + h2; hsel = h1; }
                else { bsel = 0; asel = above + h3 + h2 + h1; hsel = h0; }
                const unsigned long long bm = __ballot(mine);
                const int src = bm ? (int)__ffsll((long long)bm) - 1 : 0;
                bstar = __shfl(4 * lane + bsel, src); need = TOPK - __shfl(asel, src); nc = __shfl(hsel, src);
            }
            if (nc > need && nc <= 255) {
#pragma unroll
                for (int j = 0, base = 0; j < 33; ++j) {
                    const bool hit = bk[j] == bstar;
                    const unsigned long long mm = __ballot(hit);
                    if (mm) {
                        if (hit) { const int pos = base + (int)__builtin_amdgcn_mbcnt_hi((unsigned)(mm >> 32), __builtin_amdgcn_mbcnt_lo((unsigned)mm, 0u)); cval[pos] = val[j]; cidx[pos] = lane + 64 * j; }
                        base += __popcll(mm);
                    }
                }
                __builtin_amdgcn_fence(__ATOMIC_SEQ_CST, "wavefront");
                for (int c0 = 0; c0 < nc; c0 += 64) {
                    const int c = c0 + lane;
                    if (c < nc) {
                        const float v = cval[c]; const int ix = cidx[c]; int rank = 0;
                        for (int k = 0; k < nc; ++k) { const float w = cval[k]; const int wi = cidx[k]; rank += (w > v || (w == v && wi < ix)) ? 1 : 0; }
                        if (rank < need) __hip_atomic_fetch_or((LAS unsigned*)cbits + (ix >> 5), 1u << (ix & 31), __ATOMIC_RELAXED, __HIP_MEMORY_SCOPE_WAVEFRONT);
                    }
                }
                __builtin_amdgcn_fence(__ATOMIC_SEQ_CST, "wavefront");
#pragma unroll
                for (int j = 0; j < 33; ++j) { const unsigned long long mg = __ballot(bk[j] > bstar); if (lane == j) mymask = mg; }
                if (lane < 33) mymask |= (unsigned long long)cbits[2 * lane] | ((unsigned long long)cbits[2 * lane + 1] << 32);
            } else if (nc == need) {
#pragma unroll
                for (int j = 0; j < 33; ++j) { const unsigned long long mg = __ballot(bk[j] >= bstar); if (lane == j) mymask = mg; }
            } else {
                unsigned key[33];
#pragma unroll
                for (int j = 0; j < 33; ++j) { const unsigned u = __float_as_uint(val[j]); const unsigned srt = (u & 0x80000000u) ? ~u : (u | 0x80000000u); key[j] = (lane + 64 * j <= tpos) ? srt : 0u; }
                unsigned prefix = 0u, himask = 0u; int need2 = TOPK;
#pragma unroll 1
                for (int pass = 3; pass >= 0; --pass) {
                    const int sh = 8 * pass;
                    __builtin_amdgcn_fence(__ATOMIC_SEQ_CST, "wavefront");
                    *(LAS f32x4*)(hist + 4 * lane) = (f32x4){0.f, 0.f, 0.f, 0.f};
                    __builtin_amdgcn_fence(__ATOMIC_SEQ_CST, "wavefront");
#pragma unroll
                    for (int j = 0; j < 33; ++j) if ((key[j] & himask) == prefix) __hip_atomic_fetch_add((LAS int*)hist + ((key[j] >> sh) & 255u), 1, __ATOMIC_RELAXED, __HIP_MEMORY_SCOPE_WAVEFRONT);
                    __builtin_amdgcn_fence(__ATOMIC_SEQ_CST, "wavefront");
                    const int h0 = hist[4 * lane], h1 = hist[4 * lane + 1], h2 = hist[4 * lane + 2], h3 = hist[4 * lane + 3];
                    const int tl = h0 + h1 + h2 + h3;
                    int sfx = tl;
#pragma unroll
                    for (int o = 1; o < 64; o <<= 1) { const int v = __shfl_down(sfx, o); if (lane + o < 64) sfx += v; }
                    const int above = sfx - tl;
                    const bool mine = above < need2 && need2 <= sfx;
                    int bsel, asel;
                    if (above + h3 >= need2) { bsel = 3; asel = above; }
                    else if (above + h3 + h2 >= need2) { bsel = 2; asel = above + h3; }
                    else if (above + h3 + h2 + h1 >= need2) { bsel = 1; asel = above + h3 + h2; }
                    else { bsel = 0; asel = above + h3 + h2 + h1; }
                    const unsigned long long bm = __ballot(mine);
                    const int src = bm ? (int)__ffsll((long long)bm) - 1 : 0;
                    const int bs = __shfl(4 * lane + bsel, src), aab = __shfl(asel, src);
                    prefix |= (unsigned)bs << sh; himask |= 255u << sh; need2 -= aab;
                }
#pragma unroll
                for (int j = 0; j < 33; ++j) {
                    const unsigned long long mg = __ballot(key[j] > prefix);
                    unsigned long long me = __ballot(key[j] == prefix);
                    const int ne = __popcll(me);
                    if (ne <= need2) need2 -= ne;
                    else { while (__popcll(me) > need2) me &= ~(1ull << (63 - __clzll(me))); need2 = 0; }
                    if (lane == j) mymask = mg | me;
                }
            }
        }
        if (lane < 33) p.MASK[(size_t)(qrow0 + qi) * 33 + lane] = mymask;
    }
    lds_barrier();
    SEG(SAMPLE ? 3 : 1);
#if STAMPS == 2
    if (blockIdx.x == 0 && threadIdx.x == 0) atomicAdd(&p.bar[3620 + (SAMPLE ? 5 : 4)], 100u);
#endif
}
__device__ __forceinline__ void phase5(const Params& p, LAS unsigned char* lds) {
    constexpr int NQT = LP / 16;
    const int NU = NB * NQT + DBATCH;
    LAS int* slot = (LAS int*)(lds + 163840 - 32);
    for (;;) {
        lds_barrier();
        if (tidx() == 0) *slot = (int)__hip_atomic_fetch_add(p.bar + 3700, 1u, __ATOMIC_RELAXED, __HIP_MEMORY_SCOPE_AGENT);
        lds_barrier();
        const int u = *slot;
        if (u >= NU) break;
        if (u < DBATCH) indexer_unit<true>(p, lds, MP + u * TS, TS, PAST, 0, u);
        else { const int v = u - DBATCH, b = v % NB, qt = NQT - 1 - v / NB; indexer_unit<false>(p, lds, b * LP + qt * 16, 16, qt * 16, b * LP, 0); }
    }
}

typedef short s16x4 __attribute__((ext_vector_type(4)));
constexpr int VS = 144;
template <int NRT, bool QLDS>
__device__ __forceinline__ void attn_tile32(const LAS bf16_t* Ks, const LAS bf16_t* Vt, const bf16x8 (&qfr)[NRT][4], const LAS bf16x8* qlds, const unsigned (&mbits)[NRT], float (&m)[NRT], float (&l)[NRT], f32x4 (&acco)[NRT][8], int lane) {
    const int r = lane & 15, q = lane >> 4;
    constexpr float CSC = 0.12751743082459868f;
    bf16x8 qf[NRT][4];
#pragma unroll
    for (int rt = 0; rt < NRT; ++rt)
#pragma unroll
        for (int ks = 0; ks < 4; ++ks) qf[rt][ks] = QLDS ? qlds[(rt * 4 + ks) * 64 + lane] : qfr[rt][ks];
    f32x4 s[NRT][2];
#pragma unroll
    for (int sub = 0; sub < 2; ++sub) {
        const LAS bf16_t* kp = Ks + (sub * 16 + r) * 136 + 8 * q;
#pragma unroll
        for (int rt = 0; rt < NRT; ++rt) s[rt][sub] = (f32x4){0.f, 0.f, 0.f, 0.f};
#pragma unroll
        for (int ks = 0; ks < 4; ++ks) {
            const bf16x8 kf = *(const LAS bf16x8*)(kp + ks * 32);
#pragma unroll
            for (int rt = 0; rt < NRT; ++rt) s[rt][sub] = __builtin_amdgcn_mfma_f32_16x16x32_bf16(kf, qf[rt][ks], s[rt][sub], 0, 0, 0);
        }
    }
#if !defined(ATTN_OVERLAP) || ATTN_OVERLAP < 2
    __builtin_amdgcn_sched_barrier(0);
#endif
    bf16x8 pf[NRT];
#pragma unroll
    for (int rt = 0; rt < NRT; ++rt) {
        float tmax;
        asm("v_max3_f32 %0, %1, %2, %3" : "=v"(tmax) : "v"(s[rt][0][0]), "v"(s[rt][0][1]), "v"(s[rt][0][2]));
        asm("v_max3_f32 %0, %1, %2, %3" : "=v"(tmax) : "v"(tmax), "v"(s[rt][0][3]), "v"(s[rt][1][0]));
        asm("v_max3_f32 %0, %1, %2, %3" : "=v"(tmax) : "v"(tmax), "v"(s[rt][1][1]), "v"(s[rt][1][2]));
        asm("v_max_f32 %0, %1, %2" : "=v"(tmax) : "v"(tmax), "v"(s[rt][1][3]));
        tmax = fmaxf(tmax, __uint_as_float(lane_xor<16>(__float_as_uint(tmax), lane))); tmax = fmaxf(tmax, __uint_as_float(lane_xor<32>(__float_as_uint(tmax), lane)));
        const bool big = (tmax - m[rt]) * CSC > 8.f;
        if (__any(big)) {
            const float mn = big ? tmax : m[rt];
            const float alpha = __builtin_amdgcn_exp2f((m[rt] - mn) * CSC);
            m[rt] = mn; l[rt] *= alpha;
#pragma unroll
            for (int dt = 0; dt < 8; ++dt) acco[rt][dt] *= alpha;
        }
        const float nb = -m[rt] * CSC;
        const int mq = (int)(mbits[rt] >> (4 * q));
        float psum = 0.f;
#pragma unroll
        for (int sub = 0; sub < 2; ++sub)
#pragma unroll
            for (int i = 0; i < 4; ++i) {
                const float e = __builtin_amdgcn_exp2f(fmaf(s[rt][sub][i], CSC, nb));
                int mk; asm("v_bfe_i32 %0, %1, %2, 1" : "=v"(mk) : "v"(mq), "n"(sub * 16 + i));
                const float pv = __uint_as_float(__float_as_uint(e) & (unsigned)mk);
                s[rt][sub][i] = pv; psum += pv;
            }
        l[rt] += psum;
        {
            u32x4 w;
            asm("v_cvt_pk_bf16_f32 %0, %1, %2" : "=v"(w.x) : "v"(s[rt][0][0]), "v"(s[rt][0][1]));
            asm("v_cvt_pk_bf16_f32 %0, %1, %2" : "=v"(w.y) : "v"(s[rt][0][2]), "v"(s[rt][0][3]));
            asm("v_cvt_pk_bf16_f32 %0, %1, %2" : "=v"(w.z) : "v"(s[rt][1][0]), "v"(s[rt][1][1]));
            asm("v_cvt_pk_bf16_f32 %0, %1, %2" : "=v"(w.w) : "v"(s[rt][1][2]), "v"(s[rt][1][3]));
            pf[rt] = __builtin_bit_cast(bf16x8, w);
        }
    }
#if !defined(ATTN_OVERLAP) || ATTN_OVERLAP < 2
    __builtin_amdgcn_sched_barrier(0);
#endif
    const LAS bf16_t* vbase = Vt + (4 * q + (r >> 2)) * VS + 4 * (r & 3);
#pragma unroll
    for (int dt = 0; dt < 8; ++dt) {
        const s16x4 v0 = __builtin_amdgcn_ds_read_tr16_b64_v4i16((LAS s16x4*)(vbase + dt * 16));
        const s16x4 v1 = __builtin_amdgcn_ds_read_tr16_b64_v4i16((LAS s16x4*)(vbase + 16 * VS + dt * 16));
        bf16x8 vf; vf[0] = v0[0]; vf[1] = v0[1]; vf[2] = v0[2]; vf[3] = v0[3]; vf[4] = v1[0]; vf[5] = v1[1]; vf[6] = v1[2]; vf[7] = v1[3];
#pragma unroll
        for (int rt = 0; rt < NRT; ++rt) acco[rt][dt] = __builtin_amdgcn_mfma_f32_16x16x32_bf16(vf, pf[rt], acco[rt][dt], 0, 0, 0);
    }
#ifndef ATTN_OVERLAP
    __builtin_amdgcn_sched_barrier(0);
#endif
}
__device__ __forceinline__ void attn_finish(const f32x4 (&acco)[8], float l, bf16_t* orow  , int lane) {
    const int q = lane >> 4;
    l += __uint_as_float(lane_xor<16>(__float_as_uint(l), lane)); l += __uint_as_float(lane_xor<32>(__float_as_uint(l), lane));
    const float inv = 1.f / l;
    if (orow) {
#pragma unroll
        for (int dt = 0; dt < 8; ++dt) st4_bf16_g(orow + dt * 16 + 4 * q, acco[dt] * inv);
    }
}

constexpr int KS_BYTES = 64 * 136 * 2, VT_BYTES = 64 * VS * 2;

__device__ __forceinline__ void attn_prompt_unit(const Params& p, LAS unsigned char* lds, int b, int qb) {
    const int tid = tidx(), lane = tid & 63, wave = __builtin_amdgcn_readfirstlane(tid >> 6), r = lane & 15, q = lane >> 4;
    const int head = wave, kvh = wave >> 2;
    LAS bf16_t* Ks0 = (LAS bf16_t*)lds;
    LAS bf16_t* Vt0 = (LAS bf16_t*)(lds + 2 * KS_BYTES);
    const int t0 = qb * 32, nkt = (t0 + 31) / 64 + 1;
    const int rowb = b * LP;
    float m[2] = {-1e30f, -1e30f}, l[2] = {0.f, 0.f}; f32x4 acco[2][8];
    LAS bf16x8* qlds = (LAS bf16x8*)(lds + 2 * KS_BYTES + 2 * VT_BYTES) + wave * 512;
#pragma unroll
    for (int rt = 0; rt < 2; ++rt) {
        const bf16_t* qsrc = p.PARTS + (size_t)(rowb + t0 + rt * 16 + r) * NPAD + C_AQ + head * 128 + 8 * q;
#pragma unroll
        for (int ks = 0; ks < 4; ++ks) qlds[(rt * 4 + ks) * 64 + lane] = *(const bf16x8*)(qsrc + ks * 32);
#pragma unroll
        for (int dt = 0; dt < 8; ++dt) acco[rt][dt] = (f32x4){0.f, 0.f, 0.f, 0.f};
    }
    const bf16x8 qdummy[2][4] = {};
    u32x4 kreg[2][2], vreg[2][2];
    auto load_k = [&](int kt) {
#pragma unroll
        for (int kh = 0; kh < 2; ++kh)
#pragma unroll
            for (int it = 0; it < 2; ++it) {
                const int id = tid + 512 * it, key = id >> 4, ch = id & 15;
                kreg[kh][it] = *(const u32x4*)(p.AKC + (size_t)(rowb + kt * 64 + key) * 256 + kh * 128 + ch * 8);
            }
    };
    auto load_v = [&](int kt) {
#pragma unroll
        for (int kh = 0; kh < 2; ++kh)
#pragma unroll
            for (int it = 0; it < 2; ++it) {
                const int id = tid + 512 * it, vkey = id >> 4, vch = id & 15;
                vreg[kh][it] = *(const u32x4*)(p.AVC + (size_t)(rowb + kt * 64 + vkey) * 256 + kh * 128 + vch * 8);
            }
    };
    auto store_tile = [&]() {
#pragma unroll
        for (int kh = 0; kh < 2; ++kh)
#pragma unroll
            for (int it = 0; it < 2; ++it) {
                const int id = tid + 512 * it, key = id >> 4, ch = id & 15;
                *(LAS u32x4*)((LAS unsigned char*)Ks0 + kh * KS_BYTES + (key * 136 + ch * 8) * 2) = kreg[kh][it];
                *(LAS u32x4*)((LAS unsigned char*)Vt0 + kh * VT_BYTES + (key * VS + ch * 8) * 2) = vreg[kh][it];
            }
    };
    load_k(0); load_v(0);
    const unsigned long long* mrow0 = p.MASK + (size_t)(rowb + t0 + r) * 33;
    const unsigned long long* mrow1 = mrow0 + 16 * 33;
    unsigned long long mn0 = mrow0[0], mn1 = mrow1[0];
#pragma unroll 1
    for (int kt = 0; kt < nkt; ++kt) {
        store_tile();
        lds_barrier();
        const unsigned long long mw0 = mn0, mw1 = mn1;
        if (kt + 1 < nkt) { load_k(kt + 1); load_v(kt + 1); mn0 = mrow0[kt + 1]; mn1 = mrow1[kt + 1]; }
        const LAS bf16_t* Ks = (const LAS bf16_t*)((LAS unsigned char*)Ks0 + kvh * KS_BYTES);
        const LAS bf16_t* Vt = (const LAS bf16_t*)((LAS unsigned char*)Vt0 + kvh * VT_BYTES);
        { const unsigned mb[2] = {(unsigned)mw0, (unsigned)mw1}; attn_tile32<2, true>(Ks, Vt, qdummy, qlds, mb, m, l, acco, lane); }
        { const unsigned mb[2] = {(unsigned)(mw0 >> 32), (unsigned)(mw1 >> 32)}; attn_tile32<2, true>(Ks + 32 * 136, Vt + 32 * VS, qdummy, qlds, mb, m, l, acco, lane); }
        lds_barrier();
    }
#pragma unroll
    for (int rt = 0; rt < 2; ++rt) {
        const int t = t0 + rt * 16 + r;
        attn_finish(acco[rt], l[rt], (t >= NMETA && t < LP) ? p.OATT + (size_t)(b * SEQ + t - NMETA) * D + head * 128 : nullptr, lane);
    }
}

__device__ __forceinline__ void attn_sample_unit(const Params& p, LAS unsigned char* lds, int sb, int kvh) {
    const int tid = tidx(), lane = tid & 63, wave = __builtin_amdgcn_readfirstlane(tid >> 6), r = lane & 15, q = lane >> 4;
    LAS bf16_t* Ks = (LAS bf16_t*)lds;
    LAS bf16_t* Vt = (LAS bf16_t*)(lds + KS_BYTES);
    const int rowq = MP + sb * TS;
    constexpr int nkt = (PAST + TS + 63) / 64;
    const int tok = r & 7, head = kvh * 4 + (wave & 1) * 2 + (r >> 3);
    bf16x8 qf[1][4]; float m[1] = {-1e30f}, l[1] = {0.f}; f32x4 acco[1][8];
    {
        const bf16_t* qsrc = p.PARTS + (size_t)(rowq + tok) * NPAD + C_AQ + head * 128 + 8 * q;
#pragma unroll
        for (int ks = 0; ks < 4; ++ks) qf[0][ks] = *(const bf16x8*)(qsrc + ks * 32);
#pragma unroll
        for (int dt = 0; dt < 8; ++dt) acco[0][dt] = (f32x4){0.f, 0.f, 0.f, 0.f};
    }
    f32x4 kA[2][2], vA[2][2], kB[2][2], vB[2][2];
    LAS int* pages = (LAS int*)(lds + KS_BYTES + VT_BYTES);
    if (tid < NPAGES) pages[tid] = p.page_table[sb * NPAGES + tid];
    lds_barrier();
    auto src_row = [&](const float* cache, int s, int c_new) -> const float* {
        const int page = pages[s >> 7];
        return cache + (((size_t)page * PAGE + (s & 127)) * AKV + kvh) * ADH;
    };
    auto load_tile = [&](int kt, f32x4 (&kreg)[2][2], f32x4 (&vreg)[2][2]) {
        if (kt * 64 < PAST) {
#pragma unroll
            for (int it = 0; it < 2; ++it) {
                const int id = tid + 512 * it, key = id >> 4, ch = id & 15, s = kt * 64 + key;
                const float* a = src_row(p.cache_k, s, 0) + ch * 8; kreg[it][0] = *(const f32x4*)a; kreg[it][1] = *(const f32x4*)(a + 4);
                const float* b = src_row(p.cache_v, s, 0) + ch * 8; vreg[it][0] = *(const f32x4*)b; vreg[it][1] = *(const f32x4*)(b + 4);
            }
        } else {
#pragma unroll
            for (int it = 0; it < 2; ++it) {
                const int id = tid + 512 * it, key = id >> 4, ch = id & 15, s = kt * 64 + key;
                const int sn = s - PAST < TS ? s - PAST : TS - 1;
                const u32x4 w = *(const u32x4*)(p.PARTS + (size_t)(rowq + sn) * NPAD + C_AK + kvh * 128 + ch * 8);
                kreg[it][0] = (f32x4){bflo(w.x), bfhi(w.x), bflo(w.y), bfhi(w.y)}; kreg[it][1] = (f32x4){bflo(w.z), bfhi(w.z), bflo(w.w), bfhi(w.w)};
                const u32x4 x = *(const u32x4*)(p.PARTS + (size_t)(rowq + sn) * NPAD + C_AV + kvh * 128 + ch * 8);
                vreg[it][0] = (f32x4){bflo(x.x), bfhi(x.x), bflo(x.y), bfhi(x.y)}; vreg[it][1] = (f32x4){bflo(x.z), bfhi(x.z), bflo(x.w), bfhi(x.w)};
            }
        }
    };
    auto store_tile = [&](const f32x4 (&kreg)[2][2], const f32x4 (&vreg)[2][2]) {
#pragma unroll
        for (int it = 0; it < 2; ++it) {
            const int id = tid + 512 * it, key = id >> 4, ch = id & 15;
            const bf16x8 kw = pack8(kreg[it][0], kreg[it][1]);
            *(LAS bf16x8*)(Ks + key * 136 + ch * 8) = kw;
            *(LAS bf16x8*)(Vt + key * VS + ch * 8) = pack8(vreg[it][0], vreg[it][1]);
        }
    };
    load_tile(0, kA, vA); load_tile(1, kB, vB);
    const unsigned long long* mrow = p.MASK + (size_t)(rowq + tok) * 33;
    unsigned long long mnx = mrow[0];
    auto compute = [&](unsigned long long mw0) {
        if (wave < 2) {
            { const unsigned mb[1] = {(unsigned)mw0}; attn_tile32<1, false>(Ks, Vt, qf, nullptr, mb, m, l, acco, lane); }
            { const unsigned mb[1] = {(unsigned)(mw0 >> 32)}; attn_tile32<1, false>(Ks + 32 * 136, Vt + 32 * VS, qf, nullptr, mb, m, l, acco, lane); }
        }
    };
#pragma unroll 1
    for (int kt = 0; kt < nkt; kt += 2) {
        store_tile(kA, vA);
        lds_barrier();
        unsigned long long mw0 = mnx;
        if (kt + 1 < nkt) mnx = mrow[kt + 1];
        if (kt + 2 < nkt) load_tile(kt + 2, kA, vA);
        compute(mw0);
        lds_barrier();
        if (kt + 1 < nkt) {
            store_tile(kB, vB);
            lds_barrier();
            mw0 = mnx;
            if (kt + 2 < nkt) mnx = mrow[kt + 2];
            if (kt + 3 < nkt) load_tile(kt + 3, kB, vB);
            compute(mw0);
            lds_barrier();
        }
    }
    if (wave < 2) attn_finish(acco[0], l[0], p.OATT + (size_t)(MFB + sb * TS + tok) * D + head * 128, lane);
}

__device__ __forceinline__ void phase6(const Params& p, LAS unsigned char* lds) {
    constexpr int NQB = (LP + 31) / 32;
    constexpr int NU = NB * NQB;
    const int G = p.G;
    if (blockIdx.x & 1) for (int u = blockIdx.x; u < DBATCH * AKV; u += G) attn_sample_unit(p, lds, u >> 1, u & 1);
    for (int i = blockIdx.x, round = 0; ; ++round) {
        int li;
        if (round == 0) li = blockIdx.x; else if (round == 1) li = 2 * G - 1 - blockIdx.x; else li = round * G + blockIdx.x;
        if (round >= 2 && li >= NU) break;
        if (li < NU) { const int qb = NQB - 1 - li / NB, b = li % NB; attn_prompt_unit(p, lds, b, qb); }
        (void)i;
    }
    if (!(blockIdx.x & 1)) for (int u = blockIdx.x; u < DBATCH * AKV; u += G) attn_sample_unit(p, lds, u >> 1, u & 1);
}

__device__ __forceinline__ void unpack8(const u32x4 w, float (&o)[8]) {
    o[0] = bflo(w.x); o[1] = bfhi(w.x); o[2] = bflo(w.y); o[3] = bfhi(w.y); o[4] = bflo(w.z); o[5] = bfhi(w.z); o[6] = bflo(w.w); o[7] = bfhi(w.w);
}
template <int MODE> struct EpiFin {
    static constexpr bool PERM = true, AFTER_DRAIN = false;
    Params p;
    struct Grp { u32x4 gate[2]; f32x4 t[2][2]; u32x4 mg[2]; };
    __device__ __forceinline__ void load_grp(Grp& G, int row, int col0) const {
        const int frow = full_row(row);
#pragma unroll
        for (int bj = 0; bj < 2; ++bj) {
            const int col = col0 + bj * 128;
            if (MODE == 0 || MODE == 1) G.gate[bj] = *(const u32x4*)(p.PARTS + (size_t)frow * NPAD + (MODE == 0 ? C_GA : C_GB) + col);
            if (MODE == 1) G.mg[bj] = *(const u32x4*)(p.MERGED + (size_t)row * D + col);
            if (MODE == 2) { const float* src = (row < MFB ? p.x_prompt + (size_t)row * D : p.x_sample + (size_t)(row - MFB) * D) + col; G.t[bj][0] = *(const f32x4*)src; G.t[bj][1] = *(const f32x4*)(src + 4); }
        }
    }
    __device__ __forceinline__ void operator()(const pg8::f32x4 (&acc)[2][2][4][2], const pg8::Unit& u, int wr, int wc, int fr, int fq) const {
        const int row0 = u.pm * 256 + wr * 64 + fr, col0 = u.pn * 256 + wc * 32 + 8 * fq;
        Grp cur, nxt;
        if (MODE != 3) load_grp(cur, row0, col0);
#pragma unroll
        for (int gi = 0; gi < 8; ++gi) {
            const int ai = gi >> 2, m = gi & 3;
            const int row = row0 + ai * 128 + m * 16;
            if (MODE != 3 && gi < 7) load_grp(nxt, row0 + ((gi + 1) >> 2) * 128 + ((gi + 1) & 3) * 16, col0);
#pragma unroll
            for (int bj = 0; bj < 2; ++bj) {
                const int col = col0 + bj * 128;
                float v[8] = {acc[ai][bj][m][0][0], acc[ai][bj][m][0][1], acc[ai][bj][m][0][2], acc[ai][bj][m][0][3], acc[ai][bj][m][1][0], acc[ai][bj][m][1][1], acc[ai][bj][m][1][2], acc[ai][bj][m][1][3]};
                if (MODE == 0 || MODE == 1) {
                    float g[8]; unpack8(cur.gate[bj], g);
#pragma unroll
                    for (int i = 0; i < 8; ++i) v[i] *= sigmoidf_(g[i]);
                }
                if (MODE == 0) {
                    u32x4 w; w.x = pk2(v[0], v[1]); w.y = pk2(v[2], v[3]); w.z = pk2(v[4], v[5]); w.w = pk2(v[6], v[7]);
                    *(u32x4*)(p.MERGED + (size_t)row * D + col) = w;
                } else if (MODE == 1) {
                    float a[8]; unpack8(cur.mg[bj], a);
                    u32x4 w; w.x = pk2(v[0] + a[0], v[1] + a[1]); w.y = pk2(v[2] + a[2], v[3] + a[3]); w.z = pk2(v[4] + a[4], v[5] + a[5]); w.w = pk2(v[6] + a[6], v[7] + a[7]);
                    *(u32x4*)(p.MERGED + (size_t)row * D + col) = w;
                } else if (MODE == 2) {
                    const f32x4 a = cur.t[bj][0], b = cur.t[bj][1];
                    float* dst = p.V1 + (size_t)row * D + col;
                    *(f32x4*)dst = (f32x4){DN_ALPHA * a.x + v[0], DN_ALPHA * a.y + v[1], DN_ALPHA * a.z + v[2], DN_ALPHA * a.w + v[3]};
                    *(f32x4*)(dst + 4) = (f32x4){DN_ALPHA * b.x + v[4], DN_ALPHA * b.y + v[5], DN_ALPHA * b.z + v[6], DN_ALPHA * b.w + v[7]};
                } else {
                    u32x4 w; w.x = pk2h(v[0], v[1]); w.y = pk2h(v[2], v[3]); w.z = pk2h(v[4], v[5]); w.w = pk2h(v[6], v[7]);
                    *(u32x4*)(p.QRY + (size_t)row * 2048 + col) = w;
                }
            }
            if (MODE != 3) cur = nxt;
        }
    }
};
template <int MODE>
__device__ __forceinline__ void fin_gemm(const Params& p, LAS unsigned char* lds, const bf16_t* A, const bf16_t* Bt, int N) {
    pg8::Gemm g; g.A = A; g.Bt = Bt; g.M = MFB; g.N = N; g.K = D; g.A2 = A; g.Bt2 = Bt;
    pg8::StaticOrder S; S.init(MFB, N, p.G, blockIdx.x);
    EpiFin<MODE> E; E.p = p;
    pg8::gemm_phase<EpiFin<MODE>, pg8::StaticOrder, false>(lds, g, S, E, nullptr);
}
constexpr int SG_LD = 520;
__device__ __forceinline__ void sg_load(const bf16_t* A, const bf16_t* B, int kh, u32x4 (&ra)[8], u32x4 (&rb)[8], int tid) {
#pragma unroll
    for (int i = 0; i < 8; ++i) {
        const int pc = tid + i * 512, row = pc >> 6, ch = pc & 63;
        ra[i] = *(const u32x4*)(A + (size_t)row * D + kh * 512 + ch * 8);
        rb[i] = *(const u32x4*)(B + (size_t)row * D + kh * 512 + ch * 8);
    }
}
__device__ __forceinline__ void sg_store(LAS bf16_t* sA, LAS bf16_t* sB, const u32x4 (&ra)[8], const u32x4 (&rb)[8], int tid) {
#pragma unroll
    for (int i = 0; i < 8; ++i) {
        const int pc = tid + i * 512, row = pc >> 6, ch = pc & 63;
        *(LAS u32x4*)(sA + row * SG_LD + ch * 8) = ra[i];
        *(LAS u32x4*)(sB + row * SG_LD + ch * 8) = rb[i];
    }
}
template <int KIND>
__device__ __forceinline__ void small_gemm(const Params& p, LAS unsigned char* lds, int ncols) {
    constexpr int NG = KIND == 0 ? 2 : 1;
    const int tid = tidx(), lane = tid & 63, wave = __builtin_amdgcn_readfirstlane(tid >> 6), r = lane & 15, q = lane >> 4, wm = wave >> 1, wn = wave & 1;
    LAS bf16_t* sA = (LAS bf16_t*)lds;
    LAS bf16_t* sB = sA + 64 * SG_LD;
    const int ntn = ncols / 64, ntiles = (MS / 64) * ntn;
    for (int tl = blockIdx.x; tl < ntiles; tl += p.G) {
        const int tm = tl / ntn, tn = tl % ntn;
        const bf16_t* A[2]; const bf16_t* B[2];
        A[0] = (KIND == 0 ? p.OGDN : KIND == 1 ? p.MERGED : p.HB) + (size_t)(MFB + tm * 64) * D;
        B[0] = (KIND == 0 ? p.WBGT : KIND == 1 ? p.WOUTT : p.WQT) + (size_t)(tn * 64) * D;
        A[1] = p.OATT + (size_t)(MFB + tm * 64) * D; B[1] = p.WBAT + (size_t)(tn * 64) * D;
        f32x4 acc[2][2];
#pragma unroll
        for (int g = 0; g < 2; ++g) { acc[g][0] = (f32x4){0.f, 0.f, 0.f, 0.f}; acc[g][1] = (f32x4){0.f, 0.f, 0.f, 0.f}; }
        u32x4 ra[8], rb[8];
        sg_load(A[0], B[0], 0, ra, rb, tid);
#pragma unroll
        for (int st = 0; st < 2 * NG; ++st) {
            const int g = st >> 1;
            lds_barrier();
            sg_store(sA, sB, ra, rb, tid);
            lds_barrier();
            if (st + 1 < 2 * NG) sg_load(A[(st + 1) >> 1], B[(st + 1) >> 1], (st + 1) & 1, ra, rb, tid);
            const LAS bf16_t* ap = sA + (wm * 16 + r) * SG_LD + 8 * q;
            const LAS bf16_t* bp = sB + (wn * 32 + r) * SG_LD + 8 * q;
#pragma unroll
            for (int ks = 0; ks < 16; ++ks) {
                const bf16x8 a = *(const LAS bf16x8*)(ap + ks * 32);
                acc[g][0] = __builtin_amdgcn_mfma_f32_16x16x32_bf16(a, *(const LAS bf16x8*)(bp + ks * 32), acc[g][0], 0, 0, 0);
                acc[g][1] = __builtin_amdgcn_mfma_f32_16x16x32_bf16(a, *(const LAS bf16x8*)(bp + 16 * SG_LD + ks * 32), acc[g][1], 0, 0, 0);
            }
        }
        float ga[2][4], gb[2][4];
#pragma unroll
        for (int n = 0; n < 2; ++n)
#pragma unroll
            for (int i = 0; i < 4; ++i) {
                const int fr = MFB + tm * 64 + wm * 16 + 4 * q + i, col = tn * 64 + wn * 32 + n * 16 + r;
                if (KIND == 0) { const bf16_t* gp = p.PARTS + (size_t)(fr + (MP - MFB)) * NPAD; ga[n][i] = bf2f(gp[C_GA + col]); gb[n][i] = bf2f(gp[C_GB + col]); }
                if (KIND == 1) ga[n][i] = p.x_sample[(size_t)(fr - MFB) * D + col];
            }
#pragma unroll
        for (int n = 0; n < 2; ++n)
#pragma unroll
            for (int i = 0; i < 4; ++i) {
                const int fr = MFB + tm * 64 + wm * 16 + 4 * q + i, col = tn * 64 + wn * 32 + n * 16 + r;
                if (KIND == 0) p.MERGED[(size_t)fr * D + col] = f2bf(sigmoidf_(ga[n][i]) * acc[0][n][i] + sigmoidf_(gb[n][i]) * acc[1][n][i]);
                else if (KIND == 1) p.V1[(size_t)fr * D + col] = DN_ALPHA * ga[n][i] + acc[0][n][i];
                else p.QRY[(size_t)fr * 2048 + col] = __builtin_bit_cast(bf16_t, (_Float16)acc[0][n][i]);
            }
    }
    lds_barrier();
}
struct PairOrder : pg8::StaticOrder {
    __device__ bool next(int i, pg8::Unit& u) const { if (!pg8::StaticOrder::next(i >> 1, u)) return false; u.sel = i & 1; return true; }
};
struct EpiPair {
    static constexpr bool PERM = true, AFTER_DRAIN = false; static constexpr int MIDK = 0;
    EpiFin<0> e0; EpiFin<1> e1;
    __device__ __forceinline__ void operator()(const pg8::f32x4 (&acc)[2][2][4][2], const pg8::Unit& u, int wr, int wc, int fr, int fq) const {
        if (u.sel == 0) e0(acc, u, wr, wc, fr, fq); else e1(acc, u, wr, wc, fr, fq);
    }
};
__device__ __forceinline__ void phase7(const Params& p, LAS unsigned char* lds) {
    {
        pg8::Gemm g; g.A = p.OGDN; g.Bt = p.WBGT; g.A2 = p.OATT; g.Bt2 = p.WBAT; g.M = MFB; g.N = D; g.K = D;
        PairOrder S; S.init(MFB, D, p.G, blockIdx.x);
        EpiPair E; E.e0.p = p; E.e1.p = p;
        pg8::gemm_phase<EpiPair, PairOrder, false>(lds, g, S, E, nullptr);
    }
    small_gemm<0>(p, lds, D);
}
__device__ __forceinline__ void phase8(const Params& p, LAS unsigned char* lds) { fin_gemm<2>(p, lds, p.MERGED, p.WOUTT, D); small_gemm<1>(p, lds, D); }

__device__ __forceinline__ void ln_row(float (&v)[16], const float* g, const float* b, int lane) {
    float s = 0.f;
#pragma unroll
    for (int i = 0; i < 16; ++i) s += v[i];
    const float mu = wave_sum(s) * (1.f / D);
    float s2 = 0.f;
#pragma unroll
    for (int i = 0; i < 16; ++i) { v[i] -= mu; s2 += v[i] * v[i]; }
    const float rstd = rsqrtf(wave_sum(s2) * (1.f / D) + LN_EPS);
#pragma unroll
    for (int i = 0; i < 16; i += 4) {
        const f32x4 gg = *(const f32x4*)(g + lane * 16 + i), bb = *(const f32x4*)(b + lane * 16 + i);
        v[i] = v[i] * rstd * gg.x + bb.x; v[i + 1] = v[i + 1] * rstd * gg.y + bb.y; v[i + 2] = v[i + 2] * rstd * gg.z + bb.z; v[i + 3] = v[i + 3] * rstd * gg.w + bb.w;
    }
}
__device__ __forceinline__ void phase9(const Params& p, LAS unsigned char* lds) {
    const int lane = tidx() & 63, gw = blockIdx.x * 8 + __builtin_amdgcn_readfirstlane(tidx() >> 6), ngw = p.G * 8;
    for (int row0 = gw; row0 < MF; row0 += 2 * ngw) {
        f32x4 in[2][4];
#pragma unroll
        for (int k = 0; k < 2; ++k) {
            const int row = row0 + k * ngw < MF ? row0 + k * ngw : row0;
            const float* src = p.V1 + (size_t)row * D + lane * 16;
#pragma unroll
            for (int i = 0; i < 4; ++i) in[k][i] = *(const f32x4*)(src + 4 * i);
        }
#pragma unroll
        for (int k = 0; k < 2; ++k) {
            const int row = row0 + k * ngw;
            if (row < MF) {
                float v[16];
#pragma unroll
                for (int i = 0; i < 4; ++i) { v[4 * i] = in[k][i].x; v[4 * i + 1] = in[k][i].y; v[4 * i + 2] = in[k][i].z; v[4 * i + 3] = in[k][i].w; }
                ln_row(v, p.ln1_g, p.ln1_b, lane);
                float* dst = p.V1 + (size_t)row * D + lane * 16;
#pragma unroll
                for (int i = 0; i < 16; i += 4) *(f32x4*)(dst + i) = (f32x4){v[i], v[i + 1], v[i + 2], v[i + 3]};
                u32x4 w0, w1;
                w0.x = pk2(v[0], v[1]); w0.y = pk2(v[2], v[3]); w0.z = pk2(v[4], v[5]); w0.w = pk2(v[6], v[7]);
                w1.x = pk2(v[8], v[9]); w1.y = pk2(v[10], v[11]); w1.z = pk2(v[12], v[13]); w1.w = pk2(v[14], v[15]);
                *(u32x4*)(p.HB + (size_t)row * D + lane * 16) = w0; *(u32x4*)(p.HB + (size_t)row * D + lane * 16 + 8) = w1;
            }
        }
    }
}
__device__ __forceinline__ void phase10(const Params& p, LAS unsigned char* lds) { fin_gemm<3>(p, lds, p.HB, p.WQT, 2048); small_gemm<2>(p, lds, 2048); }

template <int N> __device__ __forceinline__ void bitonic_sort_desc(float (&v)[N]) {
#pragma unroll
    for (int k = 2; k <= N; k <<= 1)
#pragma unroll
        for (int j = k >> 1; j > 0; j >>= 1)
#pragma unroll
            for (int i = 0; i < N; ++i) {
                const int l = i ^ j;
                if (l > i) {
                    const bool desc = ((i & k) == 0);
                    const float a = v[i], b = v[l];
                    v[i] = desc ? fmaxf(a, b) : fminf(a, b);
                    v[l] = desc ? fminf(a, b) : fmaxf(a, b);
                }
            }
}
template <int N> __device__ __forceinline__ void bitonic_merge_desc(float (&v)[N]) {
#pragma unroll
    for (int j = N >> 1; j > 0; j >>= 1)
#pragma unroll
        for (int i = 0; i < N; ++i) { const int l = i ^ j; if (l > i) { const float a = v[i], b = v[l]; v[i] = fmaxf(a, b); v[l] = fminf(a, b); } }
}
__device__ __forceinline__ void merge_top16(float (&a)[16], int mask) {
    float b[16];
#pragma unroll
    for (int i = 0; i < 16; ++i) b[i] = __shfl_xor(a[15 - i], mask);
#pragma unroll
    for (int i = 0; i < 16; ++i) a[i] = fmaxf(a[i], b[i]);
    bitonic_merge_desc<16>(a);
}
__device__ __forceinline__ void ce_kp(float& ka, int& pa, float& kb, int& pb) {
    const bool sw = kb > ka;
    const float k0 = sw ? kb : ka, k1 = sw ? ka : kb; const int p0 = sw ? pb : pa, p1 = sw ? pa : pb;
    ka = k0; kb = k1; pa = p0; pb = p1;
}
__device__ __forceinline__ void bitonic_sort_desc_kp16(float (&v)[16], int (&pl)[16]) {
#pragma unroll
    for (int k = 2; k <= 16; k <<= 1)
#pragma unroll
        for (int j = k >> 1; j > 0; j >>= 1)
#pragma unroll
            for (int i = 0; i < 16; ++i) { const int l = i ^ j; if (l > i) { if ((i & k) == 0) ce_kp(v[i], pl[i], v[l], pl[l]); else ce_kp(v[l], pl[l], v[i], pl[i]); } }
}
__device__ __forceinline__ void merge_top16_kp(float (&a)[16], int (&pa)[16], int mask) {
#pragma unroll
    for (int i = 0; i < 16; ++i) {
        const float bk = __shfl_xor(a[15 - i], mask); const int bp = __shfl_xor(pa[15 - i], mask);
        const bool takeb = (bk > a[i]) || (bk == a[i] && bp < pa[i]);
        a[i] = takeb ? bk : a[i]; pa[i] = takeb ? bp : pa[i];
    }
#pragma unroll
    for (int j = 8; j > 0; j >>= 1)
#pragma unroll
        for (int i = 0; i < 16; ++i) { const int l = i ^ j; if (l > i) ce_kp(a[i], pa[i], a[l], pa[l]); }
}

__device__ __forceinline__ void phase11(const Params& p, LAS unsigned char* lds) {
    const int lane = tidx() & 63, h = __builtin_amdgcn_readfirstlane(tidx() >> 6), r = lane & 15, q = lane >> 4;
    for (int ut = blockIdx.x; ut < MF / 16; ut += p.G) {
        const int row0 = ut * 16;
        float top[2][16];
        u32x4 sraw[2][4];
#pragma unroll
        for (int c = 0; c < 2; ++c) {
            const bf16_t* ssrc = p.QRY + (size_t)(row0 + r) * 2048 + (2 * h + c) * 128 + 32 * q;
#pragma unroll
            for (int j = 0; j < 4; ++j) sraw[c][j] = *(const u32x4*)(ssrc + 8 * j);
        }
#pragma unroll
        for (int c = 0; c < 2; ++c) {
            float sv[32];
#pragma unroll
            for (int j = 0; j < 4; ++j) {
                const u32x4 w = sraw[c][j];
                const float t8[8] = {hlo(w.x), hhi(w.x), hlo(w.y), hhi(w.y), hlo(w.z), hhi(w.z), hlo(w.w), hhi(w.w)};
#pragma unroll
                for (int i = 0; i < 8; ++i) sv[8 * j + i] = __uint_as_float((__float_as_uint(t8[i]) & ~127u) | (unsigned)(32 * q + 8 * j + i));
            }
            bitonic_sort_desc<32>(sv);
#pragma unroll
            for (int i = 0; i < 16; ++i) top[c][i] = sv[i];
            merge_top16(top[c], 16);
            merge_top16(top[c], 32);
        }
        float ck[16]; int cp[16];
        {
            constexpr int PI[50] = {0,0,0,0,0,0,0,0,0,0,0,0,0,0,0,0, 1,1,1,1,1,1,1,1, 2,2,2,2,2, 3,3,3,3, 4,4,4, 5,5, 6,6, 7,7, 8,9,10,11,12,13,14,15};
            constexpr int PJ[50] = {0,1,2,3,4,5,6,7,8,9,10,11,12,13,14,15, 0,1,2,3,4,5,6,7, 0,1,2,3,4, 0,1,2,3, 0,1,2, 0,1, 0,1, 0,1, 0,0,0,0,0,0,0,0};
#pragma unroll
            for (int k = 0; k < 16; ++k) { ck[k] = -3.0e38f; cp[k] = 0x7fffffff; }
#pragma unroll
            for (int pi = 0; pi < 50; ++pi) {
                const float a = top[0][PI[pi]], b = top[1][PJ[pi]];
                const float sum = __uint_as_float(__float_as_uint(a) & ~127u) + __uint_as_float(__float_as_uint(b) & ~127u);
                const int e = (int)((__float_as_uint(a) & 127u) * 128u + (__float_as_uint(b) & 127u));
                if ((pi & 3) == q) { ck[pi >> 2] = sum; cp[pi >> 2] = e; }
            }
        }
        bitonic_sort_desc_kp16(ck, cp);
        merge_top16_kp(ck, cp, 16);
        merge_top16_kp(ck, cp, 32);
        float e[16], es = 0.f;
#pragma unroll
        for (int k = 0; k < 16; ++k) { e[k] = __expf(ck[k] - ck[0]); es += e[k]; }
        const float inv = 1.f / es;
        const int row = row0 + r;
        if (row < MF) {
#pragma unroll
            for (int k = 0; k < 16; ++k) if ((k >> 2) == q) {
                p.EIDX[(size_t)row * 128 + h * 16 + k] = (unsigned short)cp[k];
                p.EGATE[(size_t)row * 128 + h * 16 + k] = e[k] * inv;
            }
        }
    }
}

__device__ __forceinline__ float byte_f(unsigned w, int b) { return (float)((w >> (8 * b)) & 0xFFu); }
constexpr int PEER_TOKB = 2560;
__device__ __forceinline__ void peer_ids(LAS const unsigned char* tl, int c, int (&eid)[8]) {
    LAS const unsigned* El = (LAS const unsigned*)tl + c * 8;
    const u32x4 ev0 = *(LAS const u32x4*)El, ev1 = *(LAS const u32x4*)(El + 4);
    const int e[8] = {(int)ev0.x, (int)ev0.y, (int)ev0.z, (int)ev0.w, (int)ev1.x, (int)ev1.y, (int)ev1.z, (int)ev1.w};
#pragma unroll
    for (int k = 0; k < 8; ++k) eid[k] = __builtin_amdgcn_readfirstlane(e[k]);
}
__device__ __forceinline__ void peer_load(__amdgpu_buffer_rsrc_t tab, const int (&eid)[8], int lane, u32x4 (&r)[8]) {
#pragma unroll
    for (int k = 0; k < 8; ++k) r[k] = __builtin_amdgcn_raw_buffer_load_b128(tab, lane * 16, eid[k] << 10, 0);
}
__device__ __forceinline__ void peer_fetch(__amdgpu_buffer_rsrc_t tab, LAS const unsigned char* tl, int c, int lane, u32x4 (&r)[8]) {
    int eid[8]; peer_ids(tl, c, eid); peer_load(tab, eid, lane, r);
}
typedef float f32x2 __attribute__((ext_vector_type(2)));
__device__ __forceinline__ void peer_axpy(f32x2 (&f)[8], const u32x4 (&r)[8], const float (&cc)[8]) {
#pragma unroll
    for (int k = 0; k < 8; ++k) {
        const unsigned w[2] = {r[k].z, r[k].w};
        const f32x2 c2 = {cc[k], cc[k]};
#pragma unroll
        for (int dw = 0; dw < 2; ++dw) {
            f[4 * dw + 0] += c2 * __builtin_amdgcn_cvt_scalef32_pk_f32_fp4(w[dw], 1.0f, 0);
            f[4 * dw + 1] += c2 * __builtin_amdgcn_cvt_scalef32_pk_f32_fp4(w[dw], 1.0f, 1);
            f[4 * dw + 2] += c2 * __builtin_amdgcn_cvt_scalef32_pk_f32_fp4(w[dw], 1.0f, 2);
            f[4 * dw + 3] += c2 * __builtin_amdgcn_cvt_scalef32_pk_f32_fp4(w[dw], 1.0f, 3);
        }
        asm volatile("" : "+v"(f[0]), "+v"(f[1]), "+v"(f[2]), "+v"(f[3]), "+v"(f[4]), "+v"(f[5]), "+v"(f[6]), "+v"(f[7]));
    }
}
__device__ __forceinline__ void peer_chunk(LAS const unsigned char* tl, int c, int lane, int myk, const u32x4 (&r)[8], f32x2 (&f)[8]) {
    const u32x4 hq = *(LAS const u32x4*)(tl + 1536 + lane * 16);
    const float gvs = ((LAS const float*)(tl + 512))[c * 8 + myk], sus = ((LAS const float*)(tl + 1024))[c * 8 + myk];
    int x[8];
#pragma unroll
    for (int k = 0; k < 8; ++k) {
        int hi = __builtin_amdgcn_sdot8((int)r[k].x, (int)hq.x, 0, false);
        hi = __builtin_amdgcn_sdot8((int)r[k].y, (int)hq.y, hi, false);
        int lo = __builtin_amdgcn_sdot8((int)r[k].x, (int)hq.z, 0, false);
        lo = __builtin_amdgcn_sdot8((int)r[k].y, (int)hq.w, lo, false);
        x[k] = (hi << 4) + lo;
    }
    int y4[4], y2[2], y1;
#pragma unroll
    for (int j = 0; j < 4; ++j) { const auto q = __builtin_amdgcn_permlane32_swap((unsigned)x[j], (unsigned)x[j + 4], false, false); y4[j] = (int)(q[0] + q[1]); }
#pragma unroll
    for (int j = 0; j < 2; ++j) { const auto q = __builtin_amdgcn_permlane16_swap((unsigned)y4[j], (unsigned)y4[j + 2], false, false); y2[j] = (int)(q[0] + q[1]); }
    { const int snd = (lane & 8) ? y2[0] : y2[1], kp = (lane & 8) ? y2[1] : y2[0]; y1 = kp + __builtin_amdgcn_update_dpp(0, snd, 0x128, 0xF, 0xF, false); }
    y1 += __builtin_amdgcn_update_dpp(0, y1, 0xB1, 0xF, 0xF, false);
    y1 += __builtin_amdgcn_update_dpp(0, y1, 0x4E, 0xF, 0xF, false);
    y1 += __builtin_amdgcn_update_dpp(0, y1, 0x141, 0xF, 0xF, false);
    const float d = (float)y1 * sus;
    const float z = fabsf(d) * 0.70710678118654752f;
    const float t = __builtin_amdgcn_rcpf(fmaf(0.3275911f, z, 1.f));
    const float poly = t * fmaf(t, fmaf(t, fmaf(t, fmaf(t, 1.061405429f, -1.453152027f), 1.421413741f), -0.284496736f), 0.254829592f);
    const float q = poly * __builtin_amdgcn_exp2f(-1.4426950408889634f * z * z);
    const float cmine = gvs * 0.5f * d * (d >= 0.f ? 2.f - q : q);
    float cc[8];
#pragma unroll
    for (int k = 0; k < 8; ++k) cc[k] = __uint_as_float(__builtin_amdgcn_readlane(__float_as_uint(cmine), ((k & 4) ? 32 : 0) + ((k & 2) ? 16 : 0) + ((k & 1) ? 8 : 0)));
    peer_axpy(f, r, cc);
}
__device__ __forceinline__ int peer_row(int b, int w, int k, int G) {
    const int base = k * G * 8, rem = MF - base;
    if (rem >= G * 8) return base + b * 8 + w;
    if (rem <= 0) return MF;
    const int wpb = (rem + G - 1) / G, r = b * wpb + w;
    return (w < wpb && r < rem) ? base + r : MF;
}
struct PeerRaw { f32x4 h[4]; int e0, e1; float g0, g1; };
__device__ __forceinline__ void peer_raw_load(const Params& p, int row, int lane, PeerRaw& r) {
    const float* hsrc = p.V1 + (size_t)row * D + lane * 16;
#pragma unroll
    for (int j = 0; j < 4; ++j) r.h[j] = *(const f32x4*)(hsrc + 4 * j);
    r.e0 = p.EIDX[(size_t)row * 128 + lane]; r.e1 = p.EIDX[(size_t)row * 128 + 64 + lane];
    r.g0 = p.EGATE[(size_t)row * 128 + lane]; r.g1 = p.EGATE[(size_t)row * 128 + 64 + lane];
}
__device__ __forceinline__ void peer_setup(const Params& p, LAS unsigned char* tl, int lane, const PeerRaw& r) {
    LAS int* El = (LAS int*)tl; LAS float* GVl = (LAS float*)(tl + 512); LAS float* SUl = (LAS float*)(tl + 1024);
    unsigned a = ((unsigned)r.e0 << 7) | (unsigned)lane, b = ((unsigned)r.e1 << 7) | (unsigned)(64 + lane);
    auto cx = [&](auto jc, int k) {
        constexpr int j = decltype(jc)::value;
        const unsigned pa = lane_xor<j>(a, lane), pb = lane_xor<j>(b, lane);
        const bool lower = (lane & j) == 0, upa = (lane & k) == 0, upb = ((64 + lane) & k) == 0;
        a = (lower == upa) ? (a < pa ? a : pa) : (a < pa ? pa : a);
        b = (lower == upb) ? (b < pb ? b : pb) : (b < pb ? pb : b);
    };
#pragma unroll
    for (int k = 2; k <= 128; k <<= 1) {
        if (k == 128) { const unsigned lo = a < b ? a : b, hi = a < b ? b : a; a = lo; b = hi; }
        if (k >= 64) cx(std::integral_constant<int, 32>{}, k);
        if (k >= 32) cx(std::integral_constant<int, 16>{}, k);
        if (k >= 16) cx(std::integral_constant<int, 8>{}, k);
        if (k >= 8) cx(std::integral_constant<int, 4>{}, k);
        if (k >= 4) cx(std::integral_constant<int, 2>{}, k);
        cx(std::integral_constant<int, 1>{}, k);
    }
    const int e0 = (int)(a >> 7), e1 = (int)(b >> 7);
    const float sv0 = p.SV[e0], sv1 = p.SV[e1], suv0 = p.SU[e0], suv1 = p.SU[e1];
    const int sa = a & 127, sb = b & 127;
    const float ga0 = __shfl(r.g0, sa & 63), ga1 = __shfl(r.g1, sa & 63), gb0 = __shfl(r.g0, sb & 63), gb1 = __shfl(r.g1, sb & 63);
    const float gA = (sa & 64) ? ga1 : ga0, gB = (sb & 64) ? gb1 : gb0;
    float am = 0.f;
#pragma unroll
    for (int j = 0; j < 4; ++j) am = fmaxf(am, fmaxf(fmaxf(fabsf(r.h[j].x), fabsf(r.h[j].y)), fmaxf(fabsf(r.h[j].z), fabsf(r.h[j].w))));
    am = wave_max(am);
    const float sh = am > 0.f ? am * (1.f / 119.f) : 1.f, ish = 1.f / sh;
    unsigned hw[4] = {0u, 0u, 0u, 0u};
#pragma unroll
    for (int j = 0; j < 16; ++j) {
        const float hv = (j & 3) == 0 ? r.h[j >> 2].x : ((j & 3) == 1 ? r.h[j >> 2].y : ((j & 3) == 2 ? r.h[j >> 2].z : r.h[j >> 2].w));
        const int q = (int)rintf(hv * ish);
        const int bq = ((q + 8) & 15) - 8, aq = (q - bq) >> 4;
        const int jj = j & 7, pos = jj < 4 ? 2 * jj : 2 * (jj - 4) + 1;
        hw[j >> 3] |= (unsigned)(aq & 0xF) << (4 * pos);
        hw[2 + (j >> 3)] |= (unsigned)(bq & 0xF) << (4 * pos);
    }
    *(LAS u32x4*)(tl + 1536 + lane * 16) = (u32x4){hw[0], hw[1], hw[2], hw[3]};
    El[lane] = e0; El[64 + lane] = e1;
    GVl[lane] = gA * sv0; GVl[64 + lane] = gB * sv1; SUl[lane] = suv0 * sh; SUl[64 + lane] = suv1 * sh;
}
__device__ __forceinline__ void phase12(const Params& p, LAS unsigned char* lds, const XcdBarrier* gb = nullptr) {
    const int lane = tidx() & 63, wv = __builtin_amdgcn_readfirstlane(tidx() >> 6);
    const int myk = ((lane >> 5) & 1) * 4 + ((lane >> 4) & 1) * 2 + ((lane >> 3) & 1);
    LAS unsigned char* wl = lds + wv * 20352;
    const __amdgpu_buffer_rsrc_t rt = __builtin_amdgcn_make_buffer_rsrc((void*)p.PU8, (short)0, NEXP * D, 0x00020000);
    const int ktrips = (MF + p.G * 8 - 1) / (p.G * 8);
    int ntok = 0;
    for (int k = 0; k < ktrips; ++k) ntok += peer_row(blockIdx.x, wv, k, p.G) < MF ? 1 : 0;
    if (ntok == 0) return;
    const int row0 = peer_row(blockIdx.x, wv, 0, p.G);
    PeerRaw raw;
    peer_raw_load(p, row0, lane, raw);
    peer_setup(p, wl, lane, raw);
    u32x4 B0[8], B1[8], B2[8], B3[8];
    peer_fetch(rt, wl, 0, lane, B0); peer_fetch(rt, wl, 1, lane, B1); peer_fetch(rt, wl, 2, lane, B2);
#pragma unroll 1
    for (int j = 0; j < ntok; ++j) {
        LAS unsigned char* tl = wl + (j & 1) * PEER_TOKB;
        LAS unsigned char* tn = wl + ((j + 1) & 1) * PEER_TOKB;
        const bool hasn = j + 1 < ntok;
        if (hasn) { PeerRaw rw; peer_raw_load(p, peer_row(blockIdx.x, wv, j + 1, p.G), lane, rw); peer_setup(p, tn, lane, rw); }
        f32x2 f[8];
#pragma unroll
        for (int i = 0; i < 8; ++i) f[i] = (f32x2){0.f, 0.f};
        auto ahead = [&](int q, u32x4 (&r)[8]) { const bool nx = q >= 16; peer_fetch(rt, nx ? (hasn ? tn : tl) : tl, nx ? q - 16 : q, lane, r); };
#pragma unroll 1
        for (int c = 0; c < 12; c += 4) {
            ahead(c + 3, B3); peer_chunk(tl, c, lane, myk, B0, f); __builtin_amdgcn_sched_barrier(0);
            ahead(c + 4, B0); peer_chunk(tl, c + 1, lane, myk, B1, f); __builtin_amdgcn_sched_barrier(0);
            ahead(c + 5, B1); peer_chunk(tl, c + 2, lane, myk, B2, f); __builtin_amdgcn_sched_barrier(0);
            ahead(c + 6, B2); peer_chunk(tl, c + 3, lane, myk, B3, f); __builtin_amdgcn_sched_barrier(0);
        }
        const int row = peer_row(blockIdx.x, wv, j, p.G);
        const float* hsrc = p.V1 + (size_t)row * D + lane * 16;
        f32x4 hh[4];
#pragma unroll
        for (int i = 0; i < 4; ++i) hh[i] = *(const f32x4*)(hsrc + 4 * i);
        ahead(15, B3); peer_chunk(tl, 12, lane, myk, B0, f); __builtin_amdgcn_sched_barrier(0);
        ahead(16, B0); peer_chunk(tl, 13, lane, myk, B1, f); __builtin_amdgcn_sched_barrier(0);
        ahead(17, B1); peer_chunk(tl, 14, lane, myk, B2, f); __builtin_amdgcn_sched_barrier(0);
        ahead(18, B2); peer_chunk(tl, 15, lane, myk, B3, f); __builtin_amdgcn_sched_barrier(0);
        float* yout = p.out + O_YP + (size_t)row * D;
        float v[16];
#pragma unroll
        for (int i = 0; i < 4; ++i) { v[4 * i] = DN_ALPHA * hh[i].x + f[2 * i][0]; v[4 * i + 1] = DN_ALPHA * hh[i].y + f[2 * i][1]; v[4 * i + 2] = DN_ALPHA * hh[i].z + f[2 * i + 1][0]; v[4 * i + 3] = DN_ALPHA * hh[i].w + f[2 * i + 1][1]; }
        ln_row(v, p.ln2_g, p.ln2_b, lane);
#pragma unroll
        for (int i = 0; i < 16; i += 4) *(f32x4*)(yout + lane * 16 + i) = (f32x4){v[i], v[i + 1], v[i + 2], v[i + 3]};
    }
}

#ifndef MEGA
#define MEGA 1
#endif
template <int PHX> __device__ __forceinline__ void run_phase(const Params& p, LAS unsigned char* lds) {
    if constexpr (PHX == 0) phase0(p, lds);
    else if constexpr (PHX == 1) phase1(p, lds);
    else if constexpr (PHX == 2) phase2(p, lds);
    else if constexpr (PHX == 3) phase3(p, lds);
    else if constexpr (PHX == 4) phase4(p, lds);
    else if constexpr (PHX == 5) phase5(p, lds);
    else if constexpr (PHX == 6) phase6(p, lds);
#ifdef DIAG_ATTN
    else if constexpr (PHX == 7) phase_diag(p, lds);
    else if constexpr (PHX == 8) phase_report(p);
    else if constexpr (PHX >= 9) {}
#endif
    else if constexpr (PHX == 7) phase7(p, lds);
    else if constexpr (PHX == 8) phase8(p, lds);
    else if constexpr (PHX == 9) phase9(p, lds);
    else if constexpr (PHX == 10) phase10(p, lds);
    else if constexpr (PHX == 11) phase11(p, lds);
    else if constexpr (PHX == 12) phase12(p, lds);
}
#define FOR_PHASES(X) X(0) X(1) X(2) X(3) X(4) X(5) X(6) X(7) X(8) X(9) X(10) X(11) X(12)

constexpr int LDS_BYTES = 163840;
constexpr int LDS_BAR_OFF = LDS_BYTES - 16;

constexpr size_t al256(size_t x) { return (x + 255) & ~(size_t)255; }
constexpr size_t WS_BAR = 0;
constexpr size_t WS_XB = WS_BAR + 16384;
constexpr size_t WS_WINT = WS_XB + al256((size_t)MPAD * D * 2);
constexpr size_t WS_WBGT = WS_WINT + al256((size_t)NPAD * D * 2);
constexpr size_t WS_WBAT = WS_WBGT + al256((size_t)D * D * 2);
constexpr size_t WS_WOUTT = WS_WBAT + al256((size_t)D * D * 2);
constexpr size_t WS_WQT = WS_WOUTT + al256((size_t)D * D * 2);
constexpr size_t WS_SUBK = WS_WQT + al256((size_t)2048 * D * 2);
constexpr size_t WS_PARTS = WS_SUBK + al256((size_t)16 * 128 * 128 * 2);
constexpr size_t WS_SMALL = WS_PARTS + al256((size_t)MPAD * NPAD * 2);
constexpr size_t WS_GOPS = WS_SMALL + al256((size_t)MPAD * 32 * 4);
constexpr size_t WS_GOPS_S = WS_GOPS + al256((size_t)NB * GH * NCHUNK * BLOB64);
constexpr size_t WS_ORAW = WS_GOPS_S + al256((size_t)DBATCH * GH * BLOB16);
constexpr size_t WS_OGDN = WS_ORAW + al256((size_t)MPAD * D * 2);
constexpr size_t WS_OATT = WS_OGDN + al256((size_t)MPAD * D * 2);
constexpr size_t WS_MASK = WS_OATT + al256((size_t)MPAD * D * 2);
constexpr size_t WS_TMPA = WS_MASK + al256((size_t)MR * 33 * 8);
constexpr size_t WS_MERGED = WS_TMPA + al256((size_t)MPAD * D * 4);
constexpr size_t WS_V1 = WS_MERGED + al256((size_t)MPAD * D * 2);
constexpr size_t WS_HB = WS_V1 + al256((size_t)MPAD * D * 4);
constexpr size_t WS_QRY = WS_HB + al256((size_t)MPAD * D * 2);
constexpr size_t WS_EIDX = WS_QRY + al256((size_t)MPAD * 2048 * 2);
constexpr size_t WS_EGATE = WS_EIDX + al256((size_t)MR * 128 * 2);
constexpr size_t WS_PU8 = WS_EGATE + al256((size_t)MR * 128 * 4);
constexpr size_t WS_PV8 = WS_PU8 + al256((size_t)NEXP * D);
constexpr size_t WS_SU = WS_PV8 + al256((size_t)NEXP * D);
constexpr size_t WS_SV = WS_SU + al256((size_t)NEXP * 4);
constexpr size_t WS_KIDX = WS_SV + al256((size_t)NEXP * 4);
constexpr size_t WS_AKC = WS_KIDX + al256((size_t)MPAD * 64 * 2);
constexpr size_t WS_AVC = WS_AKC + al256((size_t)MPAD * 256 * 2);
constexpr size_t WS_ESU = WS_AVC + al256((size_t)MPAD * 256 * 2);
constexpr size_t WS_IKC = WS_ESU + al256((size_t)MR * 128 * 4);
constexpr size_t WS_END = WS_IKC + al256((size_t)DBATCH * PAST * IDIM * 2);

struct KArgs {
    const float *x_prompt, *x_sample, *cache_k, *cache_v, *cache_ik, *state_conv, *state_delta; const int* page_table;
    const float *meta, *w_in, *conv_w, *a_log, *dt_bias, *gnorm, *w_bg, *w_ba, *w_out, *ln1_g, *ln1_b, *peer_wq, *peer_sub, *peer_u, *peer_v, *ln2_g, *ln2_b;
    float* out; unsigned char* ws;
    int G; int pad_;
};
__device__ __forceinline__ Params make_params(const KArgs& a) {
    Params p;
    p.x_prompt = a.x_prompt; p.x_sample = a.x_sample; p.cache_k = a.cache_k; p.cache_v = a.cache_v; p.cache_ik = a.cache_ik; p.state_conv = a.state_conv; p.state_delta = a.state_delta;
    p.page_table = a.page_table; p.meta = a.meta; p.w_in = a.w_in; p.conv_w = a.conv_w; p.a_log = a.a_log; p.dt_bias = a.dt_bias; p.gnorm = a.gnorm; p.w_bg = a.w_bg; p.w_ba = a.w_ba;
    p.w_out = a.w_out; p.ln1_g = a.ln1_g; p.ln1_b = a.ln1_b; p.peer_wq = a.peer_wq; p.peer_sub = a.peer_sub; p.peer_u = a.peer_u; p.peer_v = a.peer_v; p.ln2_g = a.ln2_g; p.ln2_b = a.ln2_b;
    p.out = a.out; p.G = a.G;
    unsigned char* ws = a.ws;
    p.bar = (unsigned*)(ws + WS_BAR); p.XB = (bf16_t*)(ws + WS_XB); p.WINT = (bf16_t*)(ws + WS_WINT); p.WBGT = (bf16_t*)(ws + WS_WBGT); p.WBAT = (bf16_t*)(ws + WS_WBAT);
    p.WOUTT = (bf16_t*)(ws + WS_WOUTT); p.WQT = (bf16_t*)(ws + WS_WQT); p.SUBK = (bf16_t*)(ws + WS_SUBK); p.PU = nullptr; p.PV = nullptr; p.PARTS = (bf16_t*)(ws + WS_PARTS);
    p.SMALL = (float*)(ws + WS_SMALL); p.GOPS = ws + WS_GOPS; p.GOPS_S = ws + WS_GOPS_S; p.ORAW = (bf16_t*)(ws + WS_ORAW); p.OGDN = (bf16_t*)(ws + WS_OGDN); p.OATT = (bf16_t*)(ws + WS_OATT);
    p.MASK = (unsigned long long*)(ws + WS_MASK); p.TMPA = (float*)(ws + WS_TMPA); p.MERGED = (bf16_t*)(ws + WS_MERGED); p.V1 = (float*)(ws + WS_V1); p.HB = (bf16_t*)(ws + WS_HB);
    p.QRY = (bf16_t*)(ws + WS_QRY); p.EIDX = (unsigned short*)(ws + WS_EIDX); p.EGATE = (float*)(ws + WS_EGATE); p.PU8 = ws + WS_PU8; p.PV8 = ws + WS_PV8; p.SU = (float*)(ws + WS_SU); p.SV = (float*)(ws + WS_SV);
    p.ESU = (float*)(ws + WS_ESU); p.KIDX = (bf16_t*)(ws + WS_KIDX); p.AKC = (bf16_t*)(ws + WS_AKC); p.AVC = (bf16_t*)(ws + WS_AVC); p.IKC = (bf16_t*)(ws + WS_IKC);
    return p;
}

template <int PHX> __global__ __launch_bounds__(512, 2) void k_phase(KArgs ka) {
    extern __shared__ __attribute__((aligned(16))) unsigned char smem[];
    LAS unsigned char* lds = (LAS unsigned char*)smem;
    const Params p = make_params(ka);
    run_phase<PHX>(p, lds);
}

#if MEGA
#ifndef MEGA_MASK
#define MEGA_MASK 0xFFFF
#endif
#if STAMPS
#define RUNP(i) do { if (blockIdx.x == 0 && threadIdx.x == 0) p.bar[3600 + (i)] = (unsigned)(wall_clock64() - t_start); if ((MEGA_MASK >> (i)) & 1) run_phase<i>(p, lds); } while (0)
#else
#define RUNP(i) do { if ((MEGA_MASK >> (i)) & 1) run_phase<i>(p, lds); } while (0)
#endif
__global__ __launch_bounds__(512, 2) void k_mega(KArgs ka) {
    extern __shared__ __attribute__((aligned(16))) unsigned char smem[];
    LAS unsigned char* lds = (LAS unsigned char*)smem;
    const Params p = make_params(ka);
    if (threadIdx.x == 0) *(LAS u32x4*)(lds + LDS_BAR_OFF) = (u32x4){0u, 0u, 0u, 0u};
    __syncthreads();
    XcdBarrier bar = xcd_barrier_post(p.bar, (volatile LAS unsigned*)(lds + LDS_BAR_OFF), p.G);
#if STAMPS
    const unsigned long long t_start = wall_clock64();
#endif
    RUNP(0);  xcd_barrier(bar);
    RUNP(1);  xcd_barrier(bar);
    RUNP(2);  RUNP(5);  xcd_barrier(bar);
    RUNP(3);  xcd_barrier(bar);
    RUNP(4);  RUNP(6);  xcd_barrier(bar);
    RUNP(7);  xcd_barrier(bar);
    RUNP(8);  xcd_barrier(bar);
    RUNP(9);  xcd_barrier(bar);
    RUNP(10); xcd_barrier(bar);
    RUNP(11); xcd_barrier(bar);
#if STAMPS
    if (blockIdx.x == 0 && threadIdx.x == 0) p.bar[3600 + 12] = (unsigned)(wall_clock64() - t_start);
#endif
    phase12(p, lds, &bar);
#if STAMPS
    xcd_barrier(bar);
    if (blockIdx.x == 0) {
        LAS unsigned* dur = (LAS unsigned*)lds;
        if (threadIdx.x == 0) {
            unsigned t[14]; for (int i = 0; i < 13; ++i) t[i] = p.bar[3600 + i]; t[13] = (unsigned)(wall_clock64() - t_start);
            unsigned d[13]; for (int i = 0; i < 13; ++i) d[i] = (t[i + 1] - t[i]) / 100u;
            dur[0] = d[0]; dur[1] = d[1]; dur[2] = d[2]; dur[3] = d[3]; dur[4] = d[4] + d[9]; dur[5] = d[5]; dur[6] = d[6]; dur[7] = d[7]; dur[8] = d[8]; dur[9] = d[10]; dur[10] = d[11]; dur[11] = d[12];
#if STAMPS == 2
            { for (int i = 0; i < 12; ++i) dur[i] = p.bar[3620 + i] / 100u; }
#endif
        }
        __syncthreads();
        const long offs[12] = {O_YP, O_YS, O_PCONV, O_PDELTA, O_PK, O_PV, O_PIK, O_SCONV, O_SDELTA, O_SK, O_SV, O_SIK};
        for (int ch = 0; ch < 12; ++ch) for (unsigned i = threadIdx.x; i < 8192u; i += 512) ((unsigned*)p.out)[offs[ch] + i] = (i < dur[ch]) ? 0xAAAAAAAAu : 0u;
    }
#endif
}
#endif

extern "C" void kernel_launch(void* const* d_in, const int* in_sizes, int n_in, void* d_out, int out_size, void* d_ws, size_t ws_size, hipStream_t stream) {
    KArgs p{};
    p.x_prompt = (const float*)d_in[0]; p.x_sample = (const float*)d_in[1]; p.cache_k = (const float*)d_in[2]; p.cache_v = (const float*)d_in[3];
    p.cache_ik = (const float*)d_in[4]; p.state_conv = (const float*)d_in[5]; p.state_delta = (const float*)d_in[6]; p.page_table = (const int*)d_in[7];
    p.meta = (const float*)d_in[8]; p.w_in = (const float*)d_in[9]; p.conv_w = (const float*)d_in[10]; p.a_log = (const float*)d_in[11]; p.dt_bias = (const float*)d_in[12];
    p.gnorm = (const float*)d_in[13]; p.w_bg = (const float*)d_in[14]; p.w_ba = (const float*)d_in[15]; p.w_out = (const float*)d_in[16];
    p.ln1_g = (const float*)d_in[17]; p.ln1_b = (const float*)d_in[18]; p.peer_wq = (const float*)d_in[19]; p.peer_sub = (const float*)d_in[20];
    p.peer_u = (const float*)d_in[21]; p.peer_v = (const float*)d_in[22]; p.ln2_g = (const float*)d_in[23]; p.ln2_b = (const float*)d_in[24];
    p.out = (float*)d_out; p.ws = (unsigned char*)d_ws;
    if (WS_END > ws_size || n_in != 25) { fprintf(stderr, "kernel_launch: workspace too small (%zu > %zu) or n_in %d != 25\n", (size_t)WS_END, ws_size, n_in); return; }

    static int grid = 0;
    if (grid == 0) {
        int dev = 0, cus = 0;
        (void)hipGetDevice(&dev); (void)hipDeviceGetAttribute(&cus, hipDeviceAttributeMultiprocessorCount, dev);
        grid = cus > 0 ? cus : 256;
#if MEGA
        (void)hipFuncSetAttribute((const void*)k_mega, hipFuncAttributeMaxDynamicSharedMemorySize, LDS_BYTES);
        int per_cu = 0;
        if (hipOccupancyMaxActiveBlocksPerMultiprocessor(&per_cu, (const void*)k_mega, 512, LDS_BYTES) != hipSuccess || per_cu < 1)
            fprintf(stderr, "kernel_launch: note: the occupancy query reports %d workgroups per CU for k_mega (512 threads, %d bytes of LDS); launching one per CU anyway\n", per_cu, LDS_BYTES);
#else
#define X_ATTR(i) (void)hipFuncSetAttribute((const void*)k_phase<i>, hipFuncAttributeMaxDynamicSharedMemorySize, LDS_BYTES);
        FOR_PHASES(X_ATTR)
#endif
        (void)hipGetLastError();
    }
    p.G = grid; p.pad_ = 0;
    (void)hipMemsetAsync(p.ws + WS_BAR, 0, 16384, stream);
#if MEGA
    hipLaunchKernelGGL(k_mega, dim3(grid), dim3(512), LDS_BYTES, stream, p);
#else
#define X_LAUNCH(i) hipLaunchKernelGGL(k_phase<i>, dim3(grid), dim3(512), LDS_BYTES, stream, p);
    FOR_PHASES(X_LAUNCH)
#endif
}
```
